# Optimizing an MI355X kernel written in HIP

```python
import jax, jax.numpy as jnp
from jax import lax
import numpy as np

D_MODEL = 1024
BATCH = 8
SEQ = 4096
DEPTH = 2

GRID_W = 64
CTX_LEN = 256
N_MIXERS = 2
N_RET_LAYERS = (DEPTH + 1) // 2
N_CONV_LAYERS = DEPTH // 2
RET_HEADS = 4
RET_QK_DIM = D_MODEL // RET_HEADS
RET_V_DIM = 2 * RET_QK_DIM
RET_QK_TOTAL = RET_HEADS * RET_QK_DIM
RET_V_TOTAL = RET_HEADS * RET_V_DIM
RET_IN_DIM = 2 * RET_QK_TOTAL + 2 * RET_V_TOTAL
RET_CHUNK = 128
ROPE_AXES = (64, 96, 96)
ROPE_THETA = 10000.0
CONV_WIDTH = 31
N_EXPERTS = 64
TOP_K = 8
N_GROUPS = 8
TOPK_GROUPS = 4
EXPERT_DIM = 256
SHARED_DIM = 256
ROUTE_SCALE = 2.5
MOE_BLOCK = 128
NORM_EPS = 1e-6
LN_EPS = 1e-5

kernel_name = 'hybrid_retention_conformer_moe_dit'


def rms_norm(x, g):
    xf = x.astype(jnp.float32)
    y = xf * lax.rsqrt(jnp.mean(xf * xf, -1, keepdims=True) + NORM_EPS)
    return (y * g.astype(jnp.float32)).astype(x.dtype)


def modulate(x, shift, scale):
    return x * (1 + scale) + shift


def rope_angles(pos):
    parts = []
    for a, d in enumerate(ROPE_AXES):
        inv = ROPE_THETA ** (-jnp.arange(0, d, 2, dtype=jnp.float32) / d)
        parts.append(pos[:, a:a + 1].astype(jnp.float32) * inv[None, :])
    return jnp.concatenate(parts, -1)


def apply_rope(x, ang):
    cos = jnp.cos(ang)[None, :, None, :].astype(x.dtype)
    sin = jnp.sin(ang)[None, :, None, :].astype(x.dtype)
    xr = x.reshape(x.shape[:-1] + (-1, 2))
    x0, x1 = xr[..., 0], xr[..., 1]
    return jnp.stack([x0 * cos - x1 * sin, x0 * sin + x1 * cos], -1).reshape(x.shape)


def retention_chunkwise(q, k, v, log_g, s0):
    b, h, n, dk = q.shape
    dv = v.shape[-1]
    c = RET_CHUNK
    nc = n // c
    qc = q.reshape(b, h, nc, c, dk)
    kc = k.reshape(b, h, nc, c, dk)
    vc = v.reshape(b, h, nc, c, dv)
    idx = jnp.arange(c, dtype=jnp.float32)
    rel = idx[:, None] - idx[None, :]
    dmask = jnp.where(rel >= 0, jnp.exp(log_g[:, None, None] * jnp.maximum(rel, 0.0)), 0.0).astype(q.dtype)
    scores = jnp.einsum('bhcid,bhcjd->bhcij', qc, kc) * dmask[None, :, None]
    o_intra = jnp.einsum('bhcij,bhcje->bhcie', scores, vc)
    q_dec = jnp.exp(log_g[:, None] * (idx + 1.0)).astype(q.dtype)[None, :, :, None]
    k_dec = jnp.exp(log_g[:, None] * (c - 1.0 - idx)).astype(q.dtype)[None, :, :, None]
    c_dec = jnp.exp(log_g * c).astype(q.dtype)[None, :, None, None]

    def step(s, inp):
        qi, ki, vi = inp
        o = jnp.einsum('bhid,bhde->bhie', qi * q_dec, s)
        s = s * c_dec + jnp.einsum('bhjd,bhje->bhde', ki * k_dec, vi)
        return s, o

    xs = (jnp.moveaxis(qc, 2, 0), jnp.moveaxis(kc, 2, 0), jnp.moveaxis(vc, 2, 0))
    _, o_inter = lax.scan(step, s0, xs)
    o = o_intra + jnp.moveaxis(o_inter, 0, 2)
    return o.reshape(b, h, n, dv)


def retention_final_state(k, v, log_g, reverse):
    n = k.shape[2]
    pos = jnp.arange(n, dtype=jnp.float32)
    dist = pos if reverse else (n - 1.0 - pos)
    w = jnp.exp(log_g[:, None] * dist).astype(k.dtype)
    return jnp.einsum('bhmd,bhme->bhde', k * w[None, :, :, None], v)


def retention_mixer(h_lat, h_ctx, ang_lat, ang_ctx, w_in, w_out, decay_logit, with_ctx_out):
    log_g = jax.nn.log_sigmoid(decay_logit.astype(jnp.float32))

    def heads(z, d):
        return z.reshape(z.shape[0], z.shape[1], RET_HEADS, d)

    def to_bhnd(t):
        return jnp.transpose(t, (0, 2, 1, 3))

    def qkvg(hh, ang):
        z = hh @ w_in
        q, k, v, g = jnp.split(z, [RET_QK_TOTAL, 2 * RET_QK_TOTAL, 2 * RET_QK_TOTAL + RET_V_TOTAL], -1)
        q = apply_rope(heads(q, RET_QK_DIM), ang) * (RET_QK_DIM ** -0.5)
        k = apply_rope(heads(k, RET_QK_DIM), ang)
        return to_bhnd(q), to_bhnd(k), to_bhnd(heads(v, RET_V_DIM)), g

    def bidir(q, k, v, s_f, s_b):
        fwd = retention_chunkwise(q, k, v, log_g[0], s_f)
        bwd = retention_chunkwise(jnp.flip(q, 2), jnp.flip(k, 2), jnp.flip(v, 2), log_g[1], s_b)
        return fwd + jnp.flip(bwd, 2)

    def readout(y, g):
        yf = y.astype(jnp.float32)
        yf = yf * lax.rsqrt(jnp.mean(yf * yf, -1, keepdims=True) + NORM_EPS)
        yb = jnp.transpose(yf.astype(y.dtype), (0, 2, 1, 3)).reshape(y.shape[0], y.shape[2], RET_V_TOTAL)
        return (yb * jax.nn.silu(g)) @ w_out

    if with_ctx_out:
        qc, kc, vc, gc = qkvg(h_ctx, ang_ctx)
    else:
        z = h_ctx @ w_in[:, RET_QK_TOTAL:2 * RET_QK_TOTAL + RET_V_TOTAL]
        kc_, vc_ = jnp.split(z, [RET_QK_TOTAL], -1)
        kc = to_bhnd(apply_rope(heads(kc_, RET_QK_DIM), ang_ctx))
        vc = to_bhnd(heads(vc_, RET_V_DIM))
    s_f = retention_final_state(kc, vc, log_g[0], False)
    s_b = retention_final_state(kc, vc, log_g[1], True)
    q, k, v, g = qkvg(h_lat, ang_lat)
    out_lat = readout(bidir(q, k, v, s_f, s_b), g)
    if with_ctx_out:
        zero = jnp.zeros_like(s_f)
        out_ctx = readout(bidir(qc, kc, vc, zero, zero), gc)
        return out_lat, out_ctx
    return out_lat, None


def conv_module(hh, w1, b1, w_dw, b_dw, ln_g, ln_b, w2, b2):
    z = hh @ w1 + b1
    a, gate = jnp.split(z, 2, -1)
    u = a * jax.nn.sigmoid(gate)
    u = lax.conv_general_dilated(u, w_dw[:, None, :].astype(u.dtype), window_strides=(1,),
                                 padding=[(CONV_WIDTH // 2, CONV_WIDTH // 2)],
                                 dimension_numbers=('NWC', 'WIO', 'NWC'),
                                 feature_group_count=D_MODEL) + b_dw
    uf = u.astype(jnp.float32)
    mu = jnp.mean(uf, -1, keepdims=True)
    var = jnp.mean(jnp.square(uf - mu), -1, keepdims=True)
    uf = (uf - mu) * lax.rsqrt(var + LN_EPS) * ln_g.astype(jnp.float32) + ln_b.astype(jnp.float32)
    u = jax.nn.silu(uf.astype(u.dtype))
    return u @ w2 + b2


def swiglu(t, w1, w3, w2):
    return (jax.nn.silu(t @ w1) * (t @ w3)) @ w2


def moe_ffn(hh, w_router, router_bias, w1, w3, w2, ws1, ws3, ws2):
    shp = hh.shape
    hf = hh.reshape(-1, D_MODEL)
    n = hf.shape[0]
    scores = jax.nn.sigmoid(hf.astype(jnp.float32) @ w_router.astype(jnp.float32))
    biased = scores + router_bias.astype(jnp.float32)
    per = N_EXPERTS // N_GROUPS
    grp_score = lax.top_k(biased.reshape(n, N_GROUPS, per), 2)[0].sum(-1)
    _, gidx = lax.top_k(grp_score, TOPK_GROUPS)
    gmask = jax.nn.one_hot(gidx, N_GROUPS, dtype=jnp.float32).sum(1) > 0
    emask = jnp.repeat(gmask, per, axis=1)
    _, eidx = lax.top_k(jnp.where(emask, biased, -jnp.inf), TOP_K)
    wsel = jnp.take_along_axis(scores, eidx, 1)
    wsel = wsel / wsel.sum(-1, keepdims=True) * ROUTE_SCALE
    a = n * TOP_K
    e_flat = eidx.reshape(a).astype(jnp.int32)
    tok_flat = jnp.arange(a, dtype=jnp.int32) // TOP_K
    w_flat = wsel.reshape(a)
    order = jnp.argsort(e_flat)
    e_s = e_flat[order]
    tok_s = tok_flat[order]
    w_s = w_flat[order]
    counts = jax.ops.segment_sum(jnp.ones(a, jnp.int32), e_flat, num_segments=N_EXPERTS)
    start = jnp.cumsum(counts) - counts
    pcounts = (counts + MOE_BLOCK - 1) // MOE_BLOCK * MOE_BLOCK
    pend = jnp.cumsum(pcounts)
    pstart = pend - pcounts
    dest = pstart[e_s] + (jnp.arange(a, dtype=jnp.int32) - start[e_s])
    n_rows = -(-a // MOE_BLOCK) * MOE_BLOCK + N_EXPERTS * MOE_BLOCK
    n_blk = n_rows // MOE_BLOCK
    row_tok = jnp.zeros(n_rows, jnp.int32).at[dest].set(tok_s)
    row_w = jnp.zeros(n_rows, jnp.float32).at[dest].set(w_s)
    blk_e = jnp.minimum(jnp.searchsorted(pend, jnp.arange(n_blk, dtype=jnp.int32) * MOE_BLOCK, side='right'),
                        N_EXPERTS - 1)

    def block(acc, inp):
        toks, ws, e = inp
        y = swiglu(hf[toks], w1[e], w3[e], w2[e])
        return acc.at[toks].add((y * ws[:, None]).astype(acc.dtype)), None

    routed, _ = lax.scan(block, jnp.zeros_like(hf),
                         (row_tok.reshape(n_blk, MOE_BLOCK), row_w.reshape(n_blk, MOE_BLOCK), blk_e))
    out = routed + swiglu(hf, ws1, ws3, ws2)
    return out.reshape(shp)


def setup_inputs(seed: int = 0) -> dict:
    key = jax.random.key(seed)
    ks = jax.random.split(key, 32)

    def nrm(k, shape, scale):
        return jax.random.normal(k, shape, jnp.float32) * scale

    D = D_MODEL
    p = 1.0 - 2.0 ** (-5.0 - np.arange(RET_HEADS))
    decay_base = jnp.asarray(np.log(p / (1.0 - p)), jnp.float32)
    return {
        'x': nrm(ks[0], (BATCH, SEQ, D), 1.0),
        'c': nrm(ks[1], (BATCH, D), 1.0),
        'ctx': nrm(ks[2], (BATCH, CTX_LEN, D), 1.0),
        'c_ctx': nrm(ks[3], (D,), 1.0),
        'mod_w': nrm(ks[4], (DEPTH, D, 6 * D), 0.5 * D ** -0.5),
        'mod_b': nrm(ks[5], (DEPTH, 6 * D), 0.02),
        'norms': 1.0 + nrm(ks[6], (DEPTH, 4, D), 0.05),
        'ret_w_in': nrm(ks[7], (N_RET_LAYERS, D, RET_IN_DIM), D ** -0.5),
        'ret_w_out': nrm(ks[8], (N_RET_LAYERS, RET_V_TOTAL, D), RET_V_TOTAL ** -0.5),
        'ret_decay': decay_base[None, None, :] + nrm(ks[9], (N_RET_LAYERS, 2, RET_HEADS), 0.1),
        'conv_w1': nrm(ks[10], (N_CONV_LAYERS, D, 2 * D), D ** -0.5),
        'conv_b1': nrm(ks[11], (N_CONV_LAYERS, 2 * D), 0.02),
        'conv_dw': nrm(ks[12], (N_CONV_LAYERS, CONV_WIDTH, D), CONV_WIDTH ** -0.5),
        'conv_b_dw': nrm(ks[13], (N_CONV_LAYERS, D), 0.02),
        'conv_ln_g': 1.0 + nrm(ks[14], (N_CONV_LAYERS, D), 0.05),
        'conv_ln_b': nrm(ks[15], (N_CONV_LAYERS, D), 0.02),
        'conv_w2': nrm(ks[16], (N_CONV_LAYERS, D, D), D ** -0.5),
        'conv_b2': nrm(ks[17], (N_CONV_LAYERS, D), 0.02),
        'moe_router': nrm(ks[18], (DEPTH, D, N_EXPERTS), D ** -0.5),
        'moe_bias': nrm(ks[19], (DEPTH, N_EXPERTS), 0.01),
        'moe_w1': nrm(ks[20], (DEPTH, N_EXPERTS, D, EXPERT_DIM), D ** -0.5),
        'moe_w3': nrm(ks[21], (DEPTH, N_EXPERTS, D, EXPERT_DIM), D ** -0.5),
        'moe_w2': nrm(ks[22], (DEPTH, N_EXPERTS, EXPERT_DIM, D), EXPERT_DIM ** -0.5),
        'shared_w1': nrm(ks[23], (DEPTH, D, SHARED_DIM), D ** -0.5),
        'shared_w3': nrm(ks[24], (DEPTH, D, SHARED_DIM), D ** -0.5),
        'shared_w2': nrm(ks[25], (DEPTH, SHARED_DIM, D), SHARED_DIM ** -0.5),
    }


def reference(x, c, ctx, c_ctx, mod_w, mod_b, norms, ret_w_in, ret_w_out, ret_decay,
              conv_w1, conv_b1, conv_dw, conv_b_dw, conv_ln_g, conv_ln_b, conv_w2, conv_b2,
              moe_router, moe_bias, moe_w1, moe_w3, moe_w2, shared_w1, shared_w3, shared_w2):
    T = x.shape[1]
    L = ctx.shape[1]
    ROWS = T // GRID_W
    rows, cols = jnp.meshgrid(jnp.arange(ROWS, dtype=jnp.int32), jnp.arange(GRID_W, dtype=jnp.int32), indexing='ij')
    pos_lat = jnp.stack([jnp.full((T,), L, jnp.int32), rows.reshape(-1), cols.reshape(-1)], -1)
    zl = jnp.zeros((L,), jnp.int32)
    pos_ctx = jnp.stack([jnp.arange(L, dtype=jnp.int32), zl, zl], -1)
    ang_lat = rope_angles(pos_lat)
    ang_ctx = rope_angles(pos_ctx)
    silu_c = jax.nn.silu(c)
    silu_cc = jax.nn.silu(c_ctx)

    h, hc = x, ctx
    for i in range(DEPTH):
        kind = i % N_MIXERS
        j = i // N_MIXERS
        ctx_after = any((l % N_MIXERS) == 0 for l in range(i + 1, DEPTH))
        mod = (silu_c @ mod_w[i] + mod_b[i])[:, None, :]
        sh_m, sc_m, g_m, sh_f, sc_f, g_f = jnp.split(mod, 6, -1)
        if kind == 0 or ctx_after:
            mod_c = silu_cc @ mod_w[i] + mod_b[i]
            csh_m, csc_m, cg_m, csh_f, csc_f, cg_f = jnp.split(mod_c, 6, -1)
            uc = modulate(rms_norm(hc, norms[i, 0]), csh_m, csc_m)
        u = modulate(rms_norm(h, norms[i, 0]), sh_m, sc_m)
        if kind == 0:
            y, yc = retention_mixer(u, uc, ang_lat, ang_ctx, ret_w_in[j], ret_w_out[j], ret_decay[j], ctx_after)
        else:
            conv_args = (conv_w1[j], conv_b1[j], conv_dw[j], conv_b_dw[j], conv_ln_g[j], conv_ln_b[j],
                         conv_w2[j], conv_b2[j])
            y = conv_module(u, *conv_args)
            yc = conv_module(uc, *conv_args) if ctx_after else None
        h = h + g_m * rms_norm(y, norms[i, 1])
        moe_args = (moe_router[i], moe_bias[i], moe_w1[i], moe_w3[i], moe_w2[i],
                    shared_w1[i], shared_w3[i], shared_w2[i])
        u = modulate(rms_norm(h, norms[i, 2]), sh_f, sc_f)
        h = h + g_f * rms_norm(moe_ffn(u, *moe_args), norms[i, 3])
        if ctx_after:
            hc = hc + cg_m * rms_norm(yc, norms[i, 1])
            uc = modulate(rms_norm(hc, norms[i, 2]), csh_f, csc_f)
            hc = hc + cg_f * rms_norm(moe_ffn(uc, *moe_args), norms[i, 3])
    return h
```

```cpp
#include <hip/hip_runtime.h>
#include <cstdio>
#include <cstdint>

#ifndef MK_ONE_LAUNCH
#define MK_ONE_LAUNCH 0
#endif

#define GAS __attribute__((address_space(1)))
#define LAS __attribute__((address_space(3)))
typedef unsigned short bf16;
typedef unsigned v4u __attribute__((ext_vector_type(4)));
typedef unsigned v2u __attribute__((ext_vector_type(2)));
typedef float f32x4 __attribute__((ext_vector_type(4)));
typedef float f32x2 __attribute__((ext_vector_type(2)));
typedef float f32x16 __attribute__((ext_vector_type(16)));
typedef short bf16x8 __attribute__((ext_vector_type(8)));
typedef short s16x4 __attribute__((ext_vector_type(4)));
typedef GAS unsigned gu32;
#define RLX_AGENT __ATOMIC_RELAXED, __HIP_MEMORY_SCOPE_AGENT
#define LDS_WAIT() asm volatile("s_waitcnt lgkmcnt(0)" ::: "memory")
#define VM_WAIT() asm volatile("s_waitcnt vmcnt(0)" ::: "memory")
#define DI __device__ __forceinline__

constexpr int D = 1024, NB = 8, T = 4096, NTOK = NB * T, LCTX = 256, NCTX = NB * LCTX;
constexpr int NH = 4, DK = 256, DV = 512, VTOT = 2048, RIN = 6144;
constexpr int NE = 64, TOPK = 8, EH = 256;
constexpr int CH = 128, NCHUNK = T / CH;
constexpr int NSLICE = 2, SLTOK = NTOK / NSLICE;
constexpr int ECAP = SLTOK;
constexpr int NEX = NE + 1;
constexpr int ACT_ROUTED = SLTOK * TOPK + NE * 256;
constexpr float NORM_EPS = 1e-6f, LN_EPS = 1e-5f;

DI unsigned cvt_pk_bf16(float lo, float hi) { unsigned r; asm("v_cvt_pk_bf16_f32 %0, %1, %2" : "=v"(r) : "v"(lo), "v"(hi)); return r; }
DI float bf_lo(unsigned u) { return __uint_as_float(u << 16); }
DI float bf_hi(unsigned u) { return __uint_as_float(u & 0xffff0000u); }
DI float bf2f(bf16 b) { return __uint_as_float(((unsigned)b) << 16); }
DI bf16 f2bf(float f) { return (bf16)(cvt_pk_bf16(f, 0.f) & 0xffffu); }
DI float wave_sum(float v) {
#pragma unroll
    for (int o = 1; o < 64; o <<= 1) v += __shfl_xor(v, o);
    return v;
}
DI float sigmoidf_(float x) { return 1.f / (1.f + __expf(-x)); }
DI float siluf_(float x) { return x / (1.f + __expf(-x)); }

namespace pg8 {
constexpr int BM = 256, BK = 64, HALF = 128, HTB = HALF * BK * 2, STAGE_BYTES = 8 * HTB, NXCD = 8, WGM = 8;
DI int lds_byte(int r, int c) { const int st = (r >> 4) * 2 + (c >> 5), rr = r & 15, cc = c & 31, ob = rr * 64 + cc * 2; return st * 1024 + (ob ^ (((ob >> 9) & 1) << 5)); }
DI void stage_rc(int b, int& R, int& C) { const int st = b / 1024, sb = b % 1024, swz = sb ^ (((sb >> 9) & 1) << 5); R = (st >> 1) * 16 + swz / 64; C = (st & 1) * 32 + (swz % 64) / 2; }
DI int perm32(int rho) { const int n = rho >> 4, i = rho & 15; return 8 * (i >> 2) + 4 * n + (i & 3); }

struct Unit { int pm, pn, e0, e1; };
struct Gemm { const bf16* A; const bf16* Bt; int K; };

struct StaticOrder {
    int nM, nN, nwg, G, c;
    DI void init(int M, int N, int G_, int c_) { nM = M / BM; nN = N / BM; nwg = nM * nN; G = G_; c = c_; }
    DI bool next(int i, Unit& u) const {
        const long L = (long)i * G + c; if (L >= nwg) return false;
        int wgid = (int)L; { const int q = nwg / NXCD, r = nwg % NXCD, xcd = wgid % NXCD, off = wgid / NXCD; wgid = (xcd < r ? xcd * (q + 1) : r * (q + 1) + (xcd - r) * q) + off; }
        const int nig = WGM * nN, gid = wgid / nig, fm = gid * WGM, gsz = (nM - fm) < WGM ? (nM - fm) : WGM;
        u.pm = fm + ((wgid % nig) % gsz); u.pn = (wgid % nig) / gsz; u.e0 = 0; u.e1 = 0; return true;
    }
    DI int a_row(const Unit&, int) const { return 0; }
};

template <class Epi, class Sched, bool GATHER>
DI void gemm_phase(LAS unsigned char* lds, const Gemm g, const Sched& S, const Epi& E) {
    const int tid = threadIdx.x, wid = __builtin_amdgcn_readfirstlane(tid >> 6), lane = tid & 63, wr = wid >> 2, wc = wid & 3, fr = lane & 15, fq = lane >> 4;
    const int K = g.K, nt = K / BK;
    unsigned voffB[2], vA[2][2], nvA[2][2]; int Rr[2], Cc[2];
#pragma unroll
    for (int i = 0; i < 2; ++i) { int R, C; stage_rc(tid * 16 + i * 8192, R, C); const int Rb = Epi::PERM ? ((R & ~31) + perm32(R & 31)) : R;
        voffB[i] = (unsigned)(Rb * K + C) * 2u; Rr[i] = R; Cc[i] = C; }
    const size_t kstep = (size_t)(BK * 2);
    const size_t hstep = (size_t)HALF * K * 2;
    const size_t tstep = 2 * hstep;
    const unsigned ldsw = (unsigned)wid * 1024u;
    const int aoff = lds_byte(wr * 64 + fr, fq * 8), boff = lds_byte(wc * 32 + fr, fq * 8);
#define PG8_SETV(u, v) do { _Pragma("unroll") for (int _h = 0; _h < 2; ++_h) _Pragma("unroll") for (int _i = 0; _i < 2; ++_i) \
        (v)[_h][_i] = GATHER ? (unsigned)(S.a_row((u), _h * 128 + Rr[_i]) * K + Cc[_i]) * 2u : (unsigned)((_h * 128 + Rr[_i]) * K + Cc[_i]) * 2u; } while (0)
#define PG8_SA(b, h) (((b) * 2 + (h)) * HTB)
#define PG8_SB(b, h) ((4 + (b) * 2 + (h)) * HTB)
#define PG8_STAGE(bufoff, gbase, voff) do { _Pragma("unroll") for (int _i = 0; _i < 2; ++_i) \
        __builtin_amdgcn_global_load_lds((const unsigned*)((const char*)(gbase) + (voff)[_i]), (LAS unsigned*)(lds + (bufoff) + ldsw + _i * 8192), 16, 0, 0); } while (0)
#define PG8_LDA(dst, b, h) do { _Pragma("unroll") for (int m = 0; m < 4; ++m) _Pragma("unroll") for (int k = 0; k < 2; ++k) dst[m][k] = *(const LAS bf16x8*)(lds + PG8_SA(b, h) + aoff + m * 2048 + k * 1024); } while (0)
#define PG8_LDB(dst, b, h) do { _Pragma("unroll") for (int n = 0; n < 2; ++n) _Pragma("unroll") for (int k = 0; k < 2; ++k) dst[n][k] = *(const LAS bf16x8*)(lds + PG8_SB(b, h) + boff + n * 2048 + k * 1024); } while (0)
#define PG8_MMA(ai, bj, At, Bt) do { __builtin_amdgcn_s_setprio(1); _Pragma("unroll") for (int m = 0; m < 4; ++m) _Pragma("unroll") for (int n = 0; n < 2; ++n) _Pragma("unroll") for (int k = 0; k < 2; ++k) \
        acc[ai][bj][m][n] = __builtin_amdgcn_mfma_f32_16x16x32_bf16(Bt[n][k], At[m][k], acc[ai][bj][m][n], 0, 0, 0); __builtin_amdgcn_s_setprio(0); } while (0)
#define PG8_WAIT_V(n) asm volatile("s_waitcnt vmcnt(" #n ")" ::: "memory")
#define PG8_WAIT_L(n) asm volatile("s_waitcnt lgkmcnt(" #n ")" ::: "memory")
#define PG8_BAR __builtin_amdgcn_s_barrier()
#define PG8_SCHED __builtin_amdgcn_sched_barrier(0)
    Unit cur, nxt; int ui = 0;
    if (!S.next(0, cur)) return;
    f32x4 acc[2][2][4][2];
#pragma unroll
    for (int a = 0; a < 2; ++a)
#pragma unroll
        for (int b = 0; b < 2; ++b)
#pragma unroll
            for (int m = 0; m < 4; ++m)
#pragma unroll
                for (int n = 0; n < 2; ++n) acc[a][b][m][n] = (f32x4){0.f, 0.f, 0.f, 0.f};
    bf16x8 At[4][2], B0[2][2], B1[2][2];
    PG8_SETV(cur, vA);
    const char* cA = GATHER ? (const char*)g.A : (const char*)g.A + (size_t)cur.pm * tstep; const char* cB = (const char*)g.Bt + (size_t)cur.pn * tstep;
    PG8_STAGE(PG8_SB(0, 0), cB, voffB); PG8_STAGE(PG8_SA(0, 0), cA, vA[0]); PG8_STAGE(PG8_SB(0, 1), cB + hstep, voffB); PG8_STAGE(PG8_SA(0, 1), cA, vA[1]);
    if (wr == 1) PG8_BAR;
    PG8_WAIT_V(4); PG8_BAR;
    PG8_STAGE(PG8_SB(1, 0), cB + kstep, voffB); PG8_STAGE(PG8_SA(1, 0), cA + kstep, vA[0]); PG8_STAGE(PG8_SB(1, 1), cB + hstep + kstep, voffB);
    PG8_WAIT_V(6); PG8_BAR;
    for (;;) {
        const bool has_next = S.next(ui + 1, nxt);
        const char* nA = has_next ? (GATHER ? (const char*)g.A : (const char*)g.A + (size_t)nxt.pm * tstep) : cA; const char* nB = has_next ? (const char*)g.Bt + (size_t)nxt.pn * tstep : cB;
        if (GATHER) { if (has_next) { PG8_SETV(nxt, nvA); } else {
#pragma unroll
            for (int h = 0; h < 2; ++h)
#pragma unroll
                for (int i = 0; i < 2; ++i) nvA[h][i] = vA[h][i]; } }
#pragma unroll 1
        for (int t = 0; t < nt; t += 2) {
            const bool last = (t == nt - 2);
            const char* a1 = cA + (size_t)(t + 1) * kstep;
            const char* a2 = last ? nA : cA + (size_t)(t + 2) * kstep; const char* b2 = last ? nB : cB + (size_t)(t + 2) * kstep;
            const char* a3 = a2 + kstep; const char* b3 = b2 + kstep;
            unsigned s2[2][2];
#pragma unroll
            for (int h = 0; h < 2; ++h)
#pragma unroll
                for (int i = 0; i < 2; ++i) s2[h][i] = (GATHER && last) ? nvA[h][i] : vA[h][i];
            PG8_LDB(B0, 0, 0); PG8_SCHED; PG8_LDA(At, 0, 0); PG8_STAGE(PG8_SA(1, 1), a1, vA[1]);
            PG8_WAIT_L(8); PG8_BAR; PG8_WAIT_L(0); PG8_MMA(0, 0, At, B0); PG8_BAR; PG8_SCHED;
            PG8_LDB(B1, 0, 1); PG8_STAGE(PG8_SB(0, 0), b2, voffB);
            PG8_BAR; PG8_WAIT_L(0); PG8_MMA(0, 1, At, B1); PG8_BAR;
            PG8_LDA(At, 0, 1); PG8_STAGE(PG8_SA(0, 0), a2, s2[0]);
            PG8_BAR; PG8_WAIT_L(0); PG8_MMA(1, 0, At, B0); PG8_BAR; PG8_SCHED;
            PG8_STAGE(PG8_SB(0, 1), b2 + hstep, voffB);
            PG8_WAIT_V(6); PG8_BAR; PG8_MMA(1, 1, At, B1); PG8_BAR;
            PG8_LDB(B0, 1, 0); PG8_SCHED; PG8_LDA(At, 1, 0); PG8_STAGE(PG8_SA(0, 1), a2, s2[1]);
            PG8_WAIT_L(8); PG8_BAR; PG8_WAIT_L(0); PG8_MMA(0, 0, At, B0); PG8_BAR; PG8_SCHED;
            PG8_LDB(B1, 1, 1); PG8_STAGE(PG8_SB(1, 0), b3, voffB);
            PG8_BAR; PG8_WAIT_L(0); PG8_MMA(0, 1, At, B1); PG8_BAR;
            PG8_LDA(At, 1, 1); PG8_STAGE(PG8_SA(1, 0), a3, s2[0]);
            PG8_BAR; PG8_WAIT_L(0); PG8_MMA(1, 0, At, B0); PG8_BAR; PG8_SCHED;
            PG8_STAGE(PG8_SB(1, 1), b3 + hstep, voffB);
            PG8_WAIT_V(6); PG8_BAR; PG8_MMA(1, 1, At, B1); PG8_BAR;
        }
        { int tz = threadIdx.x; asm volatile("" : "+v"(tz));
          const int wid2 = __builtin_amdgcn_readfirstlane(tz >> 6), lane2 = tz & 63;
          E(acc, cur, wid2 >> 2, wid2 & 3, lane2 & 15, lane2 >> 4); }
        if (!has_next) break;
#pragma unroll
        for (int a = 0; a < 2; ++a)
#pragma unroll
            for (int b = 0; b < 2; ++b)
#pragma unroll
                for (int m = 0; m < 4; ++m)
#pragma unroll
                    for (int n = 0; n < 2; ++n) acc[a][b][m][n] = (f32x4){0.f, 0.f, 0.f, 0.f};
        cur = nxt; cA = nA; cB = nB; ++ui;
        if (GATHER) {
#pragma unroll
            for (int h = 0; h < 2; ++h)
#pragma unroll
                for (int i = 0; i < 2; ++i) vA[h][i] = nvA[h][i]; }
    }
    PG8_WAIT_V(0);
    if (wr == 0) PG8_BAR;
    PG8_BAR;
#undef PG8_SETV
#undef PG8_SA
#undef PG8_SB
#undef PG8_STAGE
#undef PG8_LDA
#undef PG8_LDB
#undef PG8_MMA
#undef PG8_WAIT_V
#undef PG8_WAIT_L
#undef PG8_BAR
#undef PG8_SCHED
}
}
using pg8::Unit;

constexpr size_t MiB = 1u << 20;
constexpr size_t WS_CTL = 0, CTL_ZERO_BYTES = 2 * MiB;
constexpr size_t WS_MOD = 2 * MiB;
constexpr size_t WS_ROPE = 4 * MiB;
constexpr size_t WS_WIN = 10 * MiB, WS_WOUT = 22 * MiB, WS_CW1 = 26 * MiB, WS_CW2 = 30 * MiB;
constexpr size_t WS_W13 = 32 * MiB, WS_W2 = 97 * MiB;
constexpr size_t WS_LIST = 130 * MiB;
constexpr size_t LIST_ARR = (size_t)NEX * ECAP * 4, LIST_SLICE = 3 * LIST_ARR;
constexpr size_t WS_BIG = 160 * MiB;
constexpr size_t WS_Q = WS_BIG, WS_K = WS_Q + 64 * MiB, WS_V = WS_K + 64 * MiB, WS_G = WS_V + 128 * MiB;
constexpr size_t WS_KC = 544 * MiB, WS_VC = 548 * MiB, WS_P = 560 * MiB;
constexpr size_t WS_Y = WS_BIG;
constexpr size_t WS_U = WS_BIG;
constexpr size_t WS_ACT = WS_BIG + 64 * MiB;
constexpr size_t WS_Y2 = WS_BIG + 144 * MiB;
constexpr size_t WS_Z = WS_BIG + 64 * MiB, WS_C = WS_BIG + 128 * MiB, WS_Y1 = WS_BIG + 192 * MiB;
constexpr size_t WS_END = 592 * MiB;
static_assert(WS_LIST + NSLICE * LIST_SLICE <= WS_BIG, "lists");
static_assert(WS_ACT + (size_t)(ACT_ROUTED + SLTOK) * 512 <= WS_Y2, "act");
static_assert(WS_Y2 + (size_t)SLTOK * 9 * 1024 * 2 <= WS_END, "y2");
static_assert(WS_W13 + (size_t)NEX * 512 * 1024 * 2 <= WS_W2 && WS_W2 + (size_t)NEX * 1024 * 256 * 2 <= WS_LIST, "moe w");
constexpr int CW_TMO = 0, CW_CODE = 1;
constexpr int CW_BAR = 4096;
constexpr int CW_CNT = 16384;
DI int cnt_word(int layer, int slice, int e) { return CW_CNT + ((layer * NSLICE + slice) * NE + e) * 16; }

constexpr int RING_OFF = 0, RING_BYTES = 131072;
constexpr int LDSCTL_OFF = 148480, MISC_OFF = LDSCTL_OFF + 1024;
constexpr int LDS_BYTES = 151552;

#define XB_TMO      128
#define XB_XCNT(j)  (256  + 64 * (j))
#define XB_XSUB(j)  (1280 + 64 * (j))
#define XB_XGEN(j)  (2304 + 64 * (j))
#define XB_TOP      3328
#define XB_TOPGEN   3392
#define XCD_BAR_WORDS 3456
#define XB_SPIN_CAP (1u << 18)
DI unsigned xb_ld(unsigned* p)              { return __hip_atomic_load(p, __ATOMIC_RELAXED, __HIP_MEMORY_SCOPE_AGENT); }
DI unsigned xb_add(unsigned* p, unsigned v) { return __hip_atomic_fetch_add(p, v, __ATOMIC_RELAXED, __HIP_MEMORY_SCOPE_AGENT); }
DI unsigned xb_xcc_id() { return (unsigned)__builtin_amdgcn_s_getreg((3 << 11) | 20) & 0xFu; }
#define XB_SPIN(cond, bar) do { unsigned _sp = 0; while (cond) { __builtin_amdgcn_s_sleep(1); \
    if ((++_sp & 255u) == 0u) { if (xb_ld(&(bar)[XB_TMO])) break; if (_sp > XB_SPIN_CAP) { atomicAdd(&(bar)[XB_TMO], 1u); break; } } } } while (0)
struct XcdBarrier { unsigned* bar; unsigned x; volatile LAS unsigned* st; };
DI XcdBarrier xcd_barrier_post(unsigned* bar, volatile LAS unsigned* st) {
    XcdBarrier b; b.bar = bar; b.x = xb_xcc_id(); b.st = st;
    if (threadIdx.x == 0) (void)xb_add(&bar[XB_XCNT(b.x)], 1u);
    return b;
}
DI void xcd_barrier_complete(unsigned* bar, unsigned x, unsigned& nloc, unsigned& nx) {
    const unsigned G = gridDim.x * gridDim.y * gridDim.z;
    unsigned sum, cnt, mine, sp = 0u;
    for (;;) {
        sum = 0u; cnt = 0u; mine = 0u;
#pragma unroll
        for (unsigned j = 0; j < 16; ++j) { const unsigned c = xb_ld(&bar[XB_XCNT(j)]); sum += c; cnt += (c > 0u) ? 1u : 0u; mine = (j == x) ? c : mine; }
        if (sum == G) break;
        __builtin_amdgcn_s_sleep(1);
        if ((++sp & 255u) == 0u) { if (xb_ld(&bar[XB_TMO])) break; if (sp > XB_SPIN_CAP) { atomicAdd(&bar[XB_TMO], 1u); break; } }
    }
    nloc = mine > 0u ? mine : 1u; nx = cnt > 0u ? cnt : 1u;
}
DI void xcd_barrier(const XcdBarrier& b) {
    asm volatile("s_waitcnt vmcnt(0)" ::: "memory");
    __syncthreads();
    if (threadIdx.x == 0) {
        unsigned* bar = b.bar;
        __builtin_amdgcn_s_waitcnt(0);
        unsigned nloc = b.st[0], nx = b.st[1];
        if (nloc == 0u) { xcd_barrier_complete(bar, b.x, nloc, nx); b.st[0] = nloc; b.st[1] = nx; }
        const unsigned old = xb_add(&bar[XB_XSUB(b.x)], 1u);
        const unsigned gen = old / nloc;
        if (old + 1u == (gen + 1u) * nloc) {
            __builtin_amdgcn_fence(__ATOMIC_RELEASE, "agent");
            asm volatile("s_waitcnt vmcnt(0)" ::: "memory");
            const unsigned og = xb_add(&bar[XB_TOP], 1u);
            const unsigned tg = og / nx;
            if (og + 1u == (tg + 1u) * nx) xb_add(&bar[XB_TOPGEN], 1u);
            else XB_SPIN(xb_ld(&bar[XB_TOPGEN]) == tg, bar);
            __builtin_amdgcn_fence(__ATOMIC_ACQUIRE, "agent");
            xb_add(&bar[XB_XGEN(b.x)], 1u);
            asm volatile("s_waitcnt vmcnt(0)" ::: "memory");
        } else {
            XB_SPIN(xb_ld(&bar[XB_XGEN(b.x)]) == gen, bar);
            __builtin_amdgcn_fence(__ATOMIC_ACQUIRE, "agent");
            asm volatile("s_waitcnt vmcnt(0)" ::: "memory");
        }
    }
    __syncthreads();
}

struct Frame {
    LAS unsigned char* lds;
    volatile LAS unsigned* MISC;
    unsigned* ctl;
    unsigned char* ws;
    int tid, lane, wave, vcu, G;
    float* out;
};
enum { I_X = 0, I_C, I_CTX, I_CCTX, I_MODW, I_MODB, I_NORMS, I_RWIN, I_RWOUT, I_RDECAY, I_CW1, I_CB1, I_CDW, I_CBDW, I_CLNG, I_CLNB, I_CW2, I_CB2,
       I_ROUTER, I_MBIAS, I_MW1, I_MW3, I_MW2, I_SW1, I_SW3, I_SW2 };

typedef const f32x4 (&AccRef)[2][2][4][2];
DI void st16(bf16* p, unsigned a, unsigned b, unsigned c, unsigned d) { v4u o; o.x = a; o.y = b; o.z = c; o.w = d; *(GAS v4u*)p = o; }

struct EpiQKVG {
    static constexpr bool PERM = true;
    unsigned char* ws;
    DI void operator()(AccRef acc, const Unit& u, int wr, int wc, int fr, int fq) const {
        const bool ctx = u.pm >= 128;
        const int rbase = u.pm * 256 + wr * 64 + fr, cw = wc * 32 + 8 * fq, pn = u.pn;
        if (pn < 8) {
            const bool isq = pn < 4; const int head = pn & 3;
            const size_t doff = ctx ? WS_KC : (isq ? WS_Q : WS_K);
            bf16* dst = (bf16*)(ws + doff);
            const float* cs = (const float*)(ws + WS_ROPE) + (ctx ? 2 * T * 128 : 0);
            const int snoff = ctx ? LCTX * 128 : T * 128;
            const float sc = isq ? 0.0625f : 1.f;
#pragma unroll
            for (int ai = 0; ai < 2; ++ai)
#pragma unroll
                for (int m = 0; m < 4; ++m) {
                    const int row = rbase + ai * 128 + m * 16, rr = ctx ? row - NTOK : row, t = ctx ? (rr & (LCTX - 1)) : (row & (T - 1));
#pragma unroll
                    for (int bj = 0; bj < 2; ++bj) {
                        const int p0 = bj * 64 + wc * 16 + 4 * fq;
                        const f32x4 c = *(const GAS f32x4*)(cs + (size_t)t * 128 + p0), s = *(const GAS f32x4*)(cs + snoff + (size_t)t * 128 + p0);
                        const f32x4 v0 = acc[ai][bj][m][0], v1 = acc[ai][bj][m][1];
                        const float o0 = (v0[0] * c[0] - v0[1] * s[0]) * sc, o1 = (v0[0] * s[0] + v0[1] * c[0]) * sc;
                        const float o2 = (v0[2] * c[1] - v0[3] * s[1]) * sc, o3 = (v0[2] * s[1] + v0[3] * c[1]) * sc;
                        const float o4 = (v1[0] * c[2] - v1[1] * s[2]) * sc, o5 = (v1[0] * s[2] + v1[1] * c[2]) * sc;
                        const float o6 = (v1[2] * c[3] - v1[3] * s[3]) * sc, o7 = (v1[2] * s[3] + v1[3] * c[3]) * sc;
                        st16(dst + (size_t)rr * 1024 + head * 256 + bj * 128 + cw, cvt_pk_bf16(o0, o1), cvt_pk_bf16(o2, o3), cvt_pk_bf16(o4, o5), cvt_pk_bf16(o6, o7));
                    }
                }
        } else {
            const bool isg = pn >= 16; const int ct = (pn - (isg ? 16 : 8)) * 256;
            const size_t doff = isg ? WS_G : (ctx ? WS_VC : WS_V);
            bf16* dst = (bf16*)(ws + doff);
#pragma unroll
            for (int ai = 0; ai < 2; ++ai)
#pragma unroll
                for (int m = 0; m < 4; ++m) {
                    const int row = rbase + ai * 128 + m * 16, rr = ctx ? row - NTOK : row;
#pragma unroll
                    for (int bj = 0; bj < 2; ++bj) {
                        f32x4 v0 = acc[ai][bj][m][0], v1 = acc[ai][bj][m][1];
                        if (isg) {
#pragma unroll
                            for (int e = 0; e < 4; ++e) { v0[e] = siluf_(v0[e]); v1[e] = siluf_(v1[e]); }
                        }
                        st16(dst + (size_t)rr * 2048 + ct + bj * 128 + cw, cvt_pk_bf16(v0[0], v0[1]), cvt_pk_bf16(v0[2], v0[3]), cvt_pk_bf16(v1[0], v1[1]), cvt_pk_bf16(v1[2], v1[3]));
                    }
                }
        }
    }
};
struct InprojOrder {
    pg8::StaticOrder so; int G, c;
    DI void init(int G_, int c_) { so.init(NTOK, RIN, G_, c_); G = G_; c = c_; }
    DI bool next(int i, Unit& u) const {
        const int L = i * G + c;
        if (L < 3072) return so.next(i, u);
        const int l2 = L - 3072; if (l2 >= 96) return false;
        u.pm = 128 + l2 / 12; u.pn = 4 + l2 % 12; u.e0 = 0; u.e1 = 0; return true;
    }
    DI int a_row(const Unit&, int) const { return 0; }
};
struct EpiBf16 {
    static constexpr bool PERM = true;
    bf16* O; int ldc; const float* bias;
    DI void operator()(AccRef acc, const Unit& u, int wr, int wc, int fr, int fq) const {
        const int rbase = u.pm * 256 + wr * 64 + fr, cbase = u.pn * 256 + wc * 32 + 8 * fq;
#pragma unroll
        for (int bj = 0; bj < 2; ++bj) {
            f32x4 b0 = (f32x4){0.f, 0.f, 0.f, 0.f}, b1 = b0;
            if (bias) { b0 = *(const GAS f32x4*)(bias + cbase + bj * 128); b1 = *(const GAS f32x4*)(bias + cbase + bj * 128 + 4); }
#pragma unroll
            for (int ai = 0; ai < 2; ++ai)
#pragma unroll
                for (int m = 0; m < 4; ++m) {
                    const f32x4 v0 = acc[ai][bj][m][0] + b0, v1 = acc[ai][bj][m][1] + b1;
                    st16(O + (size_t)(rbase + ai * 128 + m * 16) * ldc + cbase + bj * 128, cvt_pk_bf16(v0[0], v0[1]), cvt_pk_bf16(v0[2], v0[3]), cvt_pk_bf16(v1[0], v1[1]), cvt_pk_bf16(v1[2], v1[3]));
                }
        }
    }
};
struct EpiGLU {
    static constexpr bool PERM = true;
    bf16* Z; const float* b1;
    DI void operator()(AccRef acc, const Unit& u, int wr, int wc, int fr, int fq) const {
        const int rbase = u.pm * 256 + wr * 64 + fr, cc = u.pn * 128 + wc * 32 + 8 * fq;
        const f32x4 ba0 = *(const GAS f32x4*)(b1 + cc), ba1 = *(const GAS f32x4*)(b1 + cc + 4), bg0 = *(const GAS f32x4*)(b1 + 1024 + cc), bg1 = *(const GAS f32x4*)(b1 + 1024 + cc + 4);
#pragma unroll
        for (int ai = 0; ai < 2; ++ai)
#pragma unroll
            for (int m = 0; m < 4; ++m) {
                const f32x4 a0 = acc[ai][0][m][0] + ba0, a1 = acc[ai][0][m][1] + ba1, g0 = acc[ai][1][m][0] + bg0, g1 = acc[ai][1][m][1] + bg1;
                f32x4 o0, o1;
#pragma unroll
                for (int e = 0; e < 4; ++e) { o0[e] = a0[e] * sigmoidf_(g0[e]); o1[e] = a1[e] * sigmoidf_(g1[e]); }
                st16(Z + (size_t)(rbase + ai * 128 + m * 16) * 1024 + cc, cvt_pk_bf16(o0[0], o0[1]), cvt_pk_bf16(o0[2], o0[3]), cvt_pk_bf16(o1[0], o1[1]), cvt_pk_bf16(o1[2], o1[3]));
            }
    }
};
struct MoeOrder {
    const LAS int* cum; const LAS int* cnt; const int* ltok; int npn, G, c, total;
    DI bool next(int i, Unit& u) const {
        const int L = i * G + c; if (L >= total) return false;
        const int blk = L / npn, sub = L - blk * npn;
        int e = 0;
#pragma unroll 1
        while (e < NEX - 1 && cum[e + 1] <= blk) ++e;
        const int bi = blk - cum[e];
        u.pm = blk; u.pn = e * npn + sub; u.e0 = e * ECAP + bi * 256; const int left = cnt[e] - bi * 256; u.e1 = left < 256 ? left : 256; return true;
    }
    DI int a_row(const Unit& u, int r) const { return r < u.e1 ? ltok[u.e0 + r] : 0; }
};
struct EpiSwiGLU {
    static constexpr bool PERM = true;
    bf16* ACT;
    DI void operator()(AccRef acc, const Unit& u, int wr, int wc, int fr, int fq) const {
        const int rbase = u.pm * 256 + wr * 64 + fr, cc = (u.pn & 1) * 128 + wc * 32 + 8 * fq;
#pragma unroll
        for (int ai = 0; ai < 2; ++ai)
#pragma unroll
            for (int m = 0; m < 4; ++m) {
                const f32x4 a0 = acc[ai][0][m][0], a1 = acc[ai][0][m][1], g0 = acc[ai][1][m][0], g1 = acc[ai][1][m][1];
                f32x4 o0, o1;
#pragma unroll
                for (int e = 0; e < 4; ++e) { o0[e] = siluf_(a0[e]) * g0[e]; o1[e] = siluf_(a1[e]) * g1[e]; }
                st16(ACT + (size_t)(rbase + ai * 128 + m * 16) * 256 + cc, cvt_pk_bf16(o0[0], o0[1]), cvt_pk_bf16(o0[2], o0[3]), cvt_pk_bf16(o1[0], o1[1]), cvt_pk_bf16(o1[2], o1[3]));
            }
    }
};
struct EpiMoeOut {
    static constexpr bool PERM = true;
    bf16* Y2; const int* ldst; const float* lw;
    DI void operator()(AccRef acc, const Unit& u, int wr, int wc, int fr, int fq) const {
        const int cc = (u.pn & 3) * 256 + wc * 32 + 8 * fq;
#pragma unroll
        for (int ai = 0; ai < 2; ++ai)
#pragma unroll
            for (int m = 0; m < 4; ++m) {
                const int r = ai * 128 + wr * 64 + m * 16 + fr;
                asm volatile("" ::: "memory");
                if (r < u.e1) {
                    const int dst = ldst[u.e0 + r]; const float w = lw[u.e0 + r];
#pragma unroll
                    for (int bj = 0; bj < 2; ++bj) {
                        const f32x4 v0 = acc[ai][bj][m][0] * w, v1 = acc[ai][bj][m][1] * w;
                        st16(Y2 + (size_t)dst * 1024 + cc + bj * 128, cvt_pk_bf16(v0[0], v0[1]), cvt_pk_bf16(v0[2], v0[3]), cvt_pk_bf16(v1[0], v1[1]), cvt_pk_bf16(v1[2], v1[3]));
                    }
                }
            }
    }
};

DI void tr_item(const float* src, int ldsrc, int k0, int scol0, bf16* dst, int Kd, int drow0, LAS float* scr, int lane) {
#pragma unroll 8
    for (int i = 0; i < 32; ++i) { const int kk = 2 * i + (lane >> 5); scr[kk * 33 + (lane & 31)] = src[(size_t)(k0 + kk) * ldsrc + scol0 + (lane & 31)]; }
    LDS_WAIT(); asm volatile("" ::: "memory");
    const int c = lane & 7;
#pragma unroll
    for (int j = 0; j < 4; ++j) { const int n = (lane >> 3) + 8 * j; const LAS float* s = scr + (8 * c) * 33 + n;
        v4u o; o.x = cvt_pk_bf16(s[0 * 33], s[1 * 33]); o.y = cvt_pk_bf16(s[2 * 33], s[3 * 33]); o.z = cvt_pk_bf16(s[4 * 33], s[5 * 33]); o.w = cvt_pk_bf16(s[6 * 33], s[7 * 33]);
        *(GAS v4u*)(dst + (size_t)(drow0 + n) * Kd + k0 + 8 * c) = o; }
    LDS_WAIT(); asm volatile("" ::: "memory");
}
DI void conv_moe_weights(Frame& F, int layer, const float* mw1, const float* mw3, const float* mw2, const float* sw1, const float* sw3, const float* sw2) {
    LAS float* scr = (LAS float*)(F.lds + RING_OFF + F.wave * 16384);
    const int gw = F.vcu * 8 + F.wave, NGW = F.G * 8;
    bf16* W13 = (bf16*)(F.ws + WS_W13); bf16* W2 = (bf16*)(F.ws + WS_W2);
    constexpr int I13 = 16 * 16, I2 = 4 * 32, PER = I13 + I2;
    for (int it = gw; it < NEX * PER; it += NGW) {
        const int e = it / PER, r = it - e * PER;
        if (r < I13) {
            const int kb = r >> 4, nb = r & 15;
            const float* s1 = e < NE ? mw1 + ((size_t)(layer * NE + e) << 18) : sw1 + ((size_t)layer << 18);
            const float* s3 = e < NE ? mw3 + ((size_t)(layer * NE + e) << 18) : sw3 + ((size_t)layer << 18);
            const float* src = (nb & 7) < 4 ? s1 : s3;
            tr_item(src, 256, kb * 64, 128 * (nb >> 3) + 32 * (nb & 3), W13, 1024, e * 512 + nb * 32, scr, F.lane);
        } else {
            const int r2 = r - I13, kb = r2 >> 5, nb = r2 & 31;
            const float* src = e < NE ? mw2 + ((size_t)(layer * NE + e) << 18) : sw2 + ((size_t)layer << 18);
            tr_item(src, 1024, kb * 64, nb * 32, W2, 256, e * 1024 + nb * 32, scr, F.lane);
        }
    }
}
DI void conv_small_weights(Frame& F, const float* rwin, const float* rwout, const float* cw1, const float* cw2) {
    LAS float* scr = (LAS float*)(F.lds + RING_OFF + F.wave * 16384);
    const int gw = F.vcu * 8 + F.wave, NGW = F.G * 8;
    constexpr int I_IN = 16 * 192, I_OUT = 32 * 32, I_C1 = 16 * 64, I_C2 = 16 * 32, TOT = I_IN + I_OUT + I_C1 + I_C2;
    for (int it = gw; it < TOT; it += NGW) {
        int r = it;
        if (r < I_IN) { const int kb = r / 192, nb = r % 192; tr_item(rwin, RIN, kb * 64, nb * 32, (bf16*)(F.ws + WS_WIN), 1024, nb * 32, scr, F.lane); continue; } r -= I_IN;
        if (r < I_OUT) { const int kb = r >> 5, nb = r & 31; tr_item(rwout, 1024, kb * 64, nb * 32, (bf16*)(F.ws + WS_WOUT), 2048, nb * 32, scr, F.lane); continue; } r -= I_OUT;
        if (r < I_C1) { const int kb = r >> 6, nb = r & 63; const int sc0 = ((nb & 7) < 4 ? 0 : 1024) + 128 * (nb >> 3) + 32 * (nb & 3);
            tr_item(cw1, 2048, kb * 64, sc0, (bf16*)(F.ws + WS_CW1), 1024, nb * 32, scr, F.lane); continue; } r -= I_C1;
        { const int kb = r >> 5, nb = r & 31; tr_item(cw2, 1024, kb * 64, nb * 32, (bf16*)(F.ws + WS_CW2), 1024, nb * 32, scr, F.lane); }
    }
}
DI void rope_tables(Frame& F) {
    float* csL = (float*)(F.ws + WS_ROPE); float* snL = csL + T * 128; float* csC = snL + T * 128; float* snC = csC + LCTX * 128;
    const int gt = F.vcu * 512 + F.tid, NT = F.G * 512;
    for (int i = gt; i < (T + LCTX) * 128; i += NT) {
        const int t = i >> 7, p = i & 127;
        int ax, ii, dd; if (p < 32) { ax = 0; ii = p; dd = 64; } else if (p < 80) { ax = 1; ii = p - 32; dd = 96; } else { ax = 2; ii = p - 80; dd = 96; }
        const float inv = exp2f(-13.287712379549449f * (float)(2 * ii) / (float)dd);
        int pos;
        if (t < T) pos = ax == 0 ? LCTX : (ax == 1 ? (t >> 6) : (t & 63)); else pos = ax == 0 ? (t - T) : 0;
        const float ang = (float)pos * inv;
        const float rev = ang * 0.15915494309189535f;
        const float fr = rev - floorf(rev);
        const float s = __builtin_amdgcn_sinf(fr), c = __builtin_amdgcn_cosf(fr);
        if (t < T) { csL[i] = c; snL[i] = s; } else { csC[i - T * 128] = c; snC[i - T * 128] = s; }
    }
}
DI void mod_vectors(Frame& F, const float* cin, const float* cctx, const float* modw, const float* modb) {
    LAS float* sl = (LAS float*)(F.lds + RING_OFF);
    LAS float* red = sl + 9 * 1024;
    if (F.vcu >= 192) return;
    for (int i = F.tid; i < 9 * 1024; i += 512) { const float v = i < 8192 ? cin[i] : cctx[i - 8192]; sl[i] = siluf_(v); }
    __syncthreads();
    float* MOD = (float*)(F.ws + WS_MOD);
    for (int it = F.vcu; it < 192; it += F.G) {
        const int l = it / 96, cb = (it % 96) * 64;
        const float* w = modw + (size_t)l * 1024 * 6144 + cb + F.lane;
        float a[9];
#pragma unroll
        for (int b = 0; b < 9; ++b) a[b] = 0.f;
        const int k0 = F.wave * 128;
#pragma unroll 8
        for (int k = 0; k < 128; ++k) { const float wv = w[(size_t)(k0 + k) * 6144];
#pragma unroll
            for (int b = 0; b < 9; ++b) a[b] += sl[b * 1024 + k0 + k] * wv; }
#pragma unroll
        for (int b = 0; b < 9; ++b) red[(F.wave * 9 + b) * 64 + F.lane] = a[b];
        __syncthreads();
        for (int o = F.tid; o < 9 * 64; o += 512) { const int b = o >> 6, c = o & 63; float s = modb[l * 6144 + cb + c];
#pragma unroll
            for (int w8 = 0; w8 < 8; ++w8) s += red[(w8 * 9 + b) * 64 + c];
            MOD[(size_t)(l * 9 + b) * 6144 + cb + c] = s; }
        __syncthreads();
    }
}

DI void ld_row_f32(const float* p, int lane, float (&v)[16]) {
#pragma unroll
    for (int j = 0; j < 2; ++j) { const f32x4 a = *(const GAS f32x4*)(p + 512 * j + 8 * lane), b = *(const GAS f32x4*)(p + 512 * j + 8 * lane + 4);
#pragma unroll
        for (int e = 0; e < 4; ++e) { v[8 * j + e] = a[e]; v[8 * j + 4 + e] = b[e]; } }
}
DI void st_row_f32(float* p, int lane, const float (&v)[16]) {
#pragma unroll
    for (int j = 0; j < 2; ++j) { *(GAS f32x4*)(p + 512 * j + 8 * lane) = (f32x4){v[8 * j], v[8 * j + 1], v[8 * j + 2], v[8 * j + 3]}; *(GAS f32x4*)(p + 512 * j + 8 * lane + 4) = (f32x4){v[8 * j + 4], v[8 * j + 5], v[8 * j + 6], v[8 * j + 7]}; }
}
DI void ld_row_bf16(const bf16* p, int lane, float (&v)[16]) {
#pragma unroll
    for (int j = 0; j < 2; ++j) { const v4u a = *(const GAS v4u*)(p + 512 * j + 8 * lane);
        v[8 * j + 0] = bf_lo(a.x); v[8 * j + 1] = bf_hi(a.x); v[8 * j + 2] = bf_lo(a.y); v[8 * j + 3] = bf_hi(a.y); v[8 * j + 4] = bf_lo(a.z); v[8 * j + 5] = bf_hi(a.z); v[8 * j + 6] = bf_lo(a.w); v[8 * j + 7] = bf_hi(a.w); }
}
DI void st_row_bf16(bf16* p, int lane, const float (&v)[16]) {
#pragma unroll
    for (int j = 0; j < 2; ++j) st16(p + 512 * j + 8 * lane, cvt_pk_bf16(v[8 * j], v[8 * j + 1]), cvt_pk_bf16(v[8 * j + 2], v[8 * j + 3]), cvt_pk_bf16(v[8 * j + 4], v[8 * j + 5]), cvt_pk_bf16(v[8 * j + 6], v[8 * j + 7]));
}
DI float row_sumsq(const float (&v)[16]) { float s = 0.f;
#pragma unroll
    for (int i = 0; i < 16; ++i) s += v[i] * v[i];
    return wave_sum(s); }
DI void norm_mod(const float (&x)[16], float rstd, const float* nw, const float* sh, const float* sc, int lane, float (&u)[16]) {
    float g[16], a[16], b[16]; ld_row_f32(nw, lane, g); ld_row_f32(sh, lane, a); ld_row_f32(sc, lane, b);
#pragma unroll
    for (int i = 0; i < 16; ++i) u[i] = x[i] * rstd * g[i] * (1.f + b[i]) + a[i];
}
DI void u_rows_layer0(Frame& F, bf16* U, const float* xin, const float* ctxin, const float* norms) {
    const int gw = F.vcu * 8 + F.wave, NGW = F.G * 8;
    const float* MOD = (const float*)(F.ws + WS_MOD);
    for (int m = gw; m < NTOK + NCTX; m += NGW) {
        const bool lat = m < NTOK; const float* src = lat ? xin + (size_t)m * D : ctxin + (size_t)(m - NTOK) * D;
        const int b = lat ? m / T : 8;
        float x[16], u[16]; ld_row_f32(src, F.lane, x);
        const float rstd = rsqrtf(row_sumsq(x) * (1.f / D) + NORM_EPS);
        const float* mb = MOD + (size_t)b * 6144;
        norm_mod(x, rstd, norms, mb, mb + 1024, F.lane, u);
        st_row_bf16(U + (size_t)m * D, F.lane, u);
    }
}

#define MFMA32(a, b, c) __builtin_amdgcn_mfma_f32_32x32x16_bf16((a), (b), (c), 0, 0, 0)
DI int crow(int reg, int h5) { return (reg & 3) + 8 * (reg >> 2) + 4 * h5; }
DI float log2_gamma(const float* decay, int dir, int head) { const float x = decay[dir * NH + head]; return -log2f(1.f + expf(-x)); }

DI void retention_scores(Frame& F, const float* decay) {
    const bf16* Q = (const bf16*)(F.ws + WS_Q); const bf16* K = (const bf16*)(F.ws + WS_K); bf16* P = (bf16*)(F.ws + WS_P);
    const int lane = F.lane, r = lane & 31, h5 = lane >> 5;
    for (int unit = F.vcu; unit < NB * NH * NCHUNK; unit += F.G) {
        const int bh = unit >> 5, c = unit & 31, b = bh >> 2, head = bh & 3;
        const float lf = log2_gamma(decay, 0, head), lb = log2_gamma(decay, 1, head);
        const size_t row0 = (size_t)b * T + c * CH;
        bf16* Pt = P + (size_t)unit * CH * CH;
#pragma unroll
        for (int tt = 0; tt < 2; ++tt) {
            const int tile = F.wave * 2 + tt, jt = tile >> 2, it = tile & 3;
            const bf16* kp = K + (row0 + 32 * jt + r) * 1024 + head * 256 + 8 * h5;
            const bf16* qp = Q + (row0 + 32 * it + r) * 1024 + head * 256 + 8 * h5;
            f32x16 acc;
#pragma unroll
            for (int i = 0; i < 16; ++i) acc[i] = 0.f;
#pragma unroll
            for (int s = 0; s < 16; ++s) { const bf16x8 a = *(const GAS bf16x8*)(kp + 16 * s), bq = *(const GAS bf16x8*)(qp + 16 * s); acc = MFMA32(a, bq, acc); }
            const int i = 32 * it + r;
#pragma unroll
            for (int g = 0; g < 4; ++g) {
                float o[4];
#pragma unroll
                for (int e = 0; e < 4; ++e) { const int j = 32 * jt + 8 * g + 4 * h5 + e; const int dd = i - j;
                    const float w = dd > 0 ? exp2f(lf * (float)dd) : (dd < 0 ? exp2f(lb * (float)(-dd)) : 2.f);
                    o[e] = acc[4 * g + e] * w; }
                v2u pk; pk.x = cvt_pk_bf16(o[0], o[1]); pk.y = cvt_pk_bf16(o[2], o[3]);
                *(GAS v2u*)(Pt + (size_t)i * CH + 32 * jt + 8 * g + 4 * h5) = pk;
            }
        }
    }
}

constexpr int KSLAB = 0, VPITCH = 192, SPITCH = 528;
constexpr int VIMG = 65536, VSIMG = VIMG + 128 * VPITCH, SIMG = VSIMG + 128 * VPITCH, SCAN_LDS_END = SIMG + 64 * SPITCH;
static_assert(SCAN_LDS_END <= LDSCTL_OFF, "scan LDS");
typedef LAS s16x4 lds_s16x4;
DI const LAS unsigned char* tr_lane_base(const LAS unsigned char* img, int pitch, int lane) {
    const int h5 = lane >> 5, blk = (lane >> 4) & 1, q = (lane & 15) >> 2, p = lane & 3;
    return img + (8 * h5 + q) * pitch + (16 * blk + 4 * p) * 2;
}
DI bf16x8 tr_frag(const LAS unsigned char* lane_base, int off, int pitch) {
    const s16x4 lo = __builtin_amdgcn_ds_read_tr16_b64_v4i16((lds_s16x4*)(lane_base + off));
    const s16x4 hi = __builtin_amdgcn_ds_read_tr16_b64_v4i16((lds_s16x4*)(lane_base + off + 4 * pitch));
    return __builtin_shufflevector(lo, hi, 0, 1, 2, 3, 4, 5, 6, 7);
}
#define WG_BAR() do { asm volatile("s_waitcnt lgkmcnt(0)" ::: "memory"); __builtin_amdgcn_s_barrier(); asm volatile("" ::: "memory"); } while (0)
DI void retention_scan(Frame& F, bf16* Opart, bf16* O, const float* decay) {
    const bf16* Qg = (const bf16*)(F.ws + WS_Q); const bf16* Kg = (const bf16*)(F.ws + WS_K); const bf16* Vg = (const bf16*)(F.ws + WS_V);
    const bf16* KCg = (const bf16*)(F.ws + WS_KC); const bf16* VCg = (const bf16*)(F.ws + WS_VC); const bf16* Pg = (const bf16*)(F.ws + WS_P);
    const int lane = F.lane, r = lane & 31, h5 = lane >> 5, w = F.wave, tid = F.tid;
    const int it = w >> 1, et = w & 1;
    const LAS unsigned char* trK = tr_lane_base(F.lds + KSLAB + w * 8192, 64, lane);
    const LAS unsigned char* trV = tr_lane_base(F.lds + VIMG, VPITCH, lane);
    const LAS unsigned char* trVS = tr_lane_base(F.lds + VSIMG, VPITCH, lane);
    for (int unit = F.vcu; unit < NB * NH * 8; unit += F.G) {
        const int bh = unit >> 3, eb = unit & 7, b = bh >> 2, head = bh & 3;
        const int vcol = head * DV + eb * 64;
#pragma unroll 1
        for (int pass = 0; pass < 2; ++pass) {
            const bool fwd = pass == 1;
            const float l2g = log2_gamma(decay, fwd ? 0 : 1, head);
            const float gC = exp2f(l2g * (float)CH);
            f32x16 accS[2];
#pragma unroll
            for (int i = 0; i < 16; ++i) { accS[0][i] = 0.f; accS[1][i] = 0.f; }
            v4u vreg[2];
#define SCAN_SRC(s, kp, vp) do { if ((s) < 2) { const int cc = fwd ? (s) : 1 - (s); kp = KCg + ((size_t)b * LCTX + cc * CH) * 1024 + head * DK; vp = VCg + ((size_t)b * LCTX + cc * CH) * 2048 + vcol; } \
                else { const int cc = fwd ? (s) - 2 : 33 - (s); kp = Kg + ((size_t)b * T + cc * CH) * 1024 + head * DK; vp = Vg + ((size_t)b * T + cc * CH) * 2048 + vcol; } } while (0)
#define SCAN_LOADV(s) do { const bf16* kp_; const bf16* vp_; SCAN_SRC(s, kp_, vp_); (void)kp_; \
                _Pragma("unroll") for (int i = 0; i < 2; ++i) vreg[i] = *(const GAS v4u*)(vp_ + (size_t)((tid >> 3) + 64 * i) * 2048 + (tid & 7) * 8); } while (0)
#define SCAN_DMAK(s) do { const bf16* kp_; const bf16* vp_; SCAN_SRC(s, kp_, vp_); (void)vp_; \
                _Pragma("unroll") for (int i = 0; i < 8; ++i) __builtin_amdgcn_global_load_lds((const unsigned*)(kp_ + (size_t)(16 * i + (lane >> 2)) * 1024 + w * 32 + (lane & 3) * 8), \
                    (LAS unsigned*)(F.lds + KSLAB + w * 8192 + i * 1024), 16, 0, 0); } while (0)
            SCAN_LOADV(0); SCAN_DMAK(0);
#pragma unroll 1
            for (int s = 0; s < 34; ++s) {
#pragma unroll
                for (int i = 0; i < 2; ++i) {
                    const int row = (tid >> 3) + 64 * i;
                    const float dec = exp2f(l2g * (float)(fwd ? (CH - 1 - row) : row));
                    const v4u x = vreg[i]; v4u o;
                    o.x = cvt_pk_bf16(bf_lo(x.x) * dec, bf_hi(x.x) * dec); o.y = cvt_pk_bf16(bf_lo(x.y) * dec, bf_hi(x.y) * dec);
                    o.z = cvt_pk_bf16(bf_lo(x.z) * dec, bf_hi(x.z) * dec); o.w = cvt_pk_bf16(bf_lo(x.w) * dec, bf_hi(x.w) * dec);
                    *(LAS v4u*)(F.lds + VIMG + row * VPITCH + (tid & 7) * 16) = x;
                    *(LAS v4u*)(F.lds + VSIMG + row * VPITCH + (tid & 7) * 16) = o;
                }
#pragma unroll
                for (int e2 = 0; e2 < 2; ++e2)
#pragma unroll
                    for (int g = 0; g < 4; ++g) { v2u pk; pk.x = cvt_pk_bf16(accS[e2][4 * g], accS[e2][4 * g + 1]); pk.y = cvt_pk_bf16(accS[e2][4 * g + 2], accS[e2][4 * g + 3]);
                        *(LAS v2u*)(F.lds + SIMG + (32 * e2 + r) * SPITCH + (32 * w + 8 * g + 4 * h5) * 2) = pk; }
                WG_BAR();
                if (s + 1 < 34) SCAN_LOADV(s + 1);
                f32x16 accO;
#pragma unroll
                for (int i = 0; i < 16; ++i) accO[i] = 0.f;
                const int cc = fwd ? s - 2 : 33 - s;
                const size_t row0 = (size_t)b * T + cc * CH;
                if (s >= 2) {
                    const bf16* qp = Qg + (row0 + 32 * it + r) * 1024 + head * DK + 8 * h5;
#pragma unroll 4
                    for (int ks = 0; ks < 16; ++ks) {
                        const bf16x8 a = *(const GAS bf16x8*)(qp + 16 * ks);
                        const bf16x8 bb = *(const LAS bf16x8*)(F.lds + SIMG + (32 * et + r) * SPITCH + (16 * ks + 8 * h5) * 2);
                        accO = MFMA32(a, bb, accO);
                    }
#pragma unroll
                    for (int i = 0; i < 16; ++i) { const int il = 32 * it + crow(i, h5); accO[i] *= exp2f(l2g * (float)(fwd ? il + 1 : CH - il)); }
                    if (fwd) {
                        const bf16* pp = Pg + ((size_t)(bh * NCHUNK + cc) * CH + 32 * it + r) * CH + 8 * h5;
#pragma unroll 4
                        for (int ks = 0; ks < 8; ++ks) {
                            const bf16x8 a = *(const GAS bf16x8*)(pp + 16 * ks);
                            const bf16x8 bb = tr_frag(trV + 64 * et, 16 * ks * VPITCH, VPITCH);
                            accO = MFMA32(a, bb, accO);
                        }
                    }
                }
                asm volatile("s_waitcnt vmcnt(0)" ::: "memory");
#pragma unroll
                for (int i = 0; i < 16; ++i) { accS[0][i] *= gC; accS[1][i] *= gC; }
#pragma unroll
                for (int ks = 0; ks < 8; ++ks) {
                    const bf16x8 a = tr_frag(trK, 16 * ks * 64, 64);
                    const bf16x8 b0 = tr_frag(trVS, 16 * ks * VPITCH, VPITCH);
                    const bf16x8 b1 = tr_frag(trVS, 16 * ks * VPITCH + 64, VPITCH);
                    accS[0] = MFMA32(a, b0, accS[0]); accS[1] = MFMA32(a, b1, accS[1]);
                }
                asm volatile("s_waitcnt lgkmcnt(0)" ::: "memory");
                if (s + 1 < 34) SCAN_DMAK(s + 1);
                if (s >= 2) {
#pragma unroll
                    for (int i = 0; i < 16; ++i) {
                        const size_t idx = (row0 + 32 * it + crow(i, h5)) * 2048 + vcol + 32 * et + r;
                        if (fwd) O[idx] = f2bf(accO[i] + bf2f(Opart[idx])); else Opart[idx] = f2bf(accO[i]);
                    }
                }
                WG_BAR();
            }
#undef SCAN_SRC
#undef SCAN_LOADV
#undef SCAN_DMAK
            VM_WAIT(); __syncthreads();
        }
    }
}
DI void gn_gate_rows(Frame& F, bf16* O, const bf16* G) {
    const int gw = F.vcu * 8 + F.wave, NGW = F.G * 8;
    for (int m = gw; m < NTOK; m += NGW) {
        bf16* op = O + (size_t)m * VTOT; const bf16* gp = G + (size_t)m * VTOT;
#pragma unroll
        for (int j = 0; j < 4; ++j) {
            const v4u a = *(const GAS v4u*)(op + 512 * j + 8 * F.lane), g = *(const GAS v4u*)(gp + 512 * j + 8 * F.lane);
            float v[8] = {bf_lo(a.x), bf_hi(a.x), bf_lo(a.y), bf_hi(a.y), bf_lo(a.z), bf_hi(a.z), bf_lo(a.w), bf_hi(a.w)};
            const float gg[8] = {bf_lo(g.x), bf_hi(g.x), bf_lo(g.y), bf_hi(g.y), bf_lo(g.z), bf_hi(g.z), bf_lo(g.w), bf_hi(g.w)};
            float ss = 0.f;
#pragma unroll
            for (int e = 0; e < 8; ++e) ss += v[e] * v[e];
            const float rstd = rsqrtf(wave_sum(ss) * (1.f / DV) + NORM_EPS);
#pragma unroll
            for (int e = 0; e < 8; ++e) v[e] = v[e] * rstd * gg[e];
            st16(op + 512 * j + 8 * F.lane, cvt_pk_bf16(v[0], v[1]), cvt_pk_bf16(v[2], v[3]), cvt_pk_bf16(v[4], v[5]), cvt_pk_bf16(v[6], v[7]));
        }
    }
}

DI void rows_router(Frame& F, int layer, const float* hin, const bf16* Y, bf16* U, const float* norms, const float* router, const float* mbias) {
    const float* MOD = (const float*)(F.ws + WS_MOD) + (size_t)layer * 9 * 6144;
    const float* nrm = norms + (size_t)layer * 4 * D;
    const float* wr_ = router + (size_t)layer * D * NE;
    const float* rb = mbias + layer * NE;
    LAS float* ul = (LAS float*)(F.lds + RING_OFF + F.wave * 16384);
    const int lane = F.lane;
    const float mybias = rb[lane];
    for (int it = F.vcu; it < NTOK / 32; it += F.G) {
        const int m0 = it * 32 + F.wave * 4;
        const int b = m0 / T, slice = m0 / SLTOK;
        const float* mb = MOD + (size_t)b * 6144;
#pragma unroll 1
        for (int rr = 0; rr < 4; ++rr) {
            const int m = m0 + rr;
            float y[16], h[16], u[16];
            ld_row_bf16(Y + (size_t)m * D, lane, y); ld_row_f32(hin + (size_t)m * D, lane, h);
            const float rs1 = rsqrtf(row_sumsq(y) * (1.f / D) + NORM_EPS);
            { float g1[16], gm[16]; ld_row_f32(nrm + D, lane, g1); ld_row_f32(mb + 2 * D, lane, gm);
#pragma unroll
              for (int i = 0; i < 16; ++i) h[i] += gm[i] * (y[i] * rs1 * g1[i]); }
            st_row_f32(F.out + (size_t)m * D, lane, h);
            const float rs2 = rsqrtf(row_sumsq(h) * (1.f / D) + NORM_EPS);
            norm_mod(h, rs2, nrm + 2 * D, mb + 3 * D, mb + 4 * D, lane, u);
            st_row_bf16(U + (size_t)m * D, lane, u);
#pragma unroll
            for (int j = 0; j < 2; ++j)
#pragma unroll
                for (int e = 0; e < 8; ++e) ul[(512 * j + 8 * lane + e) * 4 + rr] = u[8 * j + e];
        }
        LDS_WAIT(); asm volatile("" ::: "memory");
        float lg[4] = {0.f, 0.f, 0.f, 0.f};
#pragma unroll 8
        for (int k = 0; k < D; ++k) { const float wv = wr_[(size_t)k * NE + lane]; const f32x4 uv = *(const LAS f32x4*)(ul + 4 * k);
            lg[0] += uv[0] * wv; lg[1] += uv[1] * wv; lg[2] += uv[2] * wv; lg[3] += uv[3] * wv; }
        asm volatile("" ::: "memory");
#pragma unroll 1
        for (int rr = 0; rr < 4; ++rr) {
            const int m = m0 + rr;
            const float sc = sigmoidf_(lg[rr]), bs = sc + mybias;
            int rk = 0;
#pragma unroll
            for (int d = 1; d < 8; ++d) { const float o = __shfl_xor(bs, d); const int ol = lane ^ d; rk += (o > bs || (o == bs && ol < lane)) ? 1 : 0; }
            float gs = rk < 2 ? bs : 0.f;
            gs += __shfl_xor(gs, 1); gs += __shfl_xor(gs, 2); gs += __shfl_xor(gs, 4);
            int grk = 0; const int grp = lane >> 3;
#pragma unroll
            for (int d = 1; d < 8; ++d) { const float o = __shfl_xor(gs, d << 3); const int og = grp ^ d; grk += (o > gs || (o == gs && og < grp)) ? 1 : 0; }
            const bool gsel = grk < 4;
            const float mv = gsel ? bs : -__builtin_inff();
            int erk = 0;
#pragma unroll 8
            for (int j = 0; j < 64; ++j) { const float o = __shfl(mv, j); erk += (o > mv || (o == mv && j < lane)) ? 1 : 0; }
            const bool sel = gsel && erk < TOPK;
            const float ssum = wave_sum(sel ? sc : 0.f);
            const unsigned long long bal = __ballot(sel);
            if (sel) {
                const int kslot = __popcll(bal & ((1ull << lane) - 1ull));
                const float wgt = sc / ssum * 2.5f;
                const int pos = (int)atomicAdd(F.ctl + cnt_word(layer, slice, lane), 1u);
                unsigned char* lb = F.ws + WS_LIST + (size_t)slice * LIST_SLICE;
                const size_t li = (size_t)lane * ECAP + pos;
                ((int*)lb)[li] = m; ((int*)(lb + LIST_ARR))[li] = (m - slice * SLTOK) * 9 + kslot; ((float*)(lb + 2 * LIST_ARR))[li] = wgt;
            }
            if (lane == 0) {
                unsigned char* lb = F.ws + WS_LIST + (size_t)slice * LIST_SLICE;
                const size_t li = (size_t)NE * ECAP + (m - slice * SLTOK);
                ((int*)lb)[li] = m; ((int*)(lb + LIST_ARR))[li] = (m - slice * SLTOK) * 9 + 8; ((float*)(lb + 2 * LIST_ARR))[li] = 1.f;
            }
        }
    }
}

DI void moe_tables(Frame& F, int layer, int slice) {
    LAS int* cum = (LAS int*)(F.lds + LDSCTL_OFF); LAS int* cnt = (LAS int*)(F.lds + LDSCTL_OFF + 512);
    __syncthreads();
    if (F.tid == 0) {
        int c = 0;
        for (int e = 0; e < NEX; ++e) { const int n = e < NE ? (int)__hip_atomic_load(F.ctl + cnt_word(layer, slice, e), RLX_AGENT) : SLTOK; cum[e] = c; cnt[e] = n; c += (n + 255) >> 8; }
        cum[NEX] = c;
    }
    __syncthreads();
}
DI void moe_gemm1(Frame& F, int layer, int slice) {
    moe_tables(F, layer, slice);
    const LAS int* cum = (const LAS int*)(F.lds + LDSCTL_OFF); const LAS int* cnt = (const LAS int*)(F.lds + LDSCTL_OFF + 512);
    unsigned char* lb = F.ws + WS_LIST + (size_t)slice * LIST_SLICE;
    pg8::Gemm g{(const bf16*)(F.ws + WS_U), (const bf16*)(F.ws + WS_W13), 1024};
    MoeOrder S{cum, cnt, (const int*)lb, 2, F.G, F.vcu, cum[NEX] * 2};
    EpiSwiGLU E{(bf16*)(F.ws + WS_ACT)};
    pg8::gemm_phase<EpiSwiGLU, MoeOrder, true>(F.lds + RING_OFF, g, S, E);
}
DI void moe_gemm2(Frame& F, int layer, int slice) {
    moe_tables(F, layer, slice);
    const LAS int* cum = (const LAS int*)(F.lds + LDSCTL_OFF); const LAS int* cnt = (const LAS int*)(F.lds + LDSCTL_OFF + 512);
    unsigned char* lb = F.ws + WS_LIST + (size_t)slice * LIST_SLICE;
    pg8::Gemm g{(const bf16*)(F.ws + WS_ACT), (const bf16*)(F.ws + WS_W2), 256};
    MoeOrder S{cum, cnt, (const int*)lb, 4, F.G, F.vcu, cum[NEX] * 4};
    EpiMoeOut E{(bf16*)(F.ws + WS_Y2), (const int*)(lb + LIST_ARR), (const float*)(lb + 2 * LIST_ARR)};
    pg8::gemm_phase<EpiMoeOut, MoeOrder, false>(F.lds + RING_OFF, g, S, E);
}
DI void moe_combine(Frame& F, int layer, int slice, bool last_layer, const float* norms) {
    const int gw = F.vcu * 8 + F.wave, NGW = F.G * 8, lane = F.lane;
    const float* MOD = (const float*)(F.ws + WS_MOD);
    const bf16* Y2 = (const bf16*)(F.ws + WS_Y2); bf16* U = (bf16*)(F.ws + WS_U);
    for (int ml = gw; ml < SLTOK; ml += NGW) {
        const int m = slice * SLTOK + ml, b = m / T;
        float o[16];
#pragma unroll
        for (int i = 0; i < 16; ++i) o[i] = 0.f;
#pragma unroll
        for (int k = 0; k < 9; ++k) { float v[16]; ld_row_bf16(Y2 + ((size_t)ml * 9 + k) * D, lane, v);
#pragma unroll
            for (int i = 0; i < 16; ++i) o[i] += v[i]; }
        const float rs = rsqrtf(row_sumsq(o) * (1.f / D) + NORM_EPS);
        float h[16], g3[16], gf[16];
        ld_row_f32(F.out + (size_t)m * D, lane, h); ld_row_f32(norms + (size_t)(layer * 4 + 3) * D, lane, g3); ld_row_f32(MOD + ((size_t)(layer * 9 + b)) * 6144 + 5 * D, lane, gf);
#pragma unroll
        for (int i = 0; i < 16; ++i) h[i] += gf[i] * (o[i] * rs * g3[i]);
        st_row_f32(F.out + (size_t)m * D, lane, h);
        if (!last_layer) {
            const float rs2 = rsqrtf(row_sumsq(h) * (1.f / D) + NORM_EPS);
            const float* mb = MOD + ((size_t)((layer + 1) * 9 + b)) * 6144;
            float u[16]; norm_mod(h, rs2, norms + (size_t)((layer + 1) * 4) * D, mb, mb + D, lane, u);
            st_row_bf16(U + (size_t)m * D, lane, u);
        }
    }
}

DI void dwconv_ln(Frame& F, const bf16* Z, bf16* C, const float* dw, const float* bdwp, const float* lngp, const float* lnbp) {
    LAS float* red = (LAS float*)(F.lds + RING_OFF);
    const int tid = F.tid, lane = F.lane, c0 = 2 * tid;
    const f32x2 bdw = *(const GAS f32x2*)(bdwp + c0), lg = *(const GAS f32x2*)(lngp + c0), lb = *(const GAS f32x2*)(lnbp + c0);
    for (int tile = F.vcu; tile < NTOK / 16; tile += F.G) {
        const int m0 = tile * 16, t0 = m0 & (T - 1);
        unsigned z[46];
#pragma unroll
        for (int i = 0; i < 46; ++i) { const int t = t0 - 15 + i; z[i] = (t >= 0 && t < T) ? *(const GAS unsigned*)(Z + (size_t)(m0 - 15 + i) * D + c0) : 0u; }
        float a0[16], a1[16];
#pragma unroll
        for (int i = 0; i < 16; ++i) { a0[i] = bdw[0]; a1[i] = bdw[1]; }
#pragma unroll
        for (int w = 0; w < 31; ++w) { const f32x2 k = *(const GAS f32x2*)(dw + w * D + c0);
#pragma unroll
            for (int i = 0; i < 16; ++i) { a0[i] += bf_lo(z[i + w]) * k[0]; a1[i] += bf_hi(z[i + w]) * k[1]; } }
        __syncthreads();
#pragma unroll
        for (int i = 0; i < 16; ++i) { const float q1 = wave_sum(a0[i] + a1[i]), q2 = wave_sum(a0[i] * a0[i] + a1[i] * a1[i]);
            if (lane == 0) { red[F.wave * 32 + i] = q1; red[F.wave * 32 + 16 + i] = q2; } }
        __syncthreads();
#pragma unroll
        for (int i = 0; i < 16; ++i) {
            float t1 = 0.f, t2 = 0.f;
#pragma unroll
            for (int w8 = 0; w8 < 8; ++w8) { t1 += red[w8 * 32 + i]; t2 += red[w8 * 32 + 16 + i]; }
            const float mu = t1 * (1.f / D), var = t2 * (1.f / D) - mu * mu, rstd = rsqrtf(fmaxf(var, 0.f) + LN_EPS);
            const float v0 = (a0[i] - mu) * rstd * lg[0] + lb[0], v1 = (a1[i] - mu) * rstd * lg[1] + lb[1];
            *(GAS unsigned*)(C + (size_t)(m0 + i) * D + c0) = cvt_pk_bf16(siluf_(v0), siluf_(v1));
        }
    }
}

constexpr int N_PHASES = 22;
struct Args { const float* in[26]; float* out; unsigned char* ws; int ph_lo, ph_hi; };
__global__ void __launch_bounds__(512, 2) fwd_kernel(Args args) {
    extern __shared__ __attribute__((aligned(16))) unsigned char lds[];
    Frame F;
    F.lds = (LAS unsigned char*)lds;
    F.MISC = (volatile LAS unsigned*)(F.lds + MISC_OFF);
    F.tid = threadIdx.x; F.lane = F.tid & 63; F.wave = __builtin_amdgcn_readfirstlane(F.tid >> 6);
    F.G = gridDim.x; { const int bx = blockIdx.x; F.vcu = (F.G % 8 == 0) ? (bx % 8) * (F.G / 8) + bx / 8 : bx; }
    F.ws = args.ws; F.ctl = (unsigned*)(args.ws + WS_CTL); F.out = args.out;
    for (int u = F.tid; u < (LDS_BYTES - LDSCTL_OFF) / 4; u += 512) ((LAS unsigned*)(F.lds + LDSCTL_OFF))[u] = 0u;
    __syncthreads();
    const int lo = args.ph_lo, hi = args.ph_hi;
    XcdBarrier bar; bar.bar = F.ctl + CW_BAR; bar.x = 0; bar.st = nullptr;
    if (hi - lo > 1) bar = xcd_barrier_post(F.ctl + CW_BAR, F.MISC + 8);
#ifndef PH_MASK
#define PH_MASK 0xffffffffu
#endif
#define IN(k) (((PH_MASK >> (k)) & 1u) && lo <= (k) && (k) < hi)
#define SEAM(k) do { if (IN(k) && IN((k) + 1)) xcd_barrier(bar); } while (0)
    unsigned char* ws = F.ws;
    bf16* U0 = (bf16*)F.out;
    bf16* OPART = (bf16*)F.out;
    bf16* Ob = (bf16*)(ws + WS_V);

    if (IN(0)) { mod_vectors(F, args.in[I_C], args.in[I_CCTX], args.in[I_MODW], args.in[I_MODB]); rope_tables(F); conv_small_weights(F, args.in[I_RWIN], args.in[I_RWOUT], args.in[I_CW1], args.in[I_CW2]); conv_moe_weights(F, 0, args.in[I_MW1], args.in[I_MW3], args.in[I_MW2], args.in[I_SW1], args.in[I_SW3], args.in[I_SW2]); }
    SEAM(0);
    if (IN(1)) { u_rows_layer0(F, U0, args.in[I_X], args.in[I_CTX], args.in[I_NORMS]); }
    SEAM(1);
    if (IN(2)) {
        pg8::Gemm g{U0, (const bf16*)(ws + WS_WIN), 1024}; InprojOrder S; S.init(F.G, (int)blockIdx.x);
        EpiQKVG E{ws};
        pg8::gemm_phase<EpiQKVG, InprojOrder, false>(F.lds + RING_OFF, g, S, E);
    }
    SEAM(2);
    if (IN(3)) { retention_scores(F, args.in[I_RDECAY]); }
    SEAM(3);
    if (IN(4)) { retention_scan(F, OPART, Ob, args.in[I_RDECAY]); }
    SEAM(4);
    if (IN(5)) { gn_gate_rows(F, Ob, (const bf16*)(ws + WS_G)); }
    SEAM(5);
    if (IN(6)) {
        pg8::Gemm g{Ob, (const bf16*)(ws + WS_WOUT), 2048}; pg8::StaticOrder S; S.init(NTOK, D, F.G, (int)blockIdx.x);
        EpiBf16 E{(bf16*)(ws + WS_Y), D, nullptr};
        pg8::gemm_phase<EpiBf16, pg8::StaticOrder, false>(F.lds + RING_OFF, g, S, E);
    }
    SEAM(6);
    if (IN(7)) { rows_router(F, 0, args.in[I_X], (const bf16*)(ws + WS_Y), (bf16*)(ws + WS_U), args.in[I_NORMS], args.in[I_ROUTER], args.in[I_MBIAS]); }
    SEAM(7);
    if (IN(8)) { moe_gemm1(F, 0, 0); }
    SEAM(8);
    if (IN(9)) { moe_gemm2(F, 0, 0); }
    SEAM(9);
    if (IN(10)) { moe_gemm1(F, 0, 1); moe_combine(F, 0, 0, false, args.in[I_NORMS]); }
    SEAM(10);
    if (IN(11)) { moe_gemm2(F, 0, 1); }
    SEAM(11);
    if (IN(12)) { moe_combine(F, 0, 1, false, args.in[I_NORMS]); conv_moe_weights(F, 1, args.in[I_MW1], args.in[I_MW3], args.in[I_MW2], args.in[I_SW1], args.in[I_SW3], args.in[I_SW2]); }
    SEAM(12);
    if (IN(13)) {
        pg8::Gemm g{(const bf16*)(ws + WS_U), (const bf16*)(ws + WS_CW1), 1024}; pg8::StaticOrder S; S.init(NTOK, 2048, F.G, (int)blockIdx.x);
        EpiGLU E{(bf16*)(ws + WS_Z), args.in[I_CB1]};
        pg8::gemm_phase<EpiGLU, pg8::StaticOrder, false>(F.lds + RING_OFF, g, S, E);
    }
    SEAM(13);
    if (IN(14)) { dwconv_ln(F, (const bf16*)(ws + WS_Z), (bf16*)(ws + WS_C), args.in[I_CDW], args.in[I_CBDW], args.in[I_CLNG], args.in[I_CLNB]); }
    SEAM(14);
    if (IN(15)) {
        pg8::Gemm g{(const bf16*)(ws + WS_C), (const bf16*)(ws + WS_CW2), 1024}; pg8::StaticOrder S; S.init(NTOK, D, F.G, (int)blockIdx.x);
        EpiBf16 E{(bf16*)(ws + WS_Y1), D, args.in[I_CB2]};
        pg8::gemm_phase<EpiBf16, pg8::StaticOrder, false>(F.lds + RING_OFF, g, S, E);
    }
    SEAM(15);
    if (IN(16)) { rows_router(F, 1, F.out, (const bf16*)(ws + WS_Y1), (bf16*)(ws + WS_U), args.in[I_NORMS], args.in[I_ROUTER], args.in[I_MBIAS]); }
    SEAM(16);
    if (IN(17)) { moe_gemm1(F, 1, 0); }
    SEAM(17);
    if (IN(18)) { moe_gemm2(F, 1, 0); }
    SEAM(18);
    if (IN(19)) { moe_gemm1(F, 1, 1); moe_combine(F, 1, 0, true, args.in[I_NORMS]); }
    SEAM(19);
    if (IN(20)) { moe_gemm2(F, 1, 1); }
    SEAM(20);
    if (IN(21)) { moe_combine(F, 1, 1, true, args.in[I_NORMS]); }
#undef IN
#undef SEAM
}

extern "C" void kernel_launch(void* const* d_in, const int* in_sizes, int n_in, void* d_out, int out_size, void* d_ws, size_t ws_size, hipStream_t stream) {
    static int grid = 0;
    if (grid == 0) {
        if (n_in != 26 || in_sizes[0] != NTOK * D || out_size != NTOK * D || ws_size < WS_END) {
            fprintf(stderr, "kernel_launch: unexpected shapes / workspace (n_in %d, ws %zu, need %zu); nothing launched\n", n_in, ws_size, (size_t)WS_END); grid = -1; return; }
        int dev = 0, cus = 0, per_cu = 0;
        if (hipGetDevice(&dev) != hipSuccess || hipDeviceGetAttribute(&cus, hipDeviceAttributeMultiprocessorCount, dev) != hipSuccess) { grid = -1; return; }
        if (hipFuncSetAttribute((const void*)fwd_kernel, hipFuncAttributeMaxDynamicSharedMemorySize, LDS_BYTES) != hipSuccess) { fprintf(stderr, "kernel_launch: hipFuncSetAttribute failed\n"); grid = -1; return; }
        if (hipOccupancyMaxActiveBlocksPerMultiprocessor(&per_cu, (const void*)fwd_kernel, 512, LDS_BYTES) != hipSuccess || per_cu < 1) { fprintf(stderr, "kernel_launch: occupancy query says %d\n", per_cu); }
        (void)hipGetLastError();
        grid = cus;
    }
    if (grid < 0) return;
    (void)hipMemsetAsync((char*)d_ws + WS_CTL, 0, CTL_ZERO_BYTES, stream);
    Args a{};
    for (int i = 0; i < 26; ++i) a.in[i] = (const float*)d_in[i];
    a.out = (float*)d_out; a.ws = (unsigned char*)d_ws;
#if MK_ONE_LAUNCH
    a.ph_lo = 0; a.ph_hi = N_PHASES;
    hipLaunchKernelGGL(fwd_kernel, dim3(grid), dim3(512), LDS_BYTES, stream, a);
#else
    for (int p = 0; p < N_PHASES; ++p) { a.ph_lo = p; a.ph_hi = p + 1; hipLaunchKernelGGL(fwd_kernel, dim3(grid), dim3(512), LDS_BYTES, stream, a); }
#endif
}
```

```cpp
#include <hip/hip_runtime.h>
#include <cstdio>
#include <cstdint>

#ifndef MK_ONE_LAUNCH
#define MK_ONE_LAUNCH 1
#endif

#define GAS __attribute__((address_space(1)))
#define LAS __attribute__((address_space(3)))
typedef unsigned short bf16;
typedef unsigned v4u __attribute__((ext_vector_type(4)));
typedef unsigned v2u __attribute__((ext_vector_type(2)));
typedef float f32x4 __attribute__((ext_vector_type(4)));
typedef float f32x2 __attribute__((ext_vector_type(2)));
typedef float f32x16 __attribute__((ext_vector_type(16)));
typedef short bf16x8 __attribute__((ext_vector_type(8)));
typedef short s16x4 __attribute__((ext_vector_type(4)));
typedef GAS unsigned gu32;
#define RLX_AGENT __ATOMIC_RELAXED, __HIP_MEMORY_SCOPE_AGENT
#define LDS_WAIT() asm volatile("s_waitcnt lgkmcnt(0)" ::: "memory")
#define VM_WAIT() asm volatile("s_waitcnt vmcnt(0)" ::: "memory")
#define DI __device__ __forceinline__

constexpr int D = 1024, NB = 8, T = 4096, NTOK = NB * T, LCTX = 256, NCTX = NB * LCTX;
constexpr int NH = 4, DK = 256, DV = 512, VTOT = 2048, RIN = 6144;
constexpr int NE = 64, TOPK = 8, EH = 256;
constexpr int CH = 128, NCHUNK = T / CH;
constexpr int NSLICE = 2, SLTOK = NTOK / NSLICE;
constexpr int ECAP = SLTOK;
constexpr int NEX = NE + 1;
constexpr int ACT_ROUTED = SLTOK * TOPK + NE * 256;
constexpr float NORM_EPS = 1e-6f, LN_EPS = 1e-5f;

DI unsigned cvt_pk_bf16(float lo, float hi) { unsigned r; asm("v_cvt_pk_bf16_f32 %0, %1, %2" : "=v"(r) : "v"(lo), "v"(hi)); return r; }
DI float bf_lo(unsigned u) { return __uint_as_float(u << 16); }
DI float bf_hi(unsigned u) { return __uint_as_float(u & 0xffff0000u); }
DI float bf2f(bf16 b) { return __uint_as_float(((unsigned)b) << 16); }
DI bf16 f2bf(float f) { return (bf16)(cvt_pk_bf16(f, 0.f) & 0xffffu); }
DI float wave_sum(float v) {
#pragma unroll
    for (int o = 1; o < 64; o <<= 1) v += __shfl_xor(v, o);
    return v;
}
DI float sigmoidf_(float x) { return 1.f / (1.f + __expf(-x)); }
DI float siluf_(float x) { return x / (1.f + __expf(-x)); }

namespace pg8 {
constexpr int BM = 256, BK = 64, HALF = 128, HTB = HALF * BK * 2, STAGE_BYTES = 8 * HTB, NXCD = 8, WGM = 8;
DI int lds_byte(int r, int c) { const int st = (r >> 4) * 2 + (c >> 5), rr = r & 15, cc = c & 31, ob = rr * 64 + cc * 2; return st * 1024 + (ob ^ (((ob >> 9) & 1) << 5)); }
DI void stage_rc(int b, int& R, int& C) { const int st = b / 1024, sb = b % 1024, swz = sb ^ (((sb >> 9) & 1) << 5); R = (st >> 1) * 16 + swz / 64; C = (st & 1) * 32 + (swz % 64) / 2; }
DI int perm32(int rho) { const int n = rho >> 4, i = rho & 15; return 8 * (i >> 2) + 4 * n + (i & 3); }

struct Unit { int pm, pn, e0, e1; };
struct Gemm { const bf16* A; const bf16* Bt; int K; };

struct StaticOrder {
    int nM, nN, nwg, G, c;
    DI void init(int M, int N, int G_, int c_) { nM = M / BM; nN = N / BM; nwg = nM * nN; G = G_; c = c_; }
    DI bool next(int i, Unit& u) const {
        const long L = (long)i * G + c; if (L >= nwg) return false;
        int wgid = (int)L; { const int q = nwg / NXCD, r = nwg % NXCD, xcd = wgid % NXCD, off = wgid / NXCD; wgid = (xcd < r ? xcd * (q + 1) : r * (q + 1) + (xcd - r) * q) + off; }
        const int nig = WGM * nN, gid = wgid / nig, fm = gid * WGM, gsz = (nM - fm) < WGM ? (nM - fm) : WGM;
        u.pm = fm + ((wgid % nig) % gsz); u.pn = (wgid % nig) / gsz; u.e0 = 0; u.e1 = 0; return true;
    }
    DI int a_row(const Unit&, int) const { return 0; }
};

template <class Epi, class Sched, bool GATHER>
DI void gemm_phase(LAS unsigned char* lds, const Gemm g, const Sched& S, const Epi& E) {
    const int tid = threadIdx.x, wid = __builtin_amdgcn_readfirstlane(tid >> 6), lane = tid & 63, wr = wid >> 2, wc = wid & 3, fr = lane & 15, fq = lane >> 4;
    const int K = g.K, nt = K / BK;
    unsigned voffB[2], vA[2][2], nvA[2][2]; int Rr[2], Cc[2];
#pragma unroll
    for (int i = 0; i < 2; ++i) { int R, C; stage_rc(tid * 16 + i * 8192, R, C); const int Rb = Epi::PERM ? ((R & ~31) + perm32(R & 31)) : R;
        voffB[i] = (unsigned)(Rb * K + C) * 2u; Rr[i] = R; Cc[i] = C; }
    const size_t kstep = (size_t)(BK * 2);
    const size_t hstep = (size_t)HALF * K * 2;
    const size_t tstep = 2 * hstep;
    const unsigned ldsw = (unsigned)wid * 1024u;
    const int aoff = lds_byte(wr * 64 + fr, fq * 8), boff = lds_byte(wc * 32 + fr, fq * 8);
#define PG8_SETV(u, v) do { _Pragma("unroll") for (int _h = 0; _h < 2; ++_h) _Pragma("unroll") for (int _i = 0; _i < 2; ++_i) \
        (v)[_h][_i] = GATHER ? (unsigned)(S.a_row((u), _h * 128 + Rr[_i]) * K + Cc[_i]) * 2u : (unsigned)((_h * 128 + Rr[_i]) * K + Cc[_i]) * 2u; } while (0)
#define PG8_SA(b, h) (((b) * 2 + (h)) * HTB)
#define PG8_SB(b, h) ((4 + (b) * 2 + (h)) * HTB)
#define PG8_STAGE(bufoff, gbase, voff) do { _Pragma("unroll") for (int _i = 0; _i < 2; ++_i) \
        __builtin_amdgcn_global_load_lds((const unsigned*)((const char*)(gbase) + (voff)[_i]), (LAS unsigned*)(lds + (bufoff) + ldsw + _i * 8192), 16, 0, 0); } while (0)
#define PG8_LDA(dst, b, h) do { _Pragma("unroll") for (int m = 0; m < 4; ++m) _Pragma("unroll") for (int k = 0; k < 2; ++k) dst[m][k] = *(const LAS bf16x8*)(lds + PG8_SA(b, h) + aoff + m * 2048 + k * 1024); } while (0)
#define PG8_LDB(dst, b, h) do { _Pragma("unroll") for (int n = 0; n < 2; ++n) _Pragma("unroll") for (int k = 0; k < 2; ++k) dst[n][k] = *(const LAS bf16x8*)(lds + PG8_SB(b, h) + boff + n * 2048 + k * 1024); } while (0)
#define PG8_MMA(ai, bj, At, Bt) do { __builtin_amdgcn_s_setprio(1); _Pragma("unroll") for (int m = 0; m < 4; ++m) _Pragma("unroll") for (int n = 0; n < 2; ++n) _Pragma("unroll") for (int k = 0; k < 2; ++k) \
        acc[ai][bj][m][n] = __builtin_amdgcn_mfma_f32_16x16x32_bf16(Bt[n][k], At[m][k], acc[ai][bj][m][n], 0, 0, 0); __builtin_amdgcn_s_setprio(0); } while (0)
#define PG8_WAIT_V(n) asm volatile("s_waitcnt vmcnt(" #n ")" ::: "memory")
#define PG8_WAIT_L(n) asm volatile("s_waitcnt lgkmcnt(" #n ")" ::: "memory")
#define PG8_BAR __builtin_amdgcn_s_barrier()
#define PG8_SCHED __builtin_amdgcn_sched_barrier(0)
    Unit cur, nxt; int ui = 0;
    if (!S.next(0, cur)) return;
    f32x4 acc[2][2][4][2];
#pragma unroll
    for (int a = 0; a < 2; ++a)
#pragma unroll
        for (int b = 0; b < 2; ++b)
#pragma unroll
            for (int m = 0; m < 4; ++m)
#pragma unroll
                for (int n = 0; n < 2; ++n) acc[a][b][m][n] = (f32x4){0.f, 0.f, 0.f, 0.f};
    bf16x8 At[4][2], B0[2][2], B1[2][2];
    PG8_SETV(cur, vA);
    const char* cA = GATHER ? (const char*)g.A : (const char*)g.A + (size_t)cur.pm * tstep; const char* cB = (const char*)g.Bt + (size_t)cur.pn * tstep;
    PG8_STAGE(PG8_SB(0, 0), cB, voffB); PG8_STAGE(PG8_SA(0, 0), cA, vA[0]); PG8_STAGE(PG8_SB(0, 1), cB + hstep, voffB); PG8_STAGE(PG8_SA(0, 1), cA, vA[1]);
    if (wr == 1) PG8_BAR;
    PG8_WAIT_V(4); PG8_BAR;
    PG8_STAGE(PG8_SB(1, 0), cB + kstep, voffB); PG8_STAGE(PG8_SA(1, 0), cA + kstep, vA[0]); PG8_STAGE(PG8_SB(1, 1), cB + hstep + kstep, voffB);
    PG8_WAIT_V(6); PG8_BAR;
    for (;;) {
        const bool has_next = S.next(ui + 1, nxt);
        const char* nA = has_next ? (GATHER ? (const char*)g.A : (const char*)g.A + (size_t)nxt.pm * tstep) : cA; const char* nB = has_next ? (const char*)g.Bt + (size_t)nxt.pn * tstep : cB;
        if (GATHER) { if (has_next) { PG8_SETV(nxt, nvA); } else {
#pragma unroll
            for (int h = 0; h < 2; ++h)
#pragma unroll
                for (int i = 0; i < 2; ++i) nvA[h][i] = vA[h][i]; } }
#pragma unroll 1
        for (int t = 0; t < nt; t += 2) {
            const bool last = (t == nt - 2);
            const char* a1 = cA + (size_t)(t + 1) * kstep;
            const char* a2 = last ? nA : cA + (size_t)(t + 2) * kstep; const char* b2 = last ? nB : cB + (size_t)(t + 2) * kstep;
            const char* a3 = a2 + kstep; const char* b3 = b2 + kstep;
            unsigned s2[2][2];
#pragma unroll
            for (int h = 0; h < 2; ++h)
#pragma unroll
                for (int i = 0; i < 2; ++i) s2[h][i] = (GATHER && last) ? nvA[h][i] : vA[h][i];
            PG8_LDB(B0, 0, 0); PG8_SCHED; PG8_LDA(At, 0, 0); PG8_STAGE(PG8_SA(1, 1), a1, vA[1]);
            PG8_WAIT_L(8); PG8_BAR; PG8_WAIT_L(0); PG8_MMA(0, 0, At, B0); PG8_BAR; PG8_SCHED;
            PG8_LDB(B1, 0, 1); PG8_STAGE(PG8_SB(0, 0), b2, voffB);
            PG8_BAR; PG8_WAIT_L(0); PG8_MMA(0, 1, At, B1); PG8_BAR;
            PG8_LDA(At, 0, 1); PG8_STAGE(PG8_SA(0, 0), a2, s2[0]);
            PG8_BAR; PG8_WAIT_L(0); PG8_MMA(1, 0, At, B0); PG8_BAR; PG8_SCHED;
            PG8_STAGE(PG8_SB(0, 1), b2 + hstep, voffB);
            PG8_WAIT_V(6); PG8_BAR; PG8_MMA(1, 1, At, B1); PG8_BAR;
            PG8_LDB(B0, 1, 0); PG8_SCHED; PG8_LDA(At, 1, 0); PG8_STAGE(PG8_SA(0, 1), a2, s2[1]);
            PG8_WAIT_L(8); PG8_BAR; PG8_WAIT_L(0); PG8_MMA(0, 0, At, B0); PG8_BAR; PG8_SCHED;
            PG8_LDB(B1, 1, 1); PG8_STAGE(PG8_SB(1, 0), b3, voffB);
            PG8_BAR; PG8_WAIT_L(0); PG8_MMA(0, 1, At, B1); PG8_BAR;
            PG8_LDA(At, 1, 1); PG8_STAGE(PG8_SA(1, 0), a3, s2[0]);
            PG8_BAR; PG8_WAIT_L(0); PG8_MMA(1, 0, At, B0); PG8_BAR; PG8_SCHED;
            PG8_STAGE(PG8_SB(1, 1), b3 + hstep, voffB);
            PG8_WAIT_V(6); PG8_BAR; PG8_MMA(1, 1, At, B1); PG8_BAR;
        }
        { int tz = threadIdx.x; asm volatile("" : "+v"(tz));
          const int wid2 = __builtin_amdgcn_readfirstlane(tz >> 6), lane2 = tz & 63;
          E(acc, cur, wid2 >> 2, wid2 & 3, lane2 & 15, lane2 >> 4); }
        if (!has_next) break;
#pragma unroll
        for (int a = 0; a < 2; ++a)
#pragma unroll
            for (int b = 0; b < 2; ++b)
#pragma unroll
                for (int m = 0; m < 4; ++m)
#pragma unroll
                    for (int n = 0; n < 2; ++n) acc[a][b][m][n] = (f32x4){0.f, 0.f, 0.f, 0.f};
        cur = nxt; cA = nA; cB = nB; ++ui;
        if (GATHER) {
#pragma unroll
            for (int h = 0; h < 2; ++h)
#pragma unroll
                for (int i = 0; i < 2; ++i) vA[h][i] = nvA[h][i]; }
    }
    PG8_WAIT_V(0);
    if (wr == 0) PG8_BAR;
    PG8_BAR;
#undef PG8_SETV
#undef PG8_SA
#undef PG8_SB
#undef PG8_STAGE
#undef PG8_LDA
#undef PG8_LDB
#undef PG8_MMA
#undef PG8_WAIT_V
#undef PG8_WAIT_L
#undef PG8_BAR
#undef PG8_SCHED
}
}
using pg8::Unit;

constexpr size_t MiB = 1u << 20;
constexpr size_t WS_CTL = 0, CTL_ZERO_BYTES = 2 * MiB;
constexpr size_t WS_MOD = 2 * MiB;
constexpr size_t WS_ROPE = 4 * MiB;
constexpr size_t WS_WIN = 10 * MiB, WS_WOUT = 22 * MiB, WS_CW1 = 26 * MiB, WS_CW2 = 30 * MiB;
constexpr size_t WS_W13 = 32 * MiB, WS_W2 = 97 * MiB;
constexpr size_t WS_LIST = 130 * MiB;
constexpr size_t LIST_ARR = (size_t)NEX * ECAP * 4, LIST_SLICE = 3 * LIST_ARR;
constexpr size_t WS_BIG = 160 * MiB;
constexpr size_t WS_Q = WS_BIG, WS_K = WS_Q + 64 * MiB, WS_V = WS_K + 64 * MiB, WS_G = WS_V + 128 * MiB;
constexpr size_t WS_KC = 544 * MiB, WS_VC = 548 * MiB, WS_P = 560 * MiB;
constexpr size_t WS_Y = WS_BIG;
constexpr size_t WS_U = WS_BIG;
constexpr size_t WS_ACT = WS_BIG + 64 * MiB;
constexpr size_t WS_Y2 = WS_BIG + 144 * MiB;
constexpr size_t WS_Z = WS_BIG + 64 * MiB, WS_C = WS_BIG + 128 * MiB, WS_Y1 = WS_BIG + 192 * MiB;
constexpr size_t WS_END = 592 * MiB;
static_assert(WS_LIST + NSLICE * LIST_SLICE <= WS_BIG, "lists");
static_assert(WS_ACT + (size_t)(ACT_ROUTED + SLTOK) * 512 <= WS_Y2, "act");
static_assert(WS_Y2 + (size_t)SLTOK * 9 * 1024 * 2 <= WS_END, "y2");
static_assert(WS_W13 + (size_t)NEX * 512 * 1024 * 2 <= WS_W2 && WS_W2 + (size_t)NEX * 1024 * 256 * 2 <= WS_LIST, "moe w");
constexpr int CW_TMO = 0, CW_CODE = 1;
constexpr int CW_BAR = 4096;
constexpr int CW_CNT = 16384;
DI int cnt_word(int layer, int slice, int e) { return CW_CNT + ((layer * NSLICE + slice) * NE + e) * 16; }

constexpr int RING_OFF = 0, RING_BYTES = 131072;
constexpr int LDSCTL_OFF = 148480, MISC_OFF = LDSCTL_OFF + 1024;
constexpr int LDS_BYTES = 151552;

#define XB_TMO      128
#define XB_XCNT(j)  (256  + 64 * (j))
#define XB_XSUB(j)  (1280 + 64 * (j))
#define XB_XGEN(j)  (2304 + 64 * (j))
#define XB_TOP      3328
#define XB_TOPGEN   3392
#define XCD_BAR_WORDS 3456
#define XB_SPIN_CAP (1u << 18)
DI unsigned xb_ld(unsigned* p)              { return __hip_atomic_load(p, __ATOMIC_RELAXED, __HIP_MEMORY_SCOPE_AGENT); }
DI unsigned xb_add(unsigned* p, unsigned v) { return __hip_atomic_fetch_add(p, v, __ATOMIC_RELAXED, __HIP_MEMORY_SCOPE_AGENT); }
DI unsigned xb_xcc_id() { return (unsigned)__builtin_amdgcn_s_getreg((3 << 11) | 20) & 0xFu; }
#define XB_SPIN(cond, bar) do { unsigned _sp = 0; while (cond) { __builtin_amdgcn_s_sleep(1); \
    if ((++_sp & 255u) == 0u) { if (xb_ld(&(bar)[XB_TMO])) break; if (_sp > XB_SPIN_CAP) { atomicAdd(&(bar)[XB_TMO], 1u); break; } } } } while (0)
struct XcdBarrier { unsigned* bar; unsigned x; volatile LAS unsigned* st; };
DI XcdBarrier xcd_barrier_post(unsigned* bar, volatile LAS unsigned* st) {
    XcdBarrier b; b.bar = bar; b.x = xb_xcc_id(); b.st = st;
    if (threadIdx.x == 0) (void)xb_add(&bar[XB_XCNT(b.x)], 1u);
    return b;
}
DI void xcd_barrier_complete(unsigned* bar, unsigned x, unsigned& nloc, unsigned& nx) {
    const unsigned G = gridDim.x * gridDim.y * gridDim.z;
    unsigned sum, cnt, mine, sp = 0u;
    for (;;) {
        sum = 0u; cnt = 0u; mine = 0u;
#pragma unroll
        for (unsigned j = 0; j < 16; ++j) { const unsigned c = xb_ld(&bar[XB_XCNT(j)]); sum += c; cnt += (c > 0u) ? 1u : 0u; mine = (j == x) ? c : mine; }
        if (sum == G) break;
        __builtin_amdgcn_s_sleep(1);
        if ((++sp & 255u) == 0u) { if (xb_ld(&bar[XB_TMO])) break; if (sp > XB_SPIN_CAP) { atomicAdd(&bar[XB_TMO], 1u); break; } }
    }
    nloc = mine > 0u ? mine : 1u; nx = cnt > 0u ? cnt : 1u;
}
DI void xcd_barrier(const XcdBarrier& b) {
    asm volatile("s_waitcnt vmcnt(0)" ::: "memory");
    __syncthreads();
    if (threadIdx.x == 0) {
        unsigned* bar = b.bar;
        __builtin_amdgcn_s_waitcnt(0);
        unsigned nloc = b.st[0], nx = b.st[1];
        if (nloc == 0u) { xcd_barrier_complete(bar, b.x, nloc, nx); b.st[0] = nloc; b.st[1] = nx; }
        const unsigned old = xb_add(&bar[XB_XSUB(b.x)], 1u);
        const unsigned gen = old / nloc;
        if (old + 1u == (gen + 1u) * nloc) {
            __builtin_amdgcn_fence(__ATOMIC_RELEASE, "agent");
            asm volatile("s_waitcnt vmcnt(0)" ::: "memory");
            const unsigned og = xb_add(&bar[XB_TOP], 1u);
            const unsigned tg = og / nx;
            if (og + 1u == (tg + 1u) * nx) xb_add(&bar[XB_TOPGEN], 1u);
            else XB_SPIN(xb_ld(&bar[XB_TOPGEN]) == tg, bar);
            __builtin_amdgcn_fence(__ATOMIC_ACQUIRE, "agent");
            xb_add(&bar[XB_XGEN(b.x)], 1u);
            asm volatile("s_waitcnt vmcnt(0)" ::: "memory");
        } else {
            XB_SPIN(xb_ld(&bar[XB_XGEN(b.x)]) == gen, bar);
            __builtin_amdgcn_fence(__ATOMIC_ACQUIRE, "agent");
            asm volatile("s_waitcnt vmcnt(0)" ::: "memory");
        }
    }
    __syncthreads();
}

struct Frame {
    LAS unsigned char* lds;
    volatile LAS unsigned* MISC;
    unsigned* ctl;
    unsigned char* ws;
    int tid, lane, wave, vcu, G;
    float* out;
};
enum { I_X = 0, I_C, I_CTX, I_CCTX, I_MODW, I_MODB, I_NORMS, I_RWIN, I_RWOUT, I_RDECAY, I_CW1, I_CB1, I_CDW, I_CBDW, I_CLNG, I_CLNB, I_CW2, I_CB2,
       I_ROUTER, I_MBIAS, I_MW1, I_MW3, I_MW2, I_SW1, I_SW3, I_SW2 };

typedef const f32x4 (&AccRef)[2][2][4][2];
DI void st16(bf16* p, unsigned a, unsigned b, unsigned c, unsigned d) { v4u o; o.x = a; o.y = b; o.z = c; o.w = d; *(GAS v4u*)p = o; }

struct EpiQKVG {
    static constexpr bool PERM = true;
    unsigned char* ws;
    DI void operator()(AccRef acc, const Unit& u, int wr, int wc, int fr, int fq) const {
        const bool ctx = u.pm >= 128;
        const int rbase = u.pm * 256 + wr * 64 + fr, cw = wc * 32 + 8 * fq, pn = u.pn;
        if (pn < 8) {
            const bool isq = pn < 4; const int head = pn & 3;
            const size_t doff = ctx ? WS_KC : (isq ? WS_Q : WS_K);
            bf16* dst = (bf16*)(ws + doff);
            const float* cs = (const float*)(ws + WS_ROPE) + (ctx ? 2 * T * 128 : 0);
            const int snoff = ctx ? LCTX * 128 : T * 128;
            const float sc = isq ? 0.0625f : 1.f;
#pragma unroll
            for (int ai = 0; ai < 2; ++ai)
#pragma unroll
                for (int m = 0; m < 4; ++m) {
                    const int row = rbase + ai * 128 + m * 16, rr = ctx ? row - NTOK : row, t = ctx ? (rr & (LCTX - 1)) : (row & (T - 1));
#pragma unroll
                    for (int bj = 0; bj < 2; ++bj) {
                        const int p0 = bj * 64 + wc * 16 + 4 * fq;
                        const f32x4 c = *(const GAS f32x4*)(cs + (size_t)t * 128 + p0), s = *(const GAS f32x4*)(cs + snoff + (size_t)t * 128 + p0);
                        const f32x4 v0 = acc[ai][bj][m][0], v1 = acc[ai][bj][m][1];
                        const float o0 = (v0[0] * c[0] - v0[1] * s[0]) * sc, o1 = (v0[0] * s[0] + v0[1] * c[0]) * sc;
                        const float o2 = (v0[2] * c[1] - v0[3] * s[1]) * sc, o3 = (v0[2] * s[1] + v0[3] * c[1]) * sc;
                        const float o4 = (v1[0] * c[2] - v1[1] * s[2]) * sc, o5 = (v1[0] * s[2] + v1[1] * c[2]) * sc;
                        const float o6 = (v1[2] * c[3] - v1[3] * s[3]) * sc, o7 = (v1[2] * s[3] + v1[3] * c[3]) * sc;
                        st16(dst + (size_t)rr * 1024 + head * 256 + bj * 128 + cw, cvt_pk_bf16(o0, o1), cvt_pk_bf16(o2, o3), cvt_pk_bf16(o4, o5), cvt_pk_bf16(o6, o7));
                    }
                }
        } else {
            const bool isg = pn >= 16; const int ct = (pn - (isg ? 16 : 8)) * 256;
            const size_t doff = isg ? WS_G : (ctx ? WS_VC : WS_V);
            bf16* dst = (bf16*)(ws + doff);
#pragma unroll
            for (int ai = 0; ai < 2; ++ai)
#pragma unroll
                for (int m = 0; m < 4; ++m) {
                    const int row = rbase + ai * 128 + m * 16, rr = ctx ? row - NTOK : row;
#pragma unroll
                    for (int bj = 0; bj < 2; ++bj) {
                        f32x4 v0 = acc[ai][bj][m][0], v1 = acc[ai][bj][m][1];
                        if (isg) {
#pragma unroll
                            for (int e = 0; e < 4; ++e) { v0[e] = siluf_(v0[e]); v1[e] = siluf_(v1[e]); }
                        }
                        st16(dst + (size_t)rr * 2048 + ct + bj * 128 + cw, cvt_pk_bf16(v0[0], v0[1]), cvt_pk_bf16(v0[2], v0[3]), cvt_pk_bf16(v1[0], v1[1]), cvt_pk_bf16(v1[2], v1[3]));
                    }
                }
        }
    }
};
struct InprojOrder {
    pg8::StaticOrder so; int G, c;
    DI void init(int G_, int c_) { so.init(NTOK, RIN, G_, c_); G = G_; c = c_; }
    DI bool next(int i, Unit& u) const {
        const int L = i * G + c;
        if (L < 3072) return so.next(i, u);
        const int l2 = L - 3072; if (l2 >= 96) return false;
        u.pm = 128 + l2 / 12; u.pn = 4 + l2 % 12; u.e0 = 0; u.e1 = 0; return true;
    }
    DI int a_row(const Unit&, int) const { return 0; }
};
struct EpiBf16 {
    static constexpr bool PERM = true;
    bf16* O; int ldc; const float* bias;
    DI void operator()(AccRef acc, const Unit& u, int wr, int wc, int fr, int fq) const {
        const int rbase = u.pm * 256 + wr * 64 + fr, cbase = u.pn * 256 + wc * 32 + 8 * fq;
#pragma unroll
        for (int bj = 0; bj < 2; ++bj) {
            f32x4 b0 = (f32x4){0.f, 0.f, 0.f, 0.f}, b1 = b0;
            if (bias) { b0 = *(const GAS f32x4*)(bias + cbase + bj * 128); b1 = *(const GAS f32x4*)(bias + cbase + bj * 128 + 4); }
#pragma unroll
            for (int ai = 0; ai < 2; ++ai)
#pragma unroll
                for (int m = 0; m < 4; ++m) {
                    const f32x4 v0 = acc[ai][bj][m][0] + b0, v1 = acc[ai][bj][m][1] + b1;
                    st16(O + (size_t)(rbase + ai * 128 + m * 16) * ldc + cbase + bj * 128, cvt_pk_bf16(v0[0], v0[1]), cvt_pk_bf16(v0[2], v0[3]), cvt_pk_bf16(v1[0], v1[1]), cvt_pk_bf16(v1[2], v1[3]));
                }
        }
    }
};
struct EpiGLU {
    static constexpr bool PERM = true;
    bf16* Z; const float* b1;
    DI void operator()(AccRef acc, const Unit& u, int wr, int wc, int fr, int fq) const {
        const int rbase = u.pm * 256 + wr * 64 + fr, cc = u.pn * 128 + wc * 32 + 8 * fq;
        const f32x4 ba0 = *(const GAS f32x4*)(b1 + cc), ba1 = *(const GAS f32x4*)(b1 + cc + 4), bg0 = *(const GAS f32x4*)(b1 + 1024 + cc), bg1 = *(const GAS f32x4*)(b1 + 1024 + cc + 4);
#pragma unroll
        for (int ai = 0; ai < 2; ++ai)
#pragma unroll
            for (int m = 0; m < 4; ++m) {
                const f32x4 a0 = acc[ai][0][m][0] + ba0, a1 = acc[ai][0][m][1] + ba1, g0 = acc[ai][1][m][0] + bg0, g1 = acc[ai][1][m][1] + bg1;
                f32x4 o0, o1;
#pragma unroll
                for (int e = 0; e < 4; ++e) { o0[e] = a0[e] * sigmoidf_(g0[e]); o1[e] = a1[e] * sigmoidf_(g1[e]); }
                st16(Z + (size_t)(rbase + ai * 128 + m * 16) * 1024 + cc, cvt_pk_bf16(o0[0], o0[1]), cvt_pk_bf16(o0[2], o0[3]), cvt_pk_bf16(o1[0], o1[1]), cvt_pk_bf16(o1[2], o1[3]));
            }
    }
};
struct MoeOrder {
    const LAS int* cum; const LAS int* cnt; const int* ltok; int npn, G, c, total;
    DI bool next(int i, Unit& u) const {
        const int L = i * G + c; if (L >= total) return false;
        const int blk = L / npn, sub = L - blk * npn;
        int e = 0;
#pragma unroll 1
        while (e < NEX - 1 && cum[e + 1] <= blk) ++e;
        const int bi = blk - cum[e];
        u.pm = blk; u.pn = e * npn + sub; u.e0 = e * ECAP + bi * 256; const int left = cnt[e] - bi * 256; u.e1 = left < 256 ? left : 256; return true;
    }
    DI int a_row(const Unit& u, int r) const { return r < u.e1 ? ltok[u.e0 + r] : 0; }
};
struct EpiSwiGLU {
    static constexpr bool PERM = true;
    bf16* ACT;
    DI void operator()(AccRef acc, const Unit& u, int wr, int wc, int fr, int fq) const {
        const int rbase = u.pm * 256 + wr * 64 + fr, cc = (u.pn & 1) * 128 + wc * 32 + 8 * fq;
#pragma unroll
        for (int ai = 0; ai < 2; ++ai)
#pragma unroll
            for (int m = 0; m < 4; ++m) {
                const f32x4 a0 = acc[ai][0][m][0], a1 = acc[ai][0][m][1], g0 = acc[ai][1][m][0], g1 = acc[ai][1][m][1];
                f32x4 o0, o1;
#pragma unroll
                for (int e = 0; e < 4; ++e) { o0[e] = siluf_(a0[e]) * g0[e]; o1[e] = siluf_(a1[e]) * g1[e]; }
                st16(ACT + (size_t)(rbase + ai * 128 + m * 16) * 256 + cc, cvt_pk_bf16(o0[0], o0[1]), cvt_pk_bf16(o0[2], o0[3]), cvt_pk_bf16(o1[0], o1[1]), cvt_pk_bf16(o1[2], o1[3]));
            }
    }
};
struct EpiMoeOut {
    static constexpr bool PERM = true;
    bf16* Y2; const int* ldst; const float* lw;
    DI void operator()(AccRef acc, const Unit& u, int wr, int wc, int fr, int fq) const {
        const int cc = (u.pn & 3) * 256 + wc * 32 + 8 * fq;
#pragma unroll
        for (int ai = 0; ai < 2; ++ai)
#pragma unroll
            for (int m = 0; m < 4; ++m) {
                const int r = ai * 128 + wr * 64 + m * 16 + fr;
                asm volatile("" ::: "memory");
                if (r < u.e1) {
                    const int dst = ldst[u.e0 + r]; const float w = lw[u.e0 + r];
#pragma unroll
                    for (int bj = 0; bj < 2; ++bj) {
                        const f32x4 v0 = acc[ai][bj][m][0] * w, v1 = acc[ai][bj][m][1] * w;
                        st16(Y2 + (size_t)dst * 1024 + cc + bj * 128, cvt_pk_bf16(v0[0], v0[1]), cvt_pk_bf16(v0[2], v0[3]), cvt_pk_bf16(v1[0], v1[1]), cvt_pk_bf16(v1[2], v1[3]));
                    }
                }
            }
    }
};

DI void tr_item(const float* src, int ldsrc, int k0, int scol0, bf16* dst, int Kd, int drow0, LAS float* scr, int lane) {
#pragma unroll 8
    for (int i = 0; i < 32; ++i) { const int kk = 2 * i + (lane >> 5); scr[kk * 33 + (lane & 31)] = src[(size_t)(k0 + kk) * ldsrc + scol0 + (lane & 31)]; }
    LDS_WAIT(); asm volatile("" ::: "memory");
    const int c = lane & 7;
#pragma unroll
    for (int j = 0; j < 4; ++j) { const int n = (lane >> 3) + 8 * j; const LAS float* s = scr + (8 * c) * 33 + n;
        v4u o; o.x = cvt_pk_bf16(s[0 * 33], s[1 * 33]); o.y = cvt_pk_bf16(s[2 * 33], s[3 * 33]); o.z = cvt_pk_bf16(s[4 * 33], s[5 * 33]); o.w = cvt_pk_bf16(s[6 * 33], s[7 * 33]);
        *(GAS v4u*)(dst + (size_t)(drow0 + n) * Kd + k0 + 8 * c) = o; }
    LDS_WAIT(); asm volatile("" ::: "memory");
}
DI void conv_moe_weights(Frame& F, int layer, const float* mw1, const float* mw3, const float* mw2, const float* sw1, const float* sw3, const float* sw2) {
    LAS float* scr = (LAS float*)(F.lds + RING_OFF + F.wave * 16384);
    const int gw = F.vcu * 8 + F.wave, NGW = F.G * 8;
    bf16* W13 = (bf16*)(F.ws + WS_W13); bf16* W2 = (bf16*)(F.ws + WS_W2);
    constexpr int I13 = 16 * 16, I2 = 4 * 32, PER = I13 + I2;
    for (int it = gw; it < NEX * PER; it += NGW) {
        const int e = it / PER, r = it - e * PER;
        if (r < I13) {
            const int kb = r >> 4, nb = r & 15;
            const float* s1 = e < NE ? mw1 + ((size_t)(layer * NE + e) << 18) : sw1 + ((size_t)layer << 18);
            const float* s3 = e < NE ? mw3 + ((size_t)(layer * NE + e) << 18) : sw3 + ((size_t)layer << 18);
            const float* src = (nb & 7) < 4 ? s1 : s3;
            tr_item(src, 256, kb * 64, 128 * (nb >> 3) + 32 * (nb & 3), W13, 1024, e * 512 + nb * 32, scr, F.lane);
        } else {
            const int r2 = r - I13, kb = r2 >> 5, nb = r2 & 31;
            const float* src = e < NE ? mw2 + ((size_t)(layer * NE + e) << 18) : sw2 + ((size_t)layer << 18);
            tr_item(src, 1024, kb * 64, nb * 32, W2, 256, e * 1024 + nb * 32, scr, F.lane);
        }
    }
}
DI void conv_small_weights(Frame& F, const float* rwin, const float* rwout, const float* cw1, const float* cw2) {
    LAS float* scr = (LAS float*)(F.lds + RING_OFF + F.wave * 16384);
    const int gw = F.vcu * 8 + F.wave, NGW = F.G * 8;
    constexpr int I_IN = 16 * 192, I_OUT = 32 * 32, I_C1 = 16 * 64, I_C2 = 16 * 32, TOT = I_IN + I_OUT + I_C1 + I_C2;
    for (int it = gw; it < TOT; it += NGW) {
        int r = it;
        if (r < I_IN) { const int kb = r / 192, nb = r % 192; tr_item(rwin, RIN, kb * 64, nb * 32, (bf16*)(F.ws + WS_WIN), 1024, nb * 32, scr, F.lane); continue; } r -= I_IN;
        if (r < I_OUT) { const int kb = r >> 5, nb = r & 31; tr_item(rwout, 1024, kb * 64, nb * 32, (bf16*)(F.ws + WS_WOUT), 2048, nb * 32, scr, F.lane); continue; } r -= I_OUT;
        if (r < I_C1) { const int kb = r >> 6, nb = r & 63; const int sc0 = ((nb & 7) < 4 ? 0 : 1024) + 128 * (nb >> 3) + 32 * (nb & 3);
            tr_item(cw1, 2048, kb * 64, sc0, (bf16*)(F.ws + WS_CW1), 1024, nb * 32, scr, F.lane); continue; } r -= I_C1;
        { const int kb = r >> 5, nb = r & 31; tr_item(cw2, 1024, kb * 64, nb * 32, (bf16*)(F.ws + WS_CW2), 1024, nb * 32, scr, F.lane); }
    }
}
DI void rope_tables(Frame& F) {
    float* csL = (float*)(F.ws + WS_ROPE); float* snL = csL + T * 128; float* csC = snL + T * 128; float* snC = csC + LCTX * 128;
    const int gt = F.vcu * 512 + F.tid, NT = F.G * 512;
    for (int i = gt; i < (T + LCTX) * 128; i += NT) {
        const int t = i >> 7, p = i & 127;
        int ax, ii, dd; if (p < 32) { ax = 0; ii = p; dd = 64; } else if (p < 80) { ax = 1; ii = p - 32; dd = 96; } else { ax = 2; ii = p - 80; dd = 96; }
        const float inv = exp2f(-13.287712379549449f * (float)(2 * ii) / (float)dd);
        int pos;
        if (t < T) pos = ax == 0 ? LCTX : (ax == 1 ? (t >> 6) : (t & 63)); else pos = ax == 0 ? (t - T) : 0;
        const float ang = (float)pos * inv;
        const float rev = ang * 0.15915494309189535f;
        const float fr = rev - floorf(rev);
        const float s = __builtin_amdgcn_sinf(fr), c = __builtin_amdgcn_cosf(fr);
        if (t < T) { csL[i] = c; snL[i] = s; } else { csC[i - T * 128] = c; snC[i - T * 128] = s; }
    }
}
DI void mod_vectors(Frame& F, const float* cin, const float* cctx, const float* modw, const float* modb) {
    LAS float* sl = (LAS float*)(F.lds + RING_OFF);
    LAS float* red = sl + 9 * 1024;
    if (F.vcu >= 192) return;
    for (int i = F.tid; i < 9 * 1024; i += 512) { const float v = i < 8192 ? cin[i] : cctx[i - 8192]; sl[i] = siluf_(v); }
    __syncthreads();
    float* MOD = (float*)(F.ws + WS_MOD);
    for (int it = F.vcu; it < 192; it += F.G) {
        const int l = it / 96, cb = (it % 96) * 64;
        const float* w = modw + (size_t)l * 1024 * 6144 + cb + F.lane;
        float a[9];
#pragma unroll
        for (int b = 0; b < 9; ++b) a[b] = 0.f;
        const int k0 = F.wave * 128;
#pragma unroll 8
        for (int k = 0; k < 128; ++k) { const float wv = w[(size_t)(k0 + k) * 6144];
#pragma unroll
            for (int b = 0; b < 9; ++b) a[b] += sl[b * 1024 + k0 + k] * wv; }
#pragma unroll
        for (int b = 0; b < 9; ++b) red[(F.wave * 9 + b) * 64 + F.lane] = a[b];
        __syncthreads();
        for (int o = F.tid; o < 9 * 64; o += 512) { const int b = o >> 6, c = o & 63; float s = modb[l * 6144 + cb + c];
#pragma unroll
            for (int w8 = 0; w8 < 8; ++w8) s += red[(w8 * 9 + b) * 64 + c];
            MOD[(size_t)(l * 9 + b) * 6144 + cb + c] = s; }
        __syncthreads();
    }
}

DI void ld_row_f32(const float* p, int lane, float (&v)[16]) {
#pragma unroll
    for (int j = 0; j < 2; ++j) { const f32x4 a = *(const GAS f32x4*)(p + 512 * j + 8 * lane), b = *(const GAS f32x4*)(p + 512 * j + 8 * lane + 4);
#pragma unroll
        for (int e = 0; e < 4; ++e) { v[8 * j + e] = a[e]; v[8 * j + 4 + e] = b[e]; } }
}
DI void st_row_f32(float* p, int lane, const float (&v)[16]) {
#pragma unroll
    for (int j = 0; j < 2; ++j) { *(GAS f32x4*)(p + 512 * j + 8 * lane) = (f32x4){v[8 * j], v[8 * j + 1], v[8 * j + 2], v[8 * j + 3]}; *(GAS f32x4*)(p + 512 * j + 8 * lane + 4) = (f32x4){v[8 * j + 4], v[8 * j + 5], v[8 * j + 6], v[8 * j + 7]}; }
}
DI void ld_row_bf16(const bf16* p, int lane, float (&v)[16]) {
#pragma unroll
    for (int j = 0; j < 2; ++j) { const v4u a = *(const GAS v4u*)(p + 512 * j + 8 * lane);
        v[8 * j + 0] = bf_lo(a.x); v[8 * j + 1] = bf_hi(a.x); v[8 * j + 2] = bf_lo(a.y); v[8 * j + 3] = bf_hi(a.y); v[8 * j + 4] = bf_lo(a.z); v[8 * j + 5] = bf_hi(a.z); v[8 * j + 6] = bf_lo(a.w); v[8 * j + 7] = bf_hi(a.w); }
}
DI void st_row_bf16(bf16* p, int lane, const float (&v)[16]) {
#pragma unroll
    for (int j = 0; j < 2; ++j) st16(p + 512 * j + 8 * lane, cvt_pk_bf16(v[8 * j], v[8 * j + 1]), cvt_pk_bf16(v[8 * j + 2], v[8 * j + 3]), cvt_pk_bf16(v[8 * j + 4], v[8 * j + 5]), cvt_pk_bf16(v[8 * j + 6], v[8 * j + 7]));
}
DI float row_sumsq(const float (&v)[16]) { float s = 0.f;
#pragma unroll
    for (int i = 0; i < 16; ++i) s += v[i] * v[i];
    return wave_sum(s); }
DI void norm_mod(const float (&x)[16], float rstd, const float* nw, const float* sh, const float* sc, int lane, float (&u)[16]) {
    float g[16], a[16], b[16]; ld_row_f32(nw, lane, g); ld_row_f32(sh, lane, a); ld_row_f32(sc, lane, b);
#pragma unroll
    for (int i = 0; i < 16; ++i) u[i] = x[i] * rstd * g[i] * (1.f + b[i]) + a[i];
}
DI void u_rows_layer0(Frame& F, bf16* U, const float* xin, const float* ctxin, const float* norms) {
    const int gw = F.vcu * 8 + F.wave, NGW = F.G * 8;
    const float* MOD = (const float*)(F.ws + WS_MOD);
    for (int m = gw; m < NTOK + NCTX; m += NGW) {
        const bool lat = m < NTOK; const float* src = lat ? xin + (size_t)m * D : ctxin + (size_t)(m - NTOK) * D;
        const int b = lat ? m / T : 8;
        float x[16], u[16]; ld_row_f32(src, F.lane, x);
        const float rstd = rsqrtf(row_sumsq(x) * (1.f / D) + NORM_EPS);
        const float* mb = MOD + (size_t)b * 6144;
        norm_mod(x, rstd, norms, mb, mb + 1024, F.lane, u);
        st_row_bf16(U + (size_t)m * D, F.lane, u);
    }
}

#define MFMA32(a, b, c) __builtin_amdgcn_mfma_f32_32x32x16_bf16((a), (b), (c), 0, 0, 0)
DI int crow(int reg, int h5) { return (reg & 3) + 8 * (reg >> 2) + 4 * h5; }
DI float log2_gamma(const float* decay, int dir, int head) { const float x = decay[dir * NH + head]; return -log2f(1.f + expf(-x)); }

DI void retention_scores(Frame& F, const float* decay) {
    const bf16* Q = (const bf16*)(F.ws + WS_Q); const bf16* K = (const bf16*)(F.ws + WS_K); bf16* P = (bf16*)(F.ws + WS_P);
    const int lane = F.lane, r = lane & 31, h5 = lane >> 5;
    for (int unit = F.vcu; unit < NB * NH * NCHUNK; unit += F.G) {
        const int bh = unit >> 5, c = unit & 31, b = bh >> 2, head = bh & 3;
        const float lf = log2_gamma(decay, 0, head), lb = log2_gamma(decay, 1, head);
        const size_t row0 = (size_t)b * T + c * CH;
        bf16* Pt = P + (size_t)unit * CH * CH;
#pragma unroll
        for (int tt = 0; tt < 2; ++tt) {
            const int tile = F.wave * 2 + tt, jt = tile >> 2, it = tile & 3;
            const bf16* kp = K + (row0 + 32 * jt + r) * 1024 + head * 256 + 8 * h5;
            const bf16* qp = Q + (row0 + 32 * it + r) * 1024 + head * 256 + 8 * h5;
            f32x16 acc;
#pragma unroll
            for (int i = 0; i < 16; ++i) acc[i] = 0.f;
#pragma unroll
            for (int s = 0; s < 16; ++s) { const bf16x8 a = *(const GAS bf16x8*)(kp + 16 * s), bq = *(const GAS bf16x8*)(qp + 16 * s); acc = MFMA32(a, bq, acc); }
            const int i = 32 * it + r;
#pragma unroll
            for (int g = 0; g < 4; ++g) {
                float o[4];
#pragma unroll
                for (int e = 0; e < 4; ++e) { const int j = 32 * jt + 8 * g + 4 * h5 + e; const int dd = i - j;
                    const float w = dd > 0 ? exp2f(lf * (float)dd) : (dd < 0 ? exp2f(lb * (float)(-dd)) : 2.f);
                    o[e] = acc[4 * g + e] * w; }
                v2u pk; pk.x = cvt_pk_bf16(o[0], o[1]); pk.y = cvt_pk_bf16(o[2], o[3]);
                *(GAS v2u*)(Pt + (size_t)i * CH + 32 * jt + 8 * g + 4 * h5) = pk;
            }
        }
    }
}

constexpr int KSLAB = 0, VPITCH = 192, SPITCH = 528;
constexpr int VIMG = 65536, VSIMG = VIMG + 128 * VPITCH, SIMG = VSIMG + 128 * VPITCH, SCAN_LDS_END = SIMG + 64 * SPITCH;
static_assert(SCAN_LDS_END <= LDSCTL_OFF, "scan LDS");
typedef LAS s16x4 lds_s16x4;
DI const LAS unsigned char* tr_lane_base(const LAS unsigned char* img, int pitch, int lane) {
    const int h5 = lane >> 5, blk = (lane >> 4) & 1, q = (lane & 15) >> 2, p = lane & 3;
    return img + (8 * h5 + q) * pitch + (16 * blk + 4 * p) * 2;
}
DI bf16x8 tr_frag(const LAS unsigned char* lane_base, int off, int pitch) {
    const s16x4 lo = __builtin_amdgcn_ds_read_tr16_b64_v4i16((lds_s16x4*)(lane_base + off));
    const s16x4 hi = __builtin_amdgcn_ds_read_tr16_b64_v4i16((lds_s16x4*)(lane_base + off + 4 * pitch));
    return __builtin_shufflevector(lo, hi, 0, 1, 2, 3, 4, 5, 6, 7);
}
#define WG_BAR() do { asm volatile("s_waitcnt lgkmcnt(0)" ::: "memory"); __builtin_amdgcn_s_barrier(); asm volatile("" ::: "memory"); } while (0)
DI void retention_scan(Frame& F, bf16* Opart, bf16* O, const float* decay) {
    const bf16* Qg = (const bf16*)(F.ws + WS_Q); const bf16* Kg = (const bf16*)(F.ws + WS_K); const bf16* Vg = (const bf16*)(F.ws + WS_V);
    const bf16* KCg = (const bf16*)(F.ws + WS_KC); const bf16* VCg = (const bf16*)(F.ws + WS_VC); const bf16* Pg = (const bf16*)(F.ws + WS_P);
    const int lane = F.lane, r = lane & 31, h5 = lane >> 5, w = F.wave, tid = F.tid;
    const int it = w >> 1, et = w & 1;
    const LAS unsigned char* trK = tr_lane_base(F.lds + KSLAB + w * 8192, 64, lane);
    const LAS unsigned char* trV = tr_lane_base(F.lds + VIMG, VPITCH, lane);
    const LAS unsigned char* trVS = tr_lane_base(F.lds + VSIMG, VPITCH, lane);
    for (int unit = F.vcu; unit < NB * NH * 8; unit += F.G) {
        const int bh = unit >> 3, eb = unit & 7, b = bh >> 2, head = bh & 3;
        const int vcol = head * DV + eb * 64;
#pragma unroll 1
        for (int pass = 0; pass < 2; ++pass) {
            const bool fwd = pass == 1;
            const float l2g = log2_gamma(decay, fwd ? 0 : 1, head);
            const float gC = exp2f(l2g * (float)CH);
            f32x16 accS[2];
#pragma unroll
            for (int i = 0; i < 16; ++i) { accS[0][i] = 0.f; accS[1][i] = 0.f; }
            v4u vreg[2];
#define SCAN_SRC(s, kp, vp) do { if ((s) < 2) { const int cc = fwd ? (s) : 1 - (s); kp = KCg + ((size_t)b * LCTX + cc * CH) * 1024 + head * DK; vp = VCg + ((size_t)b * LCTX + cc * CH) * 2048 + vcol; } \
                else { const int cc = fwd ? (s) - 2 : 33 - (s); kp = Kg + ((size_t)b * T + cc * CH) * 1024 + head * DK; vp = Vg + ((size_t)b * T + cc * CH) * 2048 + vcol; } } while (0)
#define SCAN_LOADV(s) do { const bf16* kp_; const bf16* vp_; SCAN_SRC(s, kp_, vp_); (void)kp_; \
                _Pragma("unroll") for (int i = 0; i < 2; ++i) vreg[i] = *(const GAS v4u*)(vp_ + (size_t)((tid >> 3) + 64 * i) * 2048 + (tid & 7) * 8); } while (0)
#define SCAN_DMAK(s) do { const bf16* kp_; const bf16* vp_; SCAN_SRC(s, kp_, vp_); (void)vp_; \
                _Pragma("unroll") for (int i = 0; i < 8; ++i) __builtin_amdgcn_global_load_lds((const unsigned*)(kp_ + (size_t)(16 * i + (lane >> 2)) * 1024 + w * 32 + (lane & 3) * 8), \
                    (LAS unsigned*)(F.lds + KSLAB + w * 8192 + i * 1024), 16, 0, 0); } while (0)
            SCAN_LOADV(0); SCAN_DMAK(0);
#pragma unroll 1
            for (int s = 0; s < 34; ++s) {
#pragma unroll
                for (int i = 0; i < 2; ++i) {
                    const int row = (tid >> 3) + 64 * i;
                    const float dec = exp2f(l2g * (float)(fwd ? (CH - 1 - row) : row));
                    const v4u x = vreg[i]; v4u o;
                    o.x = cvt_pk_bf16(bf_lo(x.x) * dec, bf_hi(x.x) * dec); o.y = cvt_pk_bf16(bf_lo(x.y) * dec, bf_hi(x.y) * dec);
                    o.z = cvt_pk_bf16(bf_lo(x.z) * dec, bf_hi(x.z) * dec); o.w = cvt_pk_bf16(bf_lo(x.w) * dec, bf_hi(x.w) * dec);
                    *(LAS v4u*)(F.lds + VIMG + row * VPITCH + (tid & 7) * 16) = x;
                    *(LAS v4u*)(F.lds + VSIMG + row * VPITCH + (tid & 7) * 16) = o;
                }
#pragma unroll
                for (int e2 = 0; e2 < 2; ++e2)
#pragma unroll
                    for (int g = 0; g < 4; ++g) { v2u pk; pk.x = cvt_pk_bf16(accS[e2][4 * g], accS[e2][4 * g + 1]); pk.y = cvt_pk_bf16(accS[e2][4 * g + 2], accS[e2][4 * g + 3]);
                        *(LAS v2u*)(F.lds + SIMG + (32 * e2 + r) * SPITCH + (32 * w + 8 * g + 4 * h5) * 2) = pk; }
                WG_BAR();
                if (s + 1 < 34) SCAN_LOADV(s + 1);
                f32x16 accO;
#pragma unroll
                for (int i = 0; i < 16; ++i) accO[i] = 0.f;
                const int cc = fwd ? s - 2 : 33 - s;
                const size_t row0 = (size_t)b * T + cc * CH;
                if (s >= 2) {
                    const bf16* qp = Qg + (row0 + 32 * it + r) * 1024 + head * DK + 8 * h5;
#pragma unroll 4
                    for (int ks = 0; ks < 16; ++ks) {
                        const bf16x8 a = *(const GAS bf16x8*)(qp + 16 * ks);
                        const bf16x8 bb = *(const LAS bf16x8*)(F.lds + SIMG + (32 * et + r) * SPITCH + (16 * ks + 8 * h5) * 2);
                        accO = MFMA32(a, bb, accO);
                    }
#pragma unroll
                    for (int i = 0; i < 16; ++i) { const int il = 32 * it + crow(i, h5); accO[i] *= exp2f(l2g * (float)(fwd ? il + 1 : CH - il)); }
                    if (fwd) {
                        const bf16* pp = Pg + ((size_t)(bh * NCHUNK + cc) * CH + 32 * it + r) * CH + 8 * h5;
#pragma unroll 4
                        for (int ks = 0; ks < 8; ++ks) {
                            const bf16x8 a = *(const GAS bf16x8*)(pp + 16 * ks);
                            const bf16x8 bb = tr_frag(trV + 64 * et, 16 * ks * VPITCH, VPITCH);
                            accO = MFMA32(a, bb, accO);
                        }
                    }
                }
                asm volatile("s_waitcnt vmcnt(0)" ::: "memory");
#pragma unroll
                for (int i = 0; i < 16; ++i) { accS[0][i] *= gC; accS[1][i] *= gC; }
#pragma unroll
                for (int ks = 0; ks < 8; ++ks) {
                    const bf16x8 a = tr_frag(trK, 16 * ks * 64, 64);
                    const bf16x8 b0 = tr_frag(trVS, 16 * ks * VPITCH, VPITCH);
                    const bf16x8 b1 = tr_frag(trVS, 16 * ks * VPITCH + 64, VPITCH);
                    accS[0] = MFMA32(a, b0, accS[0]); accS[1] = MFMA32(a, b1, accS[1]);
                }
                asm volatile("s_waitcnt lgkmcnt(0)" ::: "memory");
                if (s + 1 < 34) SCAN_DMAK(s + 1);
                if (s >= 2) {
#pragma unroll
                    for (int i = 0; i < 16; ++i) {
                        const size_t idx = (row0 + 32 * it + crow(i, h5)) * 2048 + vcol + 32 * et + r;
                        if (fwd) O[idx] = f2bf(accO[i] + bf2f(Opart[idx])); else Opart[idx] = f2bf(accO[i]);
                    }
                }
                WG_BAR();
            }
#undef SCAN_SRC
#undef SCAN_LOADV
#undef SCAN_DMAK
            VM_WAIT(); __syncthreads();
        }
    }
}
DI void gn_gate_rows(Frame& F, bf16* O, const bf16* G) {
    const int gw = F.vcu * 8 + F.wave, NGW = F.G * 8;
    for (int m = gw; m < NTOK; m += NGW) {
        bf16* op = O + (size_t)m * VTOT; const bf16* gp = G + (size_t)m * VTOT;
#pragma unroll
        for (int j = 0; j < 4; ++j) {
            const v4u a = *(const GAS v4u*)(op + 512 * j + 8 * F.lane), g = *(const GAS v4u*)(gp + 512 * j + 8 * F.lane);
            float v[8] = {bf_lo(a.x), bf_hi(a.x), bf_lo(a.y), bf_hi(a.y), bf_lo(a.z), bf_hi(a.z), bf_lo(a.w), bf_hi(a.w)};
            const float gg[8] = {bf_lo(g.x), bf_hi(g.x), bf_lo(g.y), bf_hi(g.y), bf_lo(g.z), bf_hi(g.z), bf_lo(g.w), bf_hi(g.w)};
            float ss = 0.f;
#pragma unroll
            for (int e = 0; e < 8; ++e) ss += v[e] * v[e];
            const float rstd = rsqrtf(wave_sum(ss) * (1.f / DV) + NORM_EPS);
#pragma unroll
            for (int e = 0; e < 8; ++e) v[e] = v[e] * rstd * gg[e];
            st16(op + 512 * j + 8 * F.lane, cvt_pk_bf16(v[0], v[1]), cvt_pk_bf16(v[2], v[3]), cvt_pk_bf16(v[4], v[5]), cvt_pk_bf16(v[6], v[7]));
        }
    }
}

DI void rows_router(Frame& F, int layer, const float* hin, const bf16* Y, bf16* U, const float* norms, const float* router, const float* mbias) {
    const float* MOD = (const float*)(F.ws + WS_MOD) + (size_t)layer * 9 * 6144;
    const float* nrm = norms + (size_t)layer * 4 * D;
    const float* wr_ = router + (size_t)layer * D * NE;
    const float* rb = mbias + layer * NE;
    LAS float* ul = (LAS float*)(F.lds + RING_OFF + F.wave * 16384);
    const int lane = F.lane;
    const float mybias = rb[lane];
    for (int it = F.vcu; it < NTOK / 32; it += F.G) {
        const int m0 = it * 32 + F.wave * 4;
        const int b = m0 / T, slice = m0 / SLTOK;
        const float* mb = MOD + (size_t)b * 6144;
#pragma unroll 1
        for (int rr = 0; rr < 4; ++rr) {
            const int m = m0 + rr;
            float y[16], h[16], u[16];
            ld_row_bf16(Y + (size_t)m * D, lane, y); ld_row_f32(hin + (size_t)m * D, lane, h);
            const float rs1 = rsqrtf(row_sumsq(y) * (1.f / D) + NORM_EPS);
            { float g1[16], gm[16]; ld_row_f32(nrm + D, lane, g1); ld_row_f32(mb + 2 * D, lane, gm);
#pragma unroll
              for (int i = 0; i < 16; ++i) h[i] += gm[i] * (y[i] * rs1 * g1[i]); }
            st_row_f32(F.out + (size_t)m * D, lane, h);
            const float rs2 = rsqrtf(row_sumsq(h) * (1.f / D) + NORM_EPS);
            norm_mod(h, rs2, nrm + 2 * D, mb + 3 * D, mb + 4 * D, lane, u);
            st_row_bf16(U + (size_t)m * D, lane, u);
#pragma unroll
            for (int j = 0; j < 2; ++j)
#pragma unroll
                for (int e = 0; e < 8; ++e) ul[(512 * j + 8 * lane + e) * 4 + rr] = u[8 * j + e];
        }
        LDS_WAIT(); asm volatile("" ::: "memory");
        float lg[4] = {0.f, 0.f, 0.f, 0.f};
#pragma unroll 8
        for (int k = 0; k < D; ++k) { const float wv = wr_[(size_t)k * NE + lane]; const f32x4 uv = *(const LAS f32x4*)(ul + 4 * k);
            lg[0] += uv[0] * wv; lg[1] += uv[1] * wv; lg[2] += uv[2] * wv; lg[3] += uv[3] * wv; }
        asm volatile("" ::: "memory");
#pragma unroll 1
        for (int rr = 0; rr < 4; ++rr) {
            const int m = m0 + rr;
            const float sc = sigmoidf_(lg[rr]), bs = sc + mybias;
            int rk = 0;
#pragma unroll
            for (int d = 1; d < 8; ++d) { const float o = __shfl_xor(bs, d); const int ol = lane ^ d; rk += (o > bs || (o == bs && ol < lane)) ? 1 : 0; }
            float gs = rk < 2 ? bs : 0.f;
            gs += __shfl_xor(gs, 1); gs += __shfl_xor(gs, 2); gs += __shfl_xor(gs, 4);
            int grk = 0; const int grp = lane >> 3;
#pragma unroll
            for (int d = 1; d < 8; ++d) { const float o = __shfl_xor(gs, d << 3); const int og = grp ^ d; grk += (o > gs || (o == gs && og < grp)) ? 1 : 0; }
            const bool gsel = grk < 4;
            const float mv = gsel ? bs : -__builtin_inff();
            int erk = 0;
#pragma unroll 8
            for (int j = 0; j < 64; ++j) { const float o = __shfl(mv, j); erk += (o > mv || (o == mv && j < lane)) ? 1 : 0; }
            const bool sel = gsel && erk < TOPK;
            const float ssum = wave_sum(sel ? sc : 0.f);
            const unsigned long long bal = __ballot(sel);
            if (sel) {
                const int kslot = __popcll(bal & ((1ull << lane) - 1ull));
                const float wgt = sc / ssum * 2.5f;
                const int pos = (int)atomicAdd(F.ctl + cnt_word(layer, slice, lane), 1u);
                unsigned char* lb = F.ws + WS_LIST + (size_t)slice * LIST_SLICE;
                const size_t li = (size_t)lane * ECAP + pos;
                ((int*)lb)[li] = m; ((int*)(lb + LIST_ARR))[li] = (m - slice * SLTOK) * 9 + kslot; ((float*)(lb + 2 * LIST_ARR))[li] = wgt;
            }
            if (lane == 0) {
                unsigned char* lb = F.ws + WS_LIST + (size_t)slice * LIST_SLICE;
                const size_t li = (size_t)NE * ECAP + (m - slice * SLTOK);
                ((int*)lb)[li] = m; ((int*)(lb + LIST_ARR))[li] = (m - slice * SLTOK) * 9 + 8; ((float*)(lb + 2 * LIST_ARR))[li] = 1.f;
            }
        }
    }
}

DI void moe_tables(Frame& F, int layer, int slice) {
    LAS int* cum = (LAS int*)(F.lds + LDSCTL_OFF); LAS int* cnt = (LAS int*)(F.lds + LDSCTL_OFF + 512);
    __syncthreads();
    if (F.tid == 0) {
        int c = 0;
        for (int e = 0; e < NEX; ++e) { const int n = e < NE ? (int)__hip_atomic_load(F.ctl + cnt_word(layer, slice, e), RLX_AGENT) : SLTOK; cum[e] = c; cnt[e] = n; c += (n + 255) >> 8; }
        cum[NEX] = c;
    }
    __syncthreads();
}
DI void moe_gemm1(Frame& F, int layer, int slice) {
    moe_tables(F, layer, slice);
    const LAS int* cum = (const LAS int*)(F.lds + LDSCTL_OFF); const LAS int* cnt = (const LAS int*)(F.lds + LDSCTL_OFF + 512);
    unsigned char* lb = F.ws + WS_LIST + (size_t)slice * LIST_SLICE;
    pg8::Gemm g{(const bf16*)(F.ws + WS_U), (const bf16*)(F.ws + WS_W13), 1024};
    MoeOrder S{cum, cnt, (const int*)lb, 2, F.G, F.vcu, cum[NEX] * 2};
    EpiSwiGLU E{(bf16*)(F.ws + WS_ACT)};
    pg8::gemm_phase<EpiSwiGLU, MoeOrder, true>(F.lds + RING_OFF, g, S, E);
}
DI void moe_gemm2(Frame& F, int layer, int slice) {
    moe_tables(F, layer, slice);
    const LAS int* cum = (const LAS int*)(F.lds + LDSCTL_OFF); const LAS int* cnt = (const LAS int*)(F.lds + LDSCTL_OFF + 512);
    unsigned char* lb = F.ws + WS_LIST + (size_t)slice * LIST_SLICE;
    pg8::Gemm g{(const bf16*)(F.ws + WS_ACT), (const bf16*)(F.ws + WS_W2), 256};
    MoeOrder S{cum, cnt, (const int*)lb, 4, F.G, F.vcu, cum[NEX] * 4};
    EpiMoeOut E{(bf16*)(F.ws + WS_Y2), (const int*)(lb + LIST_ARR), (const float*)(lb + 2 * LIST_ARR)};
    pg8::gemm_phase<EpiMoeOut, MoeOrder, false>(F.lds + RING_OFF, g, S, E);
}
DI void moe_combine(Frame& F, int layer, int slice, bool last_layer, const float* norms) {
    const int gw = F.vcu * 8 + F.wave, NGW = F.G * 8, lane = F.lane;
    const float* MOD = (const float*)(F.ws + WS_MOD);
    const bf16* Y2 = (const bf16*)(F.ws + WS_Y2); bf16* U = (bf16*)(F.ws + WS_U);
    for (int ml = gw; ml < SLTOK; ml += NGW) {
        const int m = slice * SLTOK + ml, b = m / T;
        float o[16];
#pragma unroll
        for (int i = 0; i < 16; ++i) o[i] = 0.f;
#pragma unroll
        for (int k = 0; k < 9; ++k) { float v[16]; ld_row_bf16(Y2 + ((size_t)ml * 9 + k) * D, lane, v);
#pragma unroll
            for (int i = 0; i < 16; ++i) o[i] += v[i]; }
        const float rs = rsqrtf(row_sumsq(o) * (1.f / D) + NORM_EPS);
        float h[16], g3[16], gf[16];
        ld_row_f32(F.out + (size_t)m * D, lane, h); ld_row_f32(norms + (size_t)(layer * 4 + 3) * D, lane, g3); ld_row_f32(MOD + ((size_t)(layer * 9 + b)) * 6144 + 5 * D, lane, gf);
#pragma unroll
        for (int i = 0; i < 16; ++i) h[i] += gf[i] * (o[i] * rs * g3[i]);
        st_row_f32(F.out + (size_t)m * D, lane, h);
        if (!last_layer) {
            const float rs2 = rsqrtf(row_sumsq(h) * (1.f / D) + NORM_EPS);
            const float* mb = MOD + ((size_t)((layer + 1) * 9 + b)) * 6144;
            float u[16]; norm_mod(h, rs2, norms + (size_t)((layer + 1) * 4) * D, mb, mb + D, lane, u);
            st_row_bf16(U + (size_t)m * D, lane, u);
        }
    }
}

DI void dwconv_ln(Frame& F, const bf16* Z, bf16* C, const float* dw, const float* bdwp, const float* lngp, const float* lnbp) {
    LAS float* red = (LAS float*)(F.lds + RING_OFF);
    const int tid = F.tid, lane = F.lane, c0 = 2 * tid;
    const f32x2 bdw = *(const GAS f32x2*)(bdwp + c0), lg = *(const GAS f32x2*)(lngp + c0), lb = *(const GAS f32x2*)(lnbp + c0);
    for (int tile = F.vcu; tile < NTOK / 16; tile += F.G) {
        const int m0 = tile * 16, t0 = m0 & (T - 1);
        unsigned z[46];
#pragma unroll
        for (int i = 0; i < 46; ++i) { const int t = t0 - 15 + i; z[i] = (t >= 0 && t < T) ? *(const GAS unsigned*)(Z + (size_t)(m0 - 15 + i) * D + c0) : 0u; }
        float a0[16], a1[16];
#pragma unroll
        for (int i = 0; i < 16; ++i) { a0[i] = bdw[0]; a1[i] = bdw[1]; }
#pragma unroll
        for (int w = 0; w < 31; ++w) { const f32x2 k = *(const GAS f32x2*)(dw + w * D + c0);
#pragma unroll
            for (int i = 0; i < 16; ++i) { a0[i] += bf_lo(z[i + w]) * k[0]; a1[i] += bf_hi(z[i + w]) * k[1]; } }
        __syncthreads();
#pragma unroll
        for (int i = 0; i < 16; ++i) { const float q1 = wave_sum(a0[i] + a1[i]), q2 = wave_sum(a0[i] * a0[i] + a1[i] * a1[i]);
            if (lane == 0) { red[F.wave * 32 + i] = q1; red[F.wave * 32 + 16 + i] = q2; } }
        __syncthreads();
#pragma unroll
        for (int i = 0; i < 16; ++i) {
            float t1 = 0.f, t2 = 0.f;
#pragma unroll
            for (int w8 = 0; w8 < 8; ++w8) { t1 += red[w8 * 32 + i]; t2 += red[w8 * 32 + 16 + i]; }
            const float mu = t1 * (1.f / D), var = t2 * (1.f / D) - mu * mu, rstd = rsqrtf(fmaxf(var, 0.f) + LN_EPS);
            const float v0 = (a0[i] - mu) * rstd * lg[0] + lb[0], v1 = (a1[i] - mu) * rstd * lg[1] + lb[1];
            *(GAS unsigned*)(C + (size_t)(m0 + i) * D + c0) = cvt_pk_bf16(siluf_(v0), siluf_(v1));
        }
    }
}

constexpr int N_PHASES = 22;
struct Args { const float* in[26]; float* out; unsigned char* ws; int ph_lo, ph_hi; };
__global__ void __launch_bounds__(512, 2) fwd_kernel(Args args) {
    extern __shared__ __attribute__((aligned(16))) unsigned char lds[];
    Frame F;
    F.lds = (LAS unsigned char*)lds;
    F.MISC = (volatile LAS unsigned*)(F.lds + MISC_OFF);
    F.tid = threadIdx.x; F.lane = F.tid & 63; F.wave = __builtin_amdgcn_readfirstlane(F.tid >> 6);
    F.G = gridDim.x; { const int bx = blockIdx.x; F.vcu = (F.G % 8 == 0) ? (bx % 8) * (F.G / 8) + bx / 8 : bx; }
    F.ws = args.ws; F.ctl = (unsigned*)(args.ws + WS_CTL); F.out = args.out;
    for (int u = F.tid; u < (LDS_BYTES - LDSCTL_OFF) / 4; u += 512) ((LAS unsigned*)(F.lds + LDSCTL_OFF))[u] = 0u;
    __syncthreads();
    const int lo = args.ph_lo, hi = args.ph_hi;
    XcdBarrier bar; bar.bar = F.ctl + CW_BAR; bar.x = 0; bar.st = nullptr;
    if (hi - lo > 1) bar = xcd_barrier_post(F.ctl + CW_BAR, F.MISC + 8);
#ifndef PH_MASK
#define PH_MASK 0xffffffffu
#endif
#define IN(k) (((PH_MASK >> (k)) & 1u) && lo <= (k) && (k) < hi)
#define SEAM(k) do { if (IN(k) && IN((k) + 1)) xcd_barrier(bar); } while (0)
    unsigned char* ws = F.ws;
    bf16* U0 = (bf16*)F.out;
    bf16* OPART = (bf16*)F.out;
    bf16* Ob = (bf16*)(ws + WS_V);

    if (IN(0)) { mod_vectors(F, args.in[I_C], args.in[I_CCTX], args.in[I_MODW], args.in[I_MODB]); rope_tables(F); conv_small_weights(F, args.in[I_RWIN], args.in[I_RWOUT], args.in[I_CW1], args.in[I_CW2]); conv_moe_weights(F, 0, args.in[I_MW1], args.in[I_MW3], args.in[I_MW2], args.in[I_SW1], args.in[I_SW3], args.in[I_SW2]); }
    SEAM(0);
    if (IN(1)) { u_rows_layer0(F, U0, args.in[I_X], args.in[I_CTX], args.in[I_NORMS]); }
    SEAM(1);
    if (IN(2)) {
        pg8::Gemm g{U0, (const bf16*)(ws + WS_WIN), 1024}; InprojOrder S; S.init(F.G, (int)blockIdx.x);
        EpiQKVG E{ws};
        pg8::gemm_phase<EpiQKVG, InprojOrder, false>(F.lds + RING_OFF, g, S, E);
    }
    SEAM(2);
    if (IN(3)) { retention_scores(F, args.in[I_RDECAY]); }
    SEAM(3);
    if (IN(4)) { retention_scan(F, OPART, Ob, args.in[I_RDECAY]); }
    SEAM(4);
    if (IN(5)) { gn_gate_rows(F, Ob, (const bf16*)(ws + WS_G)); }
    SEAM(5);
    if (IN(6)) {
        pg8::Gemm g{Ob, (const bf16*)(ws + WS_WOUT), 2048}; pg8::StaticOrder S; S.init(NTOK, D, F.G, (int)blockIdx.x);
        EpiBf16 E{(bf16*)(ws + WS_Y), D, nullptr};
        pg8::gemm_phase<EpiBf16, pg8::StaticOrder, false>(F.lds + RING_OFF, g, S, E);
    }
    SEAM(6);
    if (IN(7)) { rows_router(F, 0, args.in[I_X], (const bf16*)(ws + WS_Y), (bf16*)(ws + WS_U), args.in[I_NORMS], args.in[I_ROUTER], args.in[I_MBIAS]); }
    SEAM(7);
    if (IN(8)) { moe_gemm1(F, 0, 0); }
    SEAM(8);
    if (IN(9)) { moe_gemm2(F, 0, 0); }
    SEAM(9);
    if (IN(10)) { moe_gemm1(F, 0, 1); moe_combine(F, 0, 0, false, args.in[I_NORMS]); }
    SEAM(10);
    if (IN(11)) { moe_gemm2(F, 0, 1); }
    SEAM(11);
    if (IN(12)) { moe_combine(F, 0, 1, false, args.in[I_NORMS]); conv_moe_weights(F, 1, args.in[I_MW1], args.in[I_MW3], args.in[I_MW2], args.in[I_SW1], args.in[I_SW3], args.in[I_SW2]); }
    SEAM(12);
    if (IN(13)) {
        pg8::Gemm g{(const bf16*)(ws + WS_U), (const bf16*)(ws + WS_CW1), 1024}; pg8::StaticOrder S; S.init(NTOK, 2048, F.G, (int)blockIdx.x);
        EpiGLU E{(bf16*)(ws + WS_Z), args.in[I_CB1]};
        pg8::gemm_phase<EpiGLU, pg8::StaticOrder, false>(F.lds + RING_OFF, g, S, E);
    }
    SEAM(13);
    if (IN(14)) { dwconv_ln(F, (const bf16*)(ws + WS_Z), (bf16*)(ws + WS_C), args.in[I_CDW], args.in[I_CBDW], args.in[I_CLNG], args.in[I_CLNB]); }
    SEAM(14);
    if (IN(15)) {
        pg8::Gemm g{(const bf16*)(ws + WS_C), (const bf16*)(ws + WS_CW2), 1024}; pg8::StaticOrder S; S.init(NTOK, D, F.G, (int)blockIdx.x);
        EpiBf16 E{(bf16*)(ws + WS_Y1), D, args.in[I_CB2]};
        pg8::gemm_phase<EpiBf16, pg8::StaticOrder, false>(F.lds + RING_OFF, g, S, E);
    }
    SEAM(15);
    if (IN(16)) { rows_router(F, 1, F.out, (const bf16*)(ws + WS_Y1), (bf16*)(ws + WS_U), args.in[I_NORMS], args.in[I_ROUTER], args.in[I_MBIAS]); }
    SEAM(16);
    if (IN(17)) { moe_gemm1(F, 1, 0); }
    SEAM(17);
    if (IN(18)) { moe_gemm2(F, 1, 0); }
    SEAM(18);
    if (IN(19)) { moe_gemm1(F, 1, 1); moe_combine(F, 1, 0, true, args.in[I_NORMS]); }
    SEAM(19);
    if (IN(20)) { moe_gemm2(F, 1, 1); }
    SEAM(20);
    if (IN(21)) { moe_combine(F, 1, 1, true, args.in[I_NORMS]); }
#undef IN
#undef SEAM
}

extern "C" void kernel_launch(void* const* d_in, const int* in_sizes, int n_in, void* d_out, int out_size, void* d_ws, size_t ws_size, hipStream_t stream) {
    static int grid = 0;
    if (grid == 0) {
        if (n_in != 26 || in_sizes[0] != NTOK * D || out_size != NTOK * D || ws_size < WS_END) {
            fprintf(stderr, "kernel_launch: unexpected shapes / workspace (n_in %d, ws %zu, need %zu); nothing launched\n", n_in, ws_size, (size_t)WS_END); grid = -1; return; }
        int dev = 0, cus = 0, per_cu = 0;
        if (hipGetDevice(&dev) != hipSuccess || hipDeviceGetAttribute(&cus, hipDeviceAttributeMultiprocessorCount, dev) != hipSuccess) { grid = -1; return; }
        if (hipFuncSetAttribute((const void*)fwd_kernel, hipFuncAttributeMaxDynamicSharedMemorySize, LDS_BYTES) != hipSuccess) { fprintf(stderr, "kernel_launch: hipFuncSetAttribute failed\n"); grid = -1; return; }
        if (hipOccupancyMaxActiveBlocksPerMultiprocessor(&per_cu, (const void*)fwd_kernel, 512, LDS_BYTES) != hipSuccess || per_cu < 1) { fprintf(stderr, "kernel_launch: occupancy query says %d\n", per_cu); }
        (void)hipGetLastError();
        grid = cus;
    }
    if (grid < 0) return;
    (void)hipMemsetAsync((char*)d_ws + WS_CTL, 0, CTL_ZERO_BYTES, stream);
    Args a{};
    for (int i = 0; i < 26; ++i) a.in[i] = (const float*)d_in[i];
    a.out = (float*)d_out; a.ws = (unsigned char*)d_ws;
#if MK_ONE_LAUNCH
    a.ph_lo = 0; a.ph_hi = N_PHASES;
    hipLaunchKernelGGL(fwd_kernel, dim3(grid), dim3(512), LDS_BYTES, stream, a);
#else
    for (int p = 0; p < N_PHASES; ++p) { a.ph_lo = p; a.ph_hi = p + 1; hipLaunchKernelGGL(fwd_kernel, dim3(grid), dim3(512), LDS_BYTES, stream, a); }
#endif
}
```

```cpp
#include <hip/hip_runtime.h>
#include <cstdio>
#include <cstdint>

#define STAG_G1 0
#define STAG_G2 0
#define STAG_IN 0
#define STAG_PL 0
#ifndef MK_ONE_LAUNCH
#define MK_ONE_LAUNCH 1
#endif

#define GAS __attribute__((address_space(1)))
#define LAS __attribute__((address_space(3)))
typedef unsigned short bf16;
typedef unsigned v4u __attribute__((ext_vector_type(4)));
typedef unsigned v2u __attribute__((ext_vector_type(2)));
typedef float f32x4 __attribute__((ext_vector_type(4)));
typedef float f32x2 __attribute__((ext_vector_type(2)));
typedef float f32x16 __attribute__((ext_vector_type(16)));
typedef short bf16x8 __attribute__((ext_vector_type(8)));
typedef short s16x4 __attribute__((ext_vector_type(4)));
typedef GAS unsigned gu32;
#define RLX_AGENT __ATOMIC_RELAXED, __HIP_MEMORY_SCOPE_AGENT
#define LDS_WAIT() asm volatile("s_waitcnt lgkmcnt(0)" ::: "memory")
#define VM_WAIT() asm volatile("s_waitcnt vmcnt(0)" ::: "memory")
#define DI __device__ __forceinline__

constexpr int D = 1024, NB = 8, T = 4096, NTOK = NB * T, LCTX = 256, NCTX = NB * LCTX;
constexpr int NH = 4, DK = 256, DV = 512, VTOT = 2048, RIN = 6144;
constexpr int NE = 64, TOPK = 8, EH = 256;
constexpr int CH = 128, NCHUNK = T / CH;
constexpr int NSLICE = 1, SLTOK = NTOK / NSLICE;
constexpr int ECAP = SLTOK;
constexpr int NEX = NE + 1;
constexpr int ACT_ROUTED = SLTOK * TOPK + NE * 256;
constexpr float NORM_EPS = 1e-6f, LN_EPS = 1e-5f;

typedef __bf16 bf16x2_hw __attribute__((ext_vector_type(2)));
typedef float f32x2_hw __attribute__((ext_vector_type(2)));
DI unsigned cvt_pk_bf16(float lo, float hi) { const f32x2_hw v = {lo, hi}; const bf16x2_hw r = __builtin_convertvector(v, bf16x2_hw); return __builtin_bit_cast(unsigned, r); }
DI float bf_lo(unsigned u) { return __uint_as_float(u << 16); }
DI float bf_hi(unsigned u) { return __uint_as_float(u & 0xffff0000u); }
DI float bf2f(bf16 b) { return __uint_as_float(((unsigned)b) << 16); }
DI bf16 f2bf(float f) { return (bf16)(cvt_pk_bf16(f, 0.f) & 0xffffu); }
DI float wave_sum(float v) {
    int x = __builtin_bit_cast(int, v);
#define WS_STEP(ctrl, rmask) x = __builtin_bit_cast(int, __builtin_bit_cast(float, x) + __builtin_bit_cast(float, __builtin_amdgcn_update_dpp(0, x, ctrl, rmask, 0xf, false)))
    WS_STEP(0x111, 0xf); WS_STEP(0x112, 0xf); WS_STEP(0x114, 0xf); WS_STEP(0x118, 0xf); WS_STEP(0x142, 0xa); WS_STEP(0x143, 0xc);
#undef WS_STEP
    return __builtin_bit_cast(float, __builtin_amdgcn_readlane(x, 63));
}
DI float wave_max(float v) {
    int x = __builtin_bit_cast(int, v);
#define WM_STEP(ctrl, rmask) x = __builtin_bit_cast(int, fmaxf(__builtin_bit_cast(float, x), __builtin_bit_cast(float, __builtin_amdgcn_update_dpp((int)0xff800000, x, ctrl, rmask, 0xf, false))))
    WM_STEP(0x111, 0xf); WM_STEP(0x112, 0xf); WM_STEP(0x114, 0xf); WM_STEP(0x118, 0xf); WM_STEP(0x142, 0xa); WM_STEP(0x143, 0xc);
#undef WM_STEP
    return __builtin_bit_cast(float, __builtin_amdgcn_readlane(x, 63));
}
#define G8_DPP(x, ctrl) __builtin_bit_cast(float, __builtin_amdgcn_update_dpp(0, __builtin_bit_cast(int, x), ctrl, 0xf, 0xf, false))
DI float grp8_max(float x) { x = fmaxf(x, G8_DPP(x, 0xB1)); x = fmaxf(x, G8_DPP(x, 0x4E)); x = fmaxf(x, G8_DPP(x, 0x141)); return x; }
DI float grp8_sum(float x) { x += G8_DPP(x, 0xB1); x += G8_DPP(x, 0x4E); x += G8_DPP(x, 0x141); return x; }
DI float lane_xor(float v, int lane, int d) { return __builtin_bit_cast(float, __builtin_amdgcn_ds_bpermute((lane ^ d) << 2, __builtin_bit_cast(int, v))); }
DI float sigmoidf_(float x) { return __builtin_amdgcn_rcpf(1.f + __expf(-x)); }
DI float siluf_(float x) { return x * __builtin_amdgcn_rcpf(1.f + __expf(-x)); }

namespace pg8 {
constexpr int BM = 256, BK = 64, HALF = 128, HTB = HALF * BK * 2, STAGE_BYTES = 8 * HTB, NXCD = 8, WGM = 8;
DI int lds_byte(int r, int c) { const int st = (r >> 4) * 2 + (c >> 5), rr = r & 15, cc = c & 31, ob = rr * 64 + cc * 2; return st * 1024 + (ob ^ (((ob >> 9) & 1) << 5)); }
DI void stage_rc(int b, int& R, int& C) { const int st = b / 1024, sb = b % 1024, swz = sb ^ (((sb >> 9) & 1) << 5); R = (st >> 1) * 16 + swz / 64; C = (st & 1) * 32 + (swz % 64) / 2; }
DI int perm32(int rho) { const int n = rho >> 4, i = rho & 15; return 8 * (i >> 2) + 4 * n + (i & 3); }

struct Unit { int pm, pn, e0, e1; };
struct Gemm { const bf16* A; const bf16* Bt; int K; };

struct StaticOrder {
    int nM, nN, nwg, G, c;
    DI void init(int M, int N, int G_, int c_) { nM = M / BM; nN = N / BM; nwg = nM * nN; G = G_; c = c_; }
    DI bool next(int i, Unit& u) const {
        const long L = (long)i * G + c; if (L >= nwg) return false;
        int wgid = (int)L; { const int q = nwg / NXCD, r = nwg % NXCD, xcd = wgid % NXCD, off = wgid / NXCD; wgid = (xcd < r ? xcd * (q + 1) : r * (q + 1) + (xcd - r) * q) + off; }
        const int nig = WGM * nN, gid = wgid / nig, fm = gid * WGM, gsz = (nM - fm) < WGM ? (nM - fm) : WGM;
        u.pm = fm + ((wgid % nig) % gsz); u.pn = (wgid % nig) / gsz; u.e0 = 0; u.e1 = 0; return true;
    }
    DI int a_row(const Unit&, int) const { return 0; }
};

template <class Epi, class Sched, bool GATHER>
DI void gemm_phase(LAS unsigned char* lds, const Gemm g, const Sched& S, const Epi& E, const int tid, const int stagger_us = 0) {
    if (stagger_us > 0 && (S.c & 1)) {
#pragma unroll 1
        for (int i_ = 0; i_ < stagger_us / 2; ++i_) __builtin_amdgcn_s_sleep(64); }
    const int wid = __builtin_amdgcn_readfirstlane(tid >> 6), lane = tid & 63, wr = wid >> 2, wc = wid & 3, fr = lane & 15, fq = lane >> 4;
    const int K = g.K, nt = K / BK;
    unsigned voffB[2], vA[2][2], nvA[2][2]; int Rr[2], Cc[2];
#pragma unroll
    for (int i = 0; i < 2; ++i) { int R, C; stage_rc(tid * 16 + i * 8192, R, C); const int Rb = Epi::PERM ? ((R & ~31) + perm32(R & 31)) : R;
        voffB[i] = (unsigned)(Rb * K + C) * 2u; Rr[i] = R; Cc[i] = C; }
    const size_t kstep = (size_t)(BK * 2);
    const size_t hstep = (size_t)HALF * K * 2;
    const size_t tstep = 2 * hstep;
    const unsigned ldsw = (unsigned)wid * 1024u;
    const int aoff = lds_byte(wr * 64 + fr, fq * 8), boff = lds_byte(wc * 32 + fr, fq * 8);
#define PG8_SETV(u, v) do { _Pragma("unroll") for (int _h = 0; _h < 2; ++_h) _Pragma("unroll") for (int _i = 0; _i < 2; ++_i) \
        (v)[_h][_i] = GATHER ? (unsigned)(S.a_row((u), _h * 128 + Rr[_i]) * K + Cc[_i]) * 2u : (unsigned)((_h * 128 + Rr[_i]) * K + Cc[_i]) * 2u; } while (0)
#define PG8_SA(b, h) (((b) * 2 + (h)) * HTB)
#define PG8_SB(b, h) ((4 + (b) * 2 + (h)) * HTB)
#define PG8_STAGE(bufoff, gbase, voff) do { _Pragma("unroll") for (int _i = 0; _i < 2; ++_i) \
        __builtin_amdgcn_global_load_lds((const unsigned*)((const char*)(gbase) + (voff)[_i]), (LAS unsigned*)(lds + (bufoff) + ldsw + _i * 8192), 16, 0, 0); } while (0)
#define PG8_LDA(dst, b, h) do { _Pragma("unroll") for (int m = 0; m < 4; ++m) _Pragma("unroll") for (int k = 0; k < 2; ++k) dst[m][k] = *(const LAS bf16x8*)(lds + PG8_SA(b, h) + aoff + m * 2048 + k * 1024); } while (0)
#define PG8_LDB(dst, b, h) do { _Pragma("unroll") for (int n = 0; n < 2; ++n) _Pragma("unroll") for (int k = 0; k < 2; ++k) dst[n][k] = *(const LAS bf16x8*)(lds + PG8_SB(b, h) + boff + n * 2048 + k * 1024); } while (0)
#define PG8_MMA(ai, bj, At, Bt) do { __builtin_amdgcn_s_setprio(1); _Pragma("unroll") for (int m = 0; m < 4; ++m) _Pragma("unroll") for (int n = 0; n < 2; ++n) _Pragma("unroll") for (int k = 0; k < 2; ++k) \
        acc[ai][bj][m][n] = __builtin_amdgcn_mfma_f32_16x16x32_bf16(Bt[n][k], At[m][k], acc[ai][bj][m][n], 0, 0, 0); __builtin_amdgcn_s_setprio(0); } while (0)
#define PG8_WAIT_V(n) asm volatile("s_waitcnt vmcnt(" #n ")" ::: "memory")
#define PG8_WAIT_L(n) asm volatile("s_waitcnt lgkmcnt(" #n ")" ::: "memory")
#define PG8_BAR __builtin_amdgcn_s_barrier()
#define PG8_SCHED __builtin_amdgcn_sched_barrier(0)
    Unit cur, nxt; int ui = 0;
    if (!S.next(0, cur)) return;
    f32x4 acc[2][2][4][2];
#pragma unroll
    for (int a = 0; a < 2; ++a)
#pragma unroll
        for (int b = 0; b < 2; ++b)
#pragma unroll
            for (int m = 0; m < 4; ++m)
#pragma unroll
                for (int n = 0; n < 2; ++n) acc[a][b][m][n] = (f32x4){0.f, 0.f, 0.f, 0.f};
    bf16x8 At[4][2], B0[2][2], B1[2][2];
    PG8_SETV(cur, vA);
    const char* cA = GATHER ? (const char*)g.A : (const char*)g.A + (size_t)cur.pm * tstep; const char* cB = (const char*)g.Bt + (size_t)cur.pn * tstep;
    PG8_STAGE(PG8_SB(0, 0), cB, voffB); PG8_STAGE(PG8_SB(0, 1), cB + hstep, voffB); PG8_STAGE(PG8_SA(0, 0), cA, vA[0]); PG8_STAGE(PG8_SA(0, 1), cA, vA[1]);
    if (wr == 1) PG8_BAR;
    PG8_WAIT_V(2); PG8_BAR;
    PG8_STAGE(PG8_SB(1, 0), cB + kstep, voffB); PG8_STAGE(PG8_SA(1, 0), cA + kstep, vA[0]); PG8_STAGE(PG8_SB(1, 1), cB + hstep + kstep, voffB);
    PG8_WAIT_V(6); PG8_BAR;
    for (;;) {
        const bool has_next = S.next(ui + 1, nxt);
        const char* nA = has_next ? (GATHER ? (const char*)g.A : (const char*)g.A + (size_t)nxt.pm * tstep) : cA; const char* nB = has_next ? (const char*)g.Bt + (size_t)nxt.pn * tstep : cB;
        if (GATHER) { if (has_next) { PG8_SETV(nxt, nvA); } else {
#pragma unroll
            for (int h = 0; h < 2; ++h)
#pragma unroll
                for (int i = 0; i < 2; ++i) nvA[h][i] = vA[h][i]; } }
#pragma unroll 1
        for (int t = 0; t < nt; t += 2) {
            const bool last = (t == nt - 2);
            const char* a1 = cA + (size_t)(t + 1) * kstep;
            const char* a2 = last ? nA : cA + (size_t)(t + 2) * kstep; const char* b2 = last ? nB : cB + (size_t)(t + 2) * kstep;
            const char* a3 = a2 + kstep; const char* b3 = b2 + kstep;
            unsigned s2[2][2];
#pragma unroll
            for (int h = 0; h < 2; ++h)
#pragma unroll
                for (int i = 0; i < 2; ++i) s2[h][i] = (GATHER && last) ? nvA[h][i] : vA[h][i];
            PG8_LDB(B0, 0, 0); PG8_LDB(B1, 0, 1); PG8_SCHED; PG8_LDA(At, 0, 0); PG8_STAGE(PG8_SA(1, 1), a1, vA[1]);
            PG8_WAIT_V(8); PG8_WAIT_L(0); PG8_BAR; PG8_MMA(0, 0, At, B0); PG8_MMA(0, 1, At, B1); PG8_BAR; PG8_SCHED;
            PG8_LDA(At, 0, 1); PG8_STAGE(PG8_SB(0, 0), b2, voffB); PG8_STAGE(PG8_SB(0, 1), b2 + hstep, voffB); PG8_STAGE(PG8_SA(0, 0), a2, s2[0]);
            PG8_WAIT_V(8); PG8_WAIT_L(0); PG8_BAR; PG8_MMA(1, 0, At, B0); PG8_MMA(1, 1, At, B1); PG8_BAR; PG8_SCHED;
            PG8_LDB(B0, 1, 0); PG8_LDB(B1, 1, 1); PG8_SCHED; PG8_LDA(At, 1, 0); PG8_STAGE(PG8_SA(0, 1), a2, s2[1]);
            PG8_WAIT_V(8); PG8_WAIT_L(0); PG8_BAR; PG8_MMA(0, 0, At, B0); PG8_MMA(0, 1, At, B1); PG8_BAR; PG8_SCHED;
            PG8_LDA(At, 1, 1); PG8_STAGE(PG8_SB(1, 0), b3, voffB); PG8_STAGE(PG8_SB(1, 1), b3 + hstep, voffB); PG8_STAGE(PG8_SA(1, 0), a3, s2[0]);
            PG8_WAIT_V(8); PG8_WAIT_L(0); PG8_BAR; PG8_MMA(1, 0, At, B0); PG8_MMA(1, 1, At, B1); PG8_BAR; PG8_SCHED;
        }
        if (wr == 0) PG8_BAR;
        { int tz = tid; asm volatile("" : "+v"(tz));
          const int wid2 = __builtin_amdgcn_readfirstlane(tz >> 6), lane2 = tz & 63;
          E(acc, cur, wid2 >> 2, wid2 & 3, lane2 & 15, lane2 >> 4); }
        if (!has_next) break;
#pragma unroll
        for (int a = 0; a < 2; ++a)
#pragma unroll
            for (int b = 0; b < 2; ++b)
#pragma unroll
                for (int m = 0; m < 4; ++m)
#pragma unroll
                    for (int n = 0; n < 2; ++n) acc[a][b][m][n] = (f32x4){0.f, 0.f, 0.f, 0.f};
        cur = nxt; cA = nA; cB = nB; ++ui;
        if (GATHER) {
#pragma unroll
            for (int h = 0; h < 2; ++h)
#pragma unroll
                for (int i = 0; i < 2; ++i) vA[h][i] = nvA[h][i]; }
        if (wr == 1) PG8_BAR;
    }
    PG8_WAIT_V(0);
    PG8_BAR;
#undef PG8_SETV
#undef PG8_SA
#undef PG8_SB
#undef PG8_STAGE
#undef PG8_LDA
#undef PG8_LDB
#undef PG8_MMA
#undef PG8_WAIT_V
#undef PG8_WAIT_L
#undef PG8_BAR
#undef PG8_SCHED
}
}
using pg8::Unit;

constexpr size_t MiB = 1u << 20;
constexpr size_t WS_CTL = 0, CTL_ZERO_BYTES = 2 * MiB;
constexpr size_t WS_MOD = 2 * MiB;
constexpr size_t WS_ROPE = 4 * MiB;
constexpr size_t WS_WIN = 10 * MiB, WS_WOUT = 22 * MiB, WS_CW1 = 26 * MiB, WS_CW2 = 30 * MiB;
constexpr size_t WS_W13 = 32 * MiB, WS_W2 = 97 * MiB;
constexpr size_t WS_LIST = 130 * MiB;
constexpr size_t LIST_ARR = (size_t)NEX * ECAP * 4, LIST_SLICE = 3 * LIST_ARR;
constexpr size_t WS_BIG = 160 * MiB;
constexpr size_t WS_Q = WS_BIG, WS_K = WS_Q + 64 * MiB, WS_V = WS_K + 64 * MiB, WS_G = WS_V + 128 * MiB;
constexpr size_t WS_KC = 544 * MiB, WS_VC = 548 * MiB, WS_P = 560 * MiB;
constexpr size_t WS_Y = WS_BIG;
constexpr size_t WS_ACT = WS_BIG;
constexpr size_t WS_Y2 = WS_BIG + 152 * MiB;
constexpr size_t WS_U = WS_Y2;
constexpr size_t WS_UC = WS_BIG;
constexpr size_t WS_Z = WS_BIG + 64 * MiB, WS_C = WS_BIG + 128 * MiB, WS_Y1 = WS_BIG + 216 * MiB;
constexpr size_t WS_END = 600 * MiB;
static_assert(WS_LIST + NSLICE * LIST_SLICE <= WS_BIG, "lists");
static_assert(WS_ACT + (size_t)(ACT_ROUTED + SLTOK) * 512 <= WS_Y2, "act");
static_assert(WS_Y2 + (size_t)SLTOK * 9 * 1024 <= WS_END, "y2");
static_assert(WS_W13 + (size_t)NEX * 512 * 1024 * 2 <= WS_W2 && WS_W2 + (size_t)NEX * 1024 * 256 * 2 <= WS_LIST, "moe w");
constexpr int CW_TMO = 0, CW_CODE = 1;
constexpr int CW_BAR = 4096;
constexpr int CW_CNT = 16384;
DI int cnt_word(int layer, int slice, int e) { return CW_CNT + ((layer * NSLICE + slice) * NE + e) * 16; }

constexpr int RING_OFF = 0, RING_BYTES = 131072;
constexpr int LDSCTL_OFF = 148480, MISC_OFF = LDSCTL_OFF + 1024;
constexpr int LDS_BYTES = 152576;

#define XB_TMO      128
#define XB_XCNT(j)  (256  + 64 * (j))
#define XB_XSUB(j)  (1280 + 64 * (j))
#define XB_XGEN(j)  (2304 + 64 * (j))
#define XB_TOP      3328
#define XB_TOPGEN   3392
#define XCD_BAR_WORDS 3456
#define XB_SPIN_CAP (1u << 18)
DI unsigned xb_ld(unsigned* p)              { return __hip_atomic_load(p, __ATOMIC_RELAXED, __HIP_MEMORY_SCOPE_AGENT); }
DI unsigned xb_add(unsigned* p, unsigned v) { return __hip_atomic_fetch_add(p, v, __ATOMIC_RELAXED, __HIP_MEMORY_SCOPE_AGENT); }
DI unsigned xb_xcc_id() { return (unsigned)__builtin_amdgcn_s_getreg((3 << 11) | 20) & 0xFu; }
#define XB_SPIN(cond, bar) do { unsigned _sp = 0; while (cond) { __builtin_amdgcn_s_sleep(1); \
    if ((++_sp & 255u) == 0u) { if (xb_ld(&(bar)[XB_TMO])) break; if (_sp > XB_SPIN_CAP) { atomicAdd(&(bar)[XB_TMO], 1u); break; } } } } while (0)
struct XcdBarrier { unsigned* bar; unsigned x; volatile LAS unsigned* st; };
DI XcdBarrier xcd_barrier_post(unsigned* bar, volatile LAS unsigned* st) {
    XcdBarrier b; b.bar = bar; b.x = xb_xcc_id(); b.st = st;
    if (threadIdx.x == 0) (void)xb_add(&bar[XB_XCNT(b.x)], 1u);
    return b;
}
DI void xcd_barrier_complete(unsigned* bar, unsigned x, unsigned& nloc, unsigned& nx) {
    const unsigned G = gridDim.x * gridDim.y * gridDim.z;
    unsigned sum, cnt, mine, sp = 0u;
    for (;;) {
        sum = 0u; cnt = 0u; mine = 0u;
#pragma unroll
        for (unsigned j = 0; j < 16; ++j) { const unsigned c = xb_ld(&bar[XB_XCNT(j)]); sum += c; cnt += (c > 0u) ? 1u : 0u; mine = (j == x) ? c : mine; }
        if (sum == G) break;
        __builtin_amdgcn_s_sleep(1);
        if ((++sp & 255u) == 0u) { if (xb_ld(&bar[XB_TMO])) break; if (sp > XB_SPIN_CAP) { atomicAdd(&bar[XB_TMO], 1u); break; } }
    }
    nloc = mine > 0u ? mine : 1u; nx = cnt > 0u ? cnt : 1u;
}
DI void xcd_barrier(const XcdBarrier& b, const bool leader) {
    asm volatile("s_waitcnt vmcnt(0)" ::: "memory");
    __syncthreads();
    if (leader) {
        unsigned* bar = b.bar;
        __builtin_amdgcn_s_waitcnt(0);
        unsigned nloc = b.st[0], nx = b.st[1];
        if (nloc == 0u) { xcd_barrier_complete(bar, b.x, nloc, nx); b.st[0] = nloc; b.st[1] = nx; }
        const unsigned old = xb_add(&bar[XB_XSUB(b.x)], 1u);
        const unsigned gen = old / nloc;
        if (old + 1u == (gen + 1u) * nloc) {
            __builtin_amdgcn_fence(__ATOMIC_RELEASE, "agent");
            asm volatile("s_waitcnt vmcnt(0)" ::: "memory");
            const unsigned og = xb_add(&bar[XB_TOP], 1u);
            const unsigned tg = og / nx;
            if (og + 1u == (tg + 1u) * nx) xb_add(&bar[XB_TOPGEN], 1u);
            else XB_SPIN(xb_ld(&bar[XB_TOPGEN]) == tg, bar);
            __builtin_amdgcn_fence(__ATOMIC_ACQUIRE, "agent");
            xb_add(&bar[XB_XGEN(b.x)], 1u);
            asm volatile("s_waitcnt vmcnt(0)" ::: "memory");
        } else {
            XB_SPIN(xb_ld(&bar[XB_XGEN(b.x)]) == gen, bar);
            __builtin_amdgcn_fence(__ATOMIC_ACQUIRE, "agent");
            asm volatile("s_waitcnt vmcnt(0)" ::: "memory");
        }
    }
    __syncthreads();
}

struct Frame {
    LAS unsigned char* lds;
    volatile LAS unsigned* MISC;
    unsigned* ctl;
    unsigned char* ws;
    int tid, lane, wave, vcu, G;
    float* out;
};
enum { I_X = 0, I_C, I_CTX, I_CCTX, I_MODW, I_MODB, I_NORMS, I_RWIN, I_RWOUT, I_RDECAY, I_CW1, I_CB1, I_CDW, I_CBDW, I_CLNG, I_CLNB, I_CW2, I_CB2,
       I_ROUTER, I_MBIAS, I_MW1, I_MW3, I_MW2, I_SW1, I_SW3, I_SW2 };

typedef const f32x4 (&AccRef)[2][2][4][2];
DI void st16(bf16* p, unsigned a, unsigned b, unsigned c, unsigned d) { v4u o; o.x = a; o.y = b; o.z = c; o.w = d; *(GAS v4u*)p = o; }

struct EpiQKVG {
    static constexpr bool PERM = true;
    unsigned char* ws;
    DI void operator()(AccRef acc, const Unit& u, int wr, int wc, int fr, int fq) const {
        const bool ctx = u.pm >= 128;
        const int rbase = u.pm * 256 + wr * 64 + fr, cw = wc * 32 + 8 * fq, pn = u.pn;
        if (pn < 8) {
            const bool isq = pn < 4; const int head = pn & 3;
            const size_t doff = ctx ? WS_KC : (isq ? WS_Q : WS_K);
            bf16* dst = (bf16*)(ws + doff);
            const int bb = ctx ? u.pm - 128 : u.pm >> 4, nch = ctx ? 2 : NCHUNK;
            const float* cs = (const float*)(ws + WS_ROPE) + (ctx ? 2 * T * 128 : 0);
            const int snoff = ctx ? LCTX * 128 : T * 128;
            const float sc = isq ? 0.0625f : 1.f;
#pragma unroll
            for (int ai = 0; ai < 2; ++ai)
#pragma unroll
                for (int m = 0; m < 4; ++m) {
                    const int row = rbase + ai * 128 + m * 16, rr = ctx ? row - NTOK : row, t = ctx ? (rr & (LCTX - 1)) : (row & (T - 1));
#pragma unroll
                    for (int bj = 0; bj < 2; ++bj) {
                        const int p0 = bj * 64 + wc * 16 + 4 * fq;
                        const f32x4 c = *(const GAS f32x4*)(cs + (size_t)t * 128 + p0), s = *(const GAS f32x4*)(cs + snoff + (size_t)t * 128 + p0);
                        const f32x4 v0 = acc[ai][bj][m][0], v1 = acc[ai][bj][m][1];
                        const float o0 = (v0[0] * c[0] - v0[1] * s[0]) * sc, o1 = (v0[0] * s[0] + v0[1] * c[0]) * sc;
                        const float o2 = (v0[2] * c[1] - v0[3] * s[1]) * sc, o3 = (v0[2] * s[1] + v0[3] * c[1]) * sc;
                        const float o4 = (v1[0] * c[2] - v1[1] * s[2]) * sc, o5 = (v1[0] * s[2] + v1[1] * c[2]) * sc;
                        const float o6 = (v1[2] * c[3] - v1[3] * s[3]) * sc, o7 = (v1[2] * s[3] + v1[3] * c[3]) * sc;
                        const int chunk = ctx ? ai : ((2 * u.pm + ai) & (NCHUNK - 1)), itq = wr * 2 + (m >> 1), rq = (m & 1) * 16 + fr, ksq = bj * 8 + wc * 2 + (fq >> 1);
                        st16(dst + ((((size_t)(bb * nch + chunk) * NH + head) * 4 + itq) * 16 + ksq) * 512 + (rq + 32 * (fq & 1)) * 8, cvt_pk_bf16(o0, o1), cvt_pk_bf16(o2, o3), cvt_pk_bf16(o4, o5), cvt_pk_bf16(o6, o7));
                    }
                }
        } else {
            const bool isg = pn >= 16; const int ct = (pn - (isg ? 16 : 8)) * 256;
            const size_t doff = isg ? WS_G : (ctx ? WS_VC : WS_V);
            bf16* dst = (bf16*)(ws + doff);
#pragma unroll
            for (int ai = 0; ai < 2; ++ai)
#pragma unroll
                for (int m = 0; m < 4; ++m) {
                    const int row = rbase + ai * 128 + m * 16, rr = ctx ? row - NTOK : row;
#pragma unroll
                    for (int bj = 0; bj < 2; ++bj) {
                        f32x4 v0 = acc[ai][bj][m][0], v1 = acc[ai][bj][m][1];
                        if (isg) {
#pragma unroll
                            for (int e = 0; e < 4; ++e) { v0[e] = siluf_(v0[e]); v1[e] = siluf_(v1[e]); }
                        }
                        st16(dst + (size_t)rr * 2048 + ct + bj * 128 + cw, cvt_pk_bf16(v0[0], v0[1]), cvt_pk_bf16(v0[2], v0[3]), cvt_pk_bf16(v1[0], v1[1]), cvt_pk_bf16(v1[2], v1[3]));
                    }
                }
        }
    }
};
struct InprojOrder {
    pg8::StaticOrder so; int G, c;
    DI void init(int G_, int c_) { so.init(NTOK, RIN, G_, c_); G = G_; c = c_; }
    DI bool next(int i, Unit& u) const {
        const int L = i * G + c;
        if (L < 3072) return so.next(i, u);
        const int l2 = L - 3072; if (l2 >= 96) return false;
        u.pm = 128 + l2 / 12; u.pn = 4 + l2 % 12; u.e0 = 0; u.e1 = 0; return true;
    }
    DI int a_row(const Unit&, int) const { return 0; }
};
struct EpiBf16 {
    static constexpr bool PERM = true;
    bf16* O; int ldc; const float* bias;
    DI void operator()(AccRef acc, const Unit& u, int wr, int wc, int fr, int fq) const {
        const int rbase = u.pm * 256 + wr * 64 + fr, cbase = u.pn * 256 + wc * 32 + 8 * fq;
#pragma unroll
        for (int bj = 0; bj < 2; ++bj) {
            f32x4 b0 = (f32x4){0.f, 0.f, 0.f, 0.f}, b1 = b0;
            if (bias) { b0 = *(const GAS f32x4*)(bias + cbase + bj * 128); b1 = *(const GAS f32x4*)(bias + cbase + bj * 128 + 4); }
#pragma unroll
            for (int ai = 0; ai < 2; ++ai)
#pragma unroll
                for (int m = 0; m < 4; ++m) {
                    const f32x4 v0 = acc[ai][bj][m][0] + b0, v1 = acc[ai][bj][m][1] + b1;
                    st16(O + (size_t)(rbase + ai * 128 + m * 16) * ldc + cbase + bj * 128, cvt_pk_bf16(v0[0], v0[1]), cvt_pk_bf16(v0[2], v0[3]), cvt_pk_bf16(v1[0], v1[1]), cvt_pk_bf16(v1[2], v1[3]));
                }
        }
    }
};
struct EpiGLU {
    static constexpr bool PERM = true;
    bf16* Z; const float* b1;
    DI void operator()(AccRef acc, const Unit& u, int wr, int wc, int fr, int fq) const {
        const int rbase = u.pm * 256 + wr * 64 + fr, cc = u.pn * 128 + wc * 32 + 8 * fq;
        const f32x4 ba0 = *(const GAS f32x4*)(b1 + cc), ba1 = *(const GAS f32x4*)(b1 + cc + 4), bg0 = *(const GAS f32x4*)(b1 + 1024 + cc), bg1 = *(const GAS f32x4*)(b1 + 1024 + cc + 4);
#pragma unroll
        for (int ai = 0; ai < 2; ++ai)
#pragma unroll
            for (int m = 0; m < 4; ++m) {
                const f32x4 a0 = acc[ai][0][m][0] + ba0, a1 = acc[ai][0][m][1] + ba1, g0 = acc[ai][1][m][0] + bg0, g1 = acc[ai][1][m][1] + bg1;
                f32x4 o0, o1;
#pragma unroll
                for (int e = 0; e < 4; ++e) { o0[e] = a0[e] * sigmoidf_(g0[e]); o1[e] = a1[e] * sigmoidf_(g1[e]); }
                st16(Z + (size_t)(rbase + ai * 128 + m * 16) * 1024 + cc, cvt_pk_bf16(o0[0], o0[1]), cvt_pk_bf16(o0[2], o0[3]), cvt_pk_bf16(o1[0], o1[1]), cvt_pk_bf16(o1[2], o1[3]));
            }
    }
};
struct MoeOrder {
    const LAS int* cum; const LAS int* cnt; const LAS int* rb; const LAS unsigned char* eob; const int* ltok; int npn, G, c, total;
    DI bool next(int i, Unit& u) const {
        const int L = i * G + c; if (L >= total) return false;
        const int blk = L / npn, sub = L - blk * npn;
        const int e = eob[blk];
        const int bi = blk - cum[e];
        u.pm = blk; u.pn = e * npn + sub; const int left = cnt[e] - bi * 256; u.e1 = left < 256 ? left : 256;
        u.e0 = ltok ? e * ECAP + bi * 256 : rb[e] + bi * 256;
        return true;
    }
    DI int a_row(const Unit& u, int r) const { return r < u.e1 ? ltok[u.e0 + r] : 0; }
};
struct EpiSwiGLU {
    static constexpr bool PERM = true;
    bf16* ACT;
    DI void operator()(AccRef acc, const Unit& u, int wr, int wc, int fr, int fq) const {
        const int rbase = u.pm * 256 + wr * 64 + fr, cc = (u.pn & 1) * 128 + wc * 32 + 8 * fq;
#pragma unroll
        for (int ai = 0; ai < 2; ++ai)
#pragma unroll
            for (int m = 0; m < 4; ++m) {
                const f32x4 a0 = acc[ai][0][m][0], a1 = acc[ai][0][m][1], g0 = acc[ai][1][m][0], g1 = acc[ai][1][m][1];
                f32x4 o0, o1;
#pragma unroll
                for (int e = 0; e < 4; ++e) { o0[e] = siluf_(a0[e]) * g0[e]; o1[e] = siluf_(a1[e]) * g1[e]; }
                st16(ACT + (size_t)(rbase + ai * 128 + m * 16) * 256 + cc, cvt_pk_bf16(o0[0], o0[1]), cvt_pk_bf16(o0[2], o0[3]), cvt_pk_bf16(o1[0], o1[1]), cvt_pk_bf16(o1[2], o1[3]));
            }
    }
};
struct EpiMoeOut {
    static constexpr bool PERM = true;
    unsigned char* Y2; int nostore;
    DI void operator()(AccRef acc, const Unit& u, int wr, int wc, int fr, int fq) const {
        const int ch = ((u.pn & 3) * 16 + wc * 4 + fq) * 16;
        if (nostore) { if (acc[0][0][0][0][0] != 12345.678f || acc[1][1][3][1][3] != 321.f) return; }
#pragma unroll
        for (int ai = 0; ai < 2; ++ai)
#pragma unroll
            for (int m = 0; m < 4; ++m) {
                const int r = ai * 128 + wr * 64 + m * 16 + fr;
                if (r < u.e1) {
                    unsigned pk[4];
#pragma unroll
                    for (int bj = 0; bj < 2; ++bj) {
                        const f32x4 v0 = acc[ai][bj][m][0], v1 = acc[ai][bj][m][1];
                        int p0 = __builtin_amdgcn_cvt_pk_fp8_f32(v0[0], v0[1], 0, false); p0 = __builtin_amdgcn_cvt_pk_fp8_f32(v0[2], v0[3], p0, true);
                        int p1 = __builtin_amdgcn_cvt_pk_fp8_f32(v1[0], v1[1], 0, false); p1 = __builtin_amdgcn_cvt_pk_fp8_f32(v1[2], v1[3], p1, true);
                        pk[2 * bj] = (unsigned)p0; pk[2 * bj + 1] = (unsigned)p1;
                    }
                    *(GAS v4u*)(Y2 + (size_t)(u.e0 + r) * 1024 + ch) = (v4u){pk[0], pk[1], pk[2], pk[3]};
                }
            }
    }
};

struct TrItem { const float* src; bf16* dst; int ldsrc, Kd; };
DI void tr_load(const TrItem& t, float (&tv)[32], int lane) {
#pragma unroll
    for (int i = 0; i < 32; ++i) { const int kk = 2 * i + (lane >> 5); tv[i] = t.src[(size_t)kk * t.ldsrc + (lane & 31)]; }
}
DI void tr_store(const TrItem& t, const float (&tv)[32], LAS float* scr, int lane) {
#pragma unroll
    for (int i = 0; i < 32; ++i) { const int kk = 2 * i + (lane >> 5); scr[kk * 33 + (lane & 31)] = tv[i]; }
    LDS_WAIT(); asm volatile("" ::: "memory");
    const int c = lane & 7;
#pragma unroll
    for (int j = 0; j < 4; ++j) { const int n = (lane >> 3) + 8 * j; const LAS float* s = scr + (8 * c) * 33 + n;
        v4u o; o.x = cvt_pk_bf16(s[0 * 33], s[1 * 33]); o.y = cvt_pk_bf16(s[2 * 33], s[3 * 33]); o.z = cvt_pk_bf16(s[4 * 33], s[5 * 33]); o.w = cvt_pk_bf16(s[6 * 33], s[7 * 33]);
        *(GAS v4u*)(t.dst + (size_t)n * t.Kd + 8 * c) = o; }
    LDS_WAIT(); asm volatile("" ::: "memory");
}
DI TrItem tr_mk(const float* src, int ldsrc, int k0, int scol0, bf16* dst, int Kd, int drow0) { TrItem t; t.src = src + (size_t)k0 * ldsrc + scol0; t.dst = dst + (size_t)drow0 * Kd + k0; t.ldsrc = ldsrc; t.Kd = Kd; return t; }
template <class MK> DI void tr_run(int it0, int step, int n, LAS float* scr, int lane, MK mk) {
    float ta[32], tb[32];
    TrItem ia, ib;
    if (it0 < n) { ia = mk(it0); tr_load(ia, ta, lane); }
    for (int it = it0; it < n; it += 2 * step) {
        const bool hb = it + step < n;
        if (hb) { ib = mk(it + step); tr_load(ib, tb, lane); }
        tr_store(ia, ta, scr, lane);
        if (hb) {
            if (it + 2 * step < n) { ia = mk(it + 2 * step); tr_load(ia, ta, lane); }
            tr_store(ib, tb, scr, lane);
        }
    }
}
DI void conv_moe_weights(Frame& F, int layer, const float* mw1, const float* mw3, const float* mw2, const float* sw1, const float* sw3, const float* sw2) {
    LAS float* scr = (LAS float*)(F.lds + RING_OFF + F.wave * 16384);
    const int gw = F.vcu * 8 + F.wave, NGW = F.G * 8;
    bf16* W13 = (bf16*)(F.ws + WS_W13); bf16* W2 = (bf16*)(F.ws + WS_W2);
    constexpr int I13 = 16 * 16, I2 = 4 * 32, PER = I13 + I2;
    tr_run(gw, NGW, NEX * PER, scr, F.lane, [&](int it) -> TrItem {
        const int e = it / PER, r = it - e * PER;
        if (r < I13) {
            const int kb = r >> 4, nb = r & 15;
            const float* s1 = e < NE ? mw1 + ((size_t)(layer * NE + e) << 18) : sw1 + ((size_t)layer << 18);
            const float* s3 = e < NE ? mw3 + ((size_t)(layer * NE + e) << 18) : sw3 + ((size_t)layer << 18);
            const float* src = (nb & 7) < 4 ? s1 : s3;
            return tr_mk(src, 256, kb * 64, 128 * (nb >> 3) + 32 * (nb & 3), W13, 1024, e * 512 + nb * 32);
        } else {
            const int r2 = r - I13, kb = r2 >> 5, nb = r2 & 31;
            const float* src = e < NE ? mw2 + ((size_t)(layer * NE + e) << 18) : sw2 + ((size_t)layer << 18);
            return tr_mk(src, 1024, kb * 64, nb * 32, W2, 256, e * 1024 + nb * 32);
        }
    });
}
DI void conv_small_weights(Frame& F, const float* rwin, const float* rwout, const float* cw1, const float* cw2) {
    LAS float* scr = (LAS float*)(F.lds + RING_OFF + F.wave * 16384);
    const int gw = F.vcu * 8 + F.wave, NGW = F.G * 8;
    constexpr int I_IN = 16 * 192, I_OUT = 32 * 32, I_C1 = 16 * 64, I_C2 = 16 * 32, TOT = I_IN + I_OUT + I_C1 + I_C2;
    unsigned char* ws = F.ws;
    tr_run(gw, NGW, TOT, scr, F.lane, [&](int it) -> TrItem {
        int r = it;
        if (r < I_IN) { const int kb = r / 192, nb = r % 192; return tr_mk(rwin, RIN, kb * 64, nb * 32, (bf16*)(ws + WS_WIN), 1024, nb * 32); } r -= I_IN;
        if (r < I_OUT) { const int kb = r >> 5, nb = r & 31; return tr_mk(rwout, 1024, kb * 64, nb * 32, (bf16*)(ws + WS_WOUT), 2048, nb * 32); } r -= I_OUT;
        if (r < I_C1) { const int kb = r >> 6, nb = r & 63; const int sc0 = ((nb & 7) < 4 ? 0 : 1024) + 128 * (nb >> 3) + 32 * (nb & 3);
            return tr_mk(cw1, 2048, kb * 64, sc0, (bf16*)(ws + WS_CW1), 1024, nb * 32); } r -= I_C1;
        { const int kb = r >> 5, nb = r & 31; return tr_mk(cw2, 1024, kb * 64, nb * 32, (bf16*)(ws + WS_CW2), 1024, nb * 32); }
    });
}
DI void rope_tables(Frame& F) {
    float* csL = (float*)(F.ws + WS_ROPE); float* snL = csL + T * 128; float* csC = snL + T * 128; float* snC = csC + LCTX * 128;
    const int gt = F.vcu * 512 + F.tid, NT = F.G * 512;
    for (int i = gt; i < (T + LCTX) * 128; i += NT) {
        const int t = i >> 7, p = i & 127;
        int ax, ii, dd; if (p < 32) { ax = 0; ii = p; dd = 64; } else if (p < 80) { ax = 1; ii = p - 32; dd = 96; } else { ax = 2; ii = p - 80; dd = 96; }
        const float inv = exp2f(-13.287712379549449f * (float)(2 * ii) / (float)dd);
        int pos;
        if (t < T) pos = ax == 0 ? LCTX : (ax == 1 ? (t >> 6) : (t & 63)); else pos = ax == 0 ? (t - T) : 0;
        const float ang = (float)pos * inv;
        const float rev = ang * 0.15915494309189535f;
        const float fr = rev - floorf(rev);
        const float s = __builtin_amdgcn_sinf(fr), c = __builtin_amdgcn_cosf(fr);
        if (t < T) { csL[i] = c; snL[i] = s; } else { csC[i - T * 128] = c; snC[i - T * 128] = s; }
    }
}
DI void mod_vectors(Frame& F, const float* cin, const float* cctx, const float* modw, const float* modb) {
    LAS float* sl = (LAS float*)(F.lds + RING_OFF);
    LAS float* red = sl + 9 * 1024;
    if (F.vcu >= 192) return;
    for (int i = F.tid; i < 9 * 1024; i += 512) { const float v = i < 8192 ? cin[i] : cctx[i - 8192]; sl[i] = siluf_(v); }
    __syncthreads();
    float* MOD = (float*)(F.ws + WS_MOD);
    for (int it = F.vcu; it < 192; it += F.G) {
        const int l = it / 96, cb = (it % 96) * 64;
        const float* w = modw + (size_t)l * 1024 * 6144 + cb + F.lane;
        float a[9];
#pragma unroll
        for (int b = 0; b < 9; ++b) a[b] = 0.f;
        const int k0 = F.wave * 128;
#pragma unroll 8
        for (int k = 0; k < 128; ++k) { const float wv = w[(size_t)(k0 + k) * 6144];
#pragma unroll
            for (int b = 0; b < 9; ++b) a[b] += sl[b * 1024 + k0 + k] * wv; }
#pragma unroll
        for (int b = 0; b < 9; ++b) red[(F.wave * 9 + b) * 64 + F.lane] = a[b];
        __syncthreads();
        for (int o = F.tid; o < 9 * 64; o += 512) { const int b = o >> 6, c = o & 63; float s = modb[l * 6144 + cb + c];
#pragma unroll
            for (int w8 = 0; w8 < 8; ++w8) s += red[(w8 * 9 + b) * 64 + c];
            MOD[(size_t)(l * 9 + b) * 6144 + cb + c] = s; }
        __syncthreads();
    }
}

DI void ld_row_f32(const float* p, int lane, float (&v)[16]) {
#pragma unroll
    for (int j = 0; j < 2; ++j) { const f32x4 a = *(const GAS f32x4*)(p + 512 * j + 8 * lane), b = *(const GAS f32x4*)(p + 512 * j + 8 * lane + 4);
#pragma unroll
        for (int e = 0; e < 4; ++e) { v[8 * j + e] = a[e]; v[8 * j + 4 + e] = b[e]; } }
}
DI void st_row_f32(float* p, int lane, const float (&v)[16]) {
#pragma unroll
    for (int j = 0; j < 2; ++j) { *(GAS f32x4*)(p + 512 * j + 8 * lane) = (f32x4){v[8 * j], v[8 * j + 1], v[8 * j + 2], v[8 * j + 3]}; *(GAS f32x4*)(p + 512 * j + 8 * lane + 4) = (f32x4){v[8 * j + 4], v[8 * j + 5], v[8 * j + 6], v[8 * j + 7]}; }
}
DI void ld_row_bf16(const bf16* p, int lane, float (&v)[16]) {
#pragma unroll
    for (int j = 0; j < 2; ++j) { const v4u a = *(const GAS v4u*)(p + 512 * j + 8 * lane);
        v[8 * j + 0] = bf_lo(a.x); v[8 * j + 1] = bf_hi(a.x); v[8 * j + 2] = bf_lo(a.y); v[8 * j + 3] = bf_hi(a.y); v[8 * j + 4] = bf_lo(a.z); v[8 * j + 5] = bf_hi(a.z); v[8 * j + 6] = bf_lo(a.w); v[8 * j + 7] = bf_hi(a.w); }
}
DI void ld_row_fp8(const unsigned char* p, int lane, float (&v)[16]) {
#pragma unroll
    for (int j = 0; j < 2; ++j) { const v2u a = *(const GAS v2u*)(p + 512 * j + 8 * lane);
        const f32x2 d0 = __builtin_amdgcn_cvt_pk_f32_fp8((int)a.x, false), d1 = __builtin_amdgcn_cvt_pk_f32_fp8((int)a.x, true), d2 = __builtin_amdgcn_cvt_pk_f32_fp8((int)a.y, false), d3 = __builtin_amdgcn_cvt_pk_f32_fp8((int)a.y, true);
        v[8 * j + 0] = d0[0]; v[8 * j + 1] = d0[1]; v[8 * j + 2] = d1[0]; v[8 * j + 3] = d1[1]; v[8 * j + 4] = d2[0]; v[8 * j + 5] = d2[1]; v[8 * j + 6] = d3[0]; v[8 * j + 7] = d3[1]; }
}
DI void st_row_bf16(bf16* p, int lane, const float (&v)[16]) {
#pragma unroll
    for (int j = 0; j < 2; ++j) st16(p + 512 * j + 8 * lane, cvt_pk_bf16(v[8 * j], v[8 * j + 1]), cvt_pk_bf16(v[8 * j + 2], v[8 * j + 3]), cvt_pk_bf16(v[8 * j + 4], v[8 * j + 5]), cvt_pk_bf16(v[8 * j + 6], v[8 * j + 7]));
}
DI int colx(int lane, int j) { return (lane >> 4) * 256 + (lane & 15) * 8 + 128 * j; }
DI void ld_rowx_f32(const float* p, int lane, float (&v)[16]) {
#pragma unroll
    for (int j = 0; j < 2; ++j) { const f32x4 a = *(const GAS f32x4*)(p + colx(lane, j)), b = *(const GAS f32x4*)(p + colx(lane, j) + 4);
#pragma unroll
        for (int e = 0; e < 4; ++e) { v[8 * j + e] = a[e]; v[8 * j + 4 + e] = b[e]; } }
}
DI void st_rowx_f32(float* p, int lane, const float (&v)[16]) {
#pragma unroll
    for (int j = 0; j < 2; ++j) { *(GAS f32x4*)(p + colx(lane, j)) = (f32x4){v[8 * j], v[8 * j + 1], v[8 * j + 2], v[8 * j + 3]}; *(GAS f32x4*)(p + colx(lane, j) + 4) = (f32x4){v[8 * j + 4], v[8 * j + 5], v[8 * j + 6], v[8 * j + 7]}; }
}
DI void st_rowx_bf16(bf16* p, int lane, const float (&v)[16]) {
#pragma unroll
    for (int j = 0; j < 2; ++j) st16(p + colx(lane, j), cvt_pk_bf16(v[8 * j], v[8 * j + 1]), cvt_pk_bf16(v[8 * j + 2], v[8 * j + 3]), cvt_pk_bf16(v[8 * j + 4], v[8 * j + 5]), cvt_pk_bf16(v[8 * j + 6], v[8 * j + 7]));
}
DI float row_sumsq(const float (&v)[16]) { float s = 0.f;
#pragma unroll
    for (int i = 0; i < 16; ++i) s += v[i] * v[i];
    return wave_sum(s); }
DI void norm_mod(const float (&x)[16], float rstd, const float* nw, const float* sh, const float* sc, int lane, float (&u)[16]) {
    float g[16], a[16], b[16]; ld_row_f32(nw, lane, g); ld_row_f32(sh, lane, a); ld_row_f32(sc, lane, b);
#pragma unroll
    for (int i = 0; i < 16; ++i) u[i] = x[i] * rstd * g[i] * (1.f + b[i]) + a[i];
}
DI void u_rows_layer0(Frame& F, bf16* U, const float* xin, const float* ctxin, const float* norms) {
    const int gw = F.vcu * 8 + F.wave, NGW = F.G * 8;
    const float* MOD = (const float*)(F.ws + WS_MOD);
    float av[16], bv[16]; int bcur = -1;
    float xn[16];
    if (gw < NTOK + NCTX) ld_row_f32(gw < NTOK ? xin + (size_t)gw * D : ctxin + (size_t)(gw - NTOK) * D, F.lane, xn);
    for (int m = gw; m < NTOK + NCTX; m += NGW) {
        const bool lat = m < NTOK; const int b = lat ? m / T : 8;
        float x[16], u[16];
#pragma unroll
        for (int i = 0; i < 16; ++i) x[i] = xn[i];
        const int mn = m + NGW;
        if (mn < NTOK + NCTX) ld_row_f32(mn < NTOK ? xin + (size_t)mn * D : ctxin + (size_t)(mn - NTOK) * D, F.lane, xn);
        if (b != bcur) {
            bcur = b; const float* mb = MOD + (size_t)b * 6144; float t1[16], t2[16];
            ld_row_f32(norms, F.lane, t1); ld_row_f32(mb + 1024, F.lane, t2); ld_row_f32(mb, F.lane, bv);
#pragma unroll
            for (int i = 0; i < 16; ++i) av[i] = t1[i] * (1.f + t2[i]);
        }
        const float rstd = rsqrtf(row_sumsq(x) * (1.f / D) + NORM_EPS);
#pragma unroll
        for (int i = 0; i < 16; ++i) u[i] = x[i] * rstd * av[i] + bv[i];
        st_row_bf16(U + (size_t)m * D, F.lane, u);
    }
}

#define MFMA32(a, b, c) __builtin_amdgcn_mfma_f32_32x32x16_bf16((a), (b), (c), 0, 0, 0)
DI int crow(int reg, int h5) { return (reg & 3) + 8 * (reg >> 2) + 4 * h5; }
DI float log2_gamma(const float* decay, int dir, int head) { const float x = decay[dir * NH + head]; return -log2f(1.f + expf(-x)); }

DI void retention_scores(Frame& F, const float* decay) {
    const bf16* Q = (const bf16*)(F.ws + WS_Q); const bf16* K = (const bf16*)(F.ws + WS_K); bf16* P = (bf16*)(F.ws + WS_P);
    const int lane = F.lane, r = lane & 31, h5 = lane >> 5;
    for (int unit = F.vcu; unit < NB * NH * NCHUNK; unit += F.G) {
        const int bh = unit >> 5, c = unit & 31, b = bh >> 2, head = bh & 3;
        const float lf = log2_gamma(decay, 0, head), lb = log2_gamma(decay, 1, head);
        bf16* Pt = P + (size_t)unit * CH * CH;
        {
            const bf16* kb = K + ((size_t)(b * NCHUNK + c) * NH + head) * 32768 + lane * 8;
            const bf16* qb = Q + ((size_t)(b * NCHUNK + c) * NH + head) * 32768 + lane * 8;
            __syncthreads();
#pragma unroll
            for (int i = 0; i < 8; ++i) { const int pc = F.wave + 8 * i;
                __builtin_amdgcn_global_load_lds((const unsigned*)(kb + (size_t)pc * 512), (LAS unsigned*)(F.lds + RING_OFF + pc * 1024), 16, 0, 0);
                __builtin_amdgcn_global_load_lds((const unsigned*)(qb + (size_t)pc * 512), (LAS unsigned*)(F.lds + RING_OFF + 65536 + pc * 1024), 16, 0, 0); }
            VM_WAIT(); __syncthreads();
        }
#pragma unroll
        for (int tt = 0; tt < 2; ++tt) {
            const int tile = F.wave * 2 + tt, jt = tile >> 2, it = tile & 3;
            const LAS unsigned char* kp = F.lds + RING_OFF + (jt * 16) * 1024 + lane * 16;
            const LAS unsigned char* qp = F.lds + RING_OFF + 65536 + (it * 16) * 1024 + lane * 16;
            f32x16 acc;
#pragma unroll
            for (int i = 0; i < 16; ++i) acc[i] = 0.f;
#pragma unroll
            for (int s = 0; s < 16; ++s) { const bf16x8 a = *(const LAS bf16x8*)(kp + 1024 * s), bq = *(const LAS bf16x8*)(qp + 1024 * s); acc = MFMA32(a, bq, acc); }
            const int i = 32 * it + r;
#pragma unroll
            for (int g = 0; g < 4; ++g) {
                float o[4];
#pragma unroll
                for (int e = 0; e < 4; ++e) { const int j = 32 * jt + 8 * g + 4 * h5 + e; const int dd = i - j;
                    const float w = dd > 0 ? exp2f(lf * (float)dd) : (dd < 0 ? exp2f(lb * (float)(-dd)) : 2.f);
                    o[e] = acc[4 * g + e] * w; }
                v2u pk; pk.x = cvt_pk_bf16(o[0], o[1]); pk.y = cvt_pk_bf16(o[2], o[3]);
                *(GAS v2u*)(Pt + ((size_t)(it * 8 + 2 * jt + (g >> 1)) * 64 + r + 32 * (g & 1)) * 8 + 4 * h5) = pk;
            }
        }
    }
}

DI void dma16_untracked(const void* g, const LAS unsigned char* l) {
    const unsigned la = __builtin_amdgcn_readfirstlane((unsigned)(__UINTPTR_TYPE__)l);
    asm volatile("s_mov_b32 m0, %1\n\ts_nop 0\n\tglobal_load_lds_dwordx4 %0, off" :: "v"(g), "s"(la) : "memory", "m0");
}
constexpr size_t WS_SCANDUMP = 130 * MiB;
constexpr int KSLAB = 0, VPITCH = 192, SPITCH = 528;
constexpr int VIMG = 65536, VSIMG = VIMG + 128 * VPITCH, SIMG = VSIMG + 128 * VPITCH, SCAN_LDS_END = SIMG + 64 * SPITCH;
static_assert(SCAN_LDS_END <= LDSCTL_OFF, "scan LDS");
typedef LAS s16x4 lds_s16x4;
DI const LAS unsigned char* tr_lane_base(const LAS unsigned char* img, int pitch, int lane) {
    const int h5 = lane >> 5, blk = (lane >> 4) & 1, q = (lane & 15) >> 2, p = lane & 3;
    return img + (8 * h5 + q) * pitch + (16 * blk + 4 * p) * 2;
}
DI bf16x8 tr_frag(const LAS unsigned char* lane_base, int off, int pitch) {
    const s16x4 lo = __builtin_amdgcn_ds_read_tr16_b64_v4i16((lds_s16x4*)(lane_base + off));
    const s16x4 hi = __builtin_amdgcn_ds_read_tr16_b64_v4i16((lds_s16x4*)(lane_base + off + 4 * pitch));
    return __builtin_shufflevector(lo, hi, 0, 1, 2, 3, 4, 5, 6, 7);
}
#define WG_BAR() do { asm volatile("s_waitcnt lgkmcnt(0)" ::: "memory"); __builtin_amdgcn_s_barrier(); asm volatile("" ::: "memory"); } while (0)
DI void retention_scan(Frame& F, bf16* Opart, bf16* O, const float* decay, const int variant = 0) {
    const bf16* Qg = (const bf16*)(F.ws + WS_Q); const bf16* Kg = (const bf16*)(F.ws + WS_K); const bf16* Vg = (const bf16*)(F.ws + WS_V);
    const bf16* KCg = (const bf16*)(F.ws + WS_KC); const bf16* VCg = (const bf16*)(F.ws + WS_VC); const bf16* Pg = (const bf16*)(F.ws + WS_P);
    const int lane = F.lane, w = F.wave, tid = F.tid;
    const int it = w >> 1, et = w & 1;
    const LAS unsigned char* trK = tr_lane_base(F.lds + KSLAB + w * 8192, 64, lane);
    const LAS unsigned char* trV = tr_lane_base(F.lds + VIMG, VPITCH, lane);
    const LAS unsigned char* trVS = tr_lane_base(F.lds + VSIMG, VPITCH, lane);
    for (int unit = F.vcu; unit < NB * NH * 8; unit += F.G) {
        const int bh = unit >> 3, eb = unit & 7, b = bh >> 2, head = bh & 3;
        const int vcol = head * DV + eb * 64;
#pragma unroll
        for (int pass = 0; pass < 2; ++pass) {
            const bool fwd = pass == 1;
            const float l2g = log2_gamma(decay, fwd ? 0 : 1, head);
            const float gC = exp2f(l2g * (float)CH);
            f32x16 accS[2];
#pragma unroll
            for (int i = 0; i < 16; ++i) { accS[0][i] = 0.f; accS[1][i] = 0.f; }
            v4u vreg[2];
#define SCAN_SRC(s, kp, vp) do { if ((s) < 2) { const int cc = fwd ? (s) : 1 - (s); kp = KCg + ((size_t)(b * 2 + cc) * NH + head) * 32768; vp = VCg + ((size_t)b * LCTX + cc * CH) * 2048 + vcol; } \
                else { const int cc = fwd ? (s) - 2 : 33 - (s); kp = Kg + ((size_t)(b * NCHUNK + cc) * NH + head) * 32768; vp = Vg + ((size_t)b * T + cc * CH) * 2048 + vcol; } } while (0)
#define SCAN_LOADV(s) do { const bf16* kp_; const bf16* vp_; SCAN_SRC(s, kp_, vp_); (void)kp_; \
                _Pragma("unroll") for (int i = 0; i < 2; ++i) vreg[i] = *(const GAS v4u*)(vp_ + (size_t)((tid >> 3) + 64 * i) * 2048 + (tid & 7) * 8); } while (0)
#define SCAN_DMAK(s) do { const bf16* kp_; const bf16* vp_; SCAN_SRC(s, kp_, vp_); (void)vp_; \
                _Pragma("unroll") for (int i = 0; i < 8; ++i) dma16_untracked(kp_ + (unsigned)((((i >> 1) * 16 + 2 * w + ((lane & 3) >> 1)) * 64 + ((16 * i + (lane >> 2)) & 31) + 32 * (lane & 1)) * 8), \
                    F.lds + KSLAB + w * 8192 + i * 1024); } while (0)
            bf16x8 qf[16], pf[8];
            { int lane_ = lane, tid_ = tid; asm volatile("" : "+v"(lane_), "+v"(tid_));
              const int lane = lane_, tid = tid_; (void)lane; (void)tid;
              SCAN_LOADV(0); asm volatile("" : "+v"(vreg[0]), "+v"(vreg[1]));
              SCAN_DMAK(0); }
#pragma unroll 1
            for (int s = 0; s < 34; ++s) {
                int lz = lane, tz = tid; asm volatile("" : "+v"(lz), "+v"(tz));
                const int r = lz & 31, h5 = lz >> 5;
                const unsigned ooff = (unsigned)(4 * h5) * 2048u + (unsigned)r;
#pragma unroll
                for (int i = 0; i < 2; ++i) {
                    const int row = (tz >> 3) + 64 * i;
                    const float dec = exp2f(l2g * (float)(fwd ? (CH - 1 - row) : row));
                    const v4u x = vreg[i]; v4u o;
                    o.x = cvt_pk_bf16(bf_lo(x.x) * dec, bf_hi(x.x) * dec); o.y = cvt_pk_bf16(bf_lo(x.y) * dec, bf_hi(x.y) * dec);
                    o.z = cvt_pk_bf16(bf_lo(x.z) * dec, bf_hi(x.z) * dec); o.w = cvt_pk_bf16(bf_lo(x.w) * dec, bf_hi(x.w) * dec);
                    *(LAS v4u*)(F.lds + VIMG + row * VPITCH + (tz & 7) * 16) = x;
                    *(LAS v4u*)(F.lds + VSIMG + row * VPITCH + (tz & 7) * 16) = o;
                }
#pragma unroll
                for (int e2 = 0; e2 < 2; ++e2)
#pragma unroll
                    for (int g = 0; g < 4; ++g) { v2u pk; pk.x = cvt_pk_bf16(accS[e2][4 * g], accS[e2][4 * g + 1]); pk.y = cvt_pk_bf16(accS[e2][4 * g + 2], accS[e2][4 * g + 3]);
                        *(LAS v2u*)(F.lds + SIMG + (32 * e2 + r) * SPITCH + (32 * w + 8 * g + 4 * h5) * 2) = pk; }
                WG_BAR();
                unsigned opk[8];
#pragma unroll
                for (int i = 0; i < 8; ++i) opk[i] = 0u;
                if (s >= 2 && !(variant & 1)) {
                    f32x16 accO;
#pragma unroll
                    for (int i = 0; i < 16; ++i) accO[i] = 0.f;
                    {
                        const LAS unsigned char* sp_ = F.lds + SIMG + (32 * et + r) * SPITCH + 16 * h5;
                        bf16x8 sb[2][4];
#pragma unroll
                        for (int j = 0; j < 4; ++j) sb[0][j] = *(const LAS bf16x8*)(sp_ + 32 * j);
#pragma unroll
                        for (int g = 0; g < 4; ++g) {
                            if (g < 3) {
#pragma unroll
                                for (int j = 0; j < 4; ++j) sb[(g + 1) & 1][j] = *(const LAS bf16x8*)(sp_ + 32 * (4 * (g + 1) + j)); }
                            __builtin_amdgcn_sched_barrier(0);
#pragma unroll
                            for (int j = 0; j < 4; ++j) accO = MFMA32(qf[4 * g + j], sb[g & 1][j], accO);
                            __builtin_amdgcn_sched_barrier(0);
                        }
                    }
                    {
                        float qd_lo[4], qd_hi[4];
#pragma unroll
                        for (int i = 0; i < 4; ++i) { qd_lo[i] = exp2f(l2g * (float)(fwd ? 32 * it + 4 * h5 + i + 1 : CH - 32 * it - 4 * h5 - i)); qd_hi[i] = exp2f(l2g * (float)(fwd ? 8 * i : -8 * i)); }
#pragma unroll
                        for (int i = 0; i < 16; ++i) accO[i] *= qd_lo[i & 3] * qd_hi[i >> 2];
                    }
                    if (fwd) {
                        bf16x8 vb[2][4];
#pragma unroll
                        for (int j = 0; j < 4; ++j) vb[0][j] = tr_frag(trV + 64 * et, 16 * j * VPITCH, VPITCH);
#pragma unroll
                        for (int g = 0; g < 2; ++g) {
                            if (g < 1) {
#pragma unroll
                                for (int j = 0; j < 4; ++j) vb[1][j] = tr_frag(trV + 64 * et, 16 * (4 + j) * VPITCH, VPITCH); }
                            __builtin_amdgcn_sched_barrier(0);
#pragma unroll
                            for (int j = 0; j < 4; ++j) accO = MFMA32(pf[4 * g + j], vb[g][j], accO);
                            __builtin_amdgcn_sched_barrier(0);
                        }
                    }
#pragma unroll
                    for (int i = 0; i < 8; ++i) opk[i] = cvt_pk_bf16(accO[2 * i], accO[2 * i + 1]);
                }
                {
                    const int sn = s + 1 < 34 ? s + 1 : 33;
                    const bf16* kp_; const bf16* vp_; SCAN_SRC(sn, kp_, vp_); (void)kp_;
#pragma unroll
                    for (int i = 0; i < 2; ++i) vreg[i] = *(const GAS v4u*)(vp_ + (unsigned)(((tz >> 3) + 64 * i) * 2048 + (tz & 7) * 8));
                    const int cq = sn >= 2 ? (fwd ? sn - 2 : 33 - sn) : (fwd ? 0 : 31);
                    const bf16* qn = Qg + ((((size_t)(b * NCHUNK + cq) * NH + head) * 4 + it) * 16) * 512;
                    const unsigned qoff = (unsigned)lz * 8u;
#pragma unroll
                    for (int ks = 0; ks < 16; ++ks) qf[ks] = *(const GAS bf16x8*)(qn + qoff + 512 * ks);
                    if (fwd) {
                        const bf16* pn = Pg + ((size_t)(bh * NCHUNK + cq) * CH * CH) + (size_t)(it * 8) * 512;
#pragma unroll
                        for (int ks = 0; ks < 8; ++ks) pf[ks] = *(const GAS bf16x8*)(pn + qoff + 512 * ks);
                    }
                }
                if (s == 0) { if (fwd) asm volatile("s_waitcnt vmcnt(26)" ::: "memory"); else asm volatile("s_waitcnt vmcnt(18)" ::: "memory"); }
                else { if (fwd) asm volatile("s_waitcnt vmcnt(42)" ::: "memory"); else asm volatile("s_waitcnt vmcnt(34)" ::: "memory"); }
#pragma unroll
                for (int i = 0; i < 16; ++i) { accS[0][i] *= gC; accS[1][i] *= gC; }
                if (!(variant & 2))
                {
                    bf16x8 ua[2], ub0[2], ub1[2];
                    ua[0] = tr_frag(trK, 0, 64); ub0[0] = tr_frag(trVS, 0, VPITCH); ub1[0] = tr_frag(trVS, 64, VPITCH);
#pragma unroll
                    for (int ks = 0; ks < 8; ++ks) {
                        if (ks < 7) { ua[(ks + 1) & 1] = tr_frag(trK, 16 * (ks + 1) * 64, 64); ub0[(ks + 1) & 1] = tr_frag(trVS, 16 * (ks + 1) * VPITCH, VPITCH); ub1[(ks + 1) & 1] = tr_frag(trVS, 16 * (ks + 1) * VPITCH + 64, VPITCH); }
                        __builtin_amdgcn_sched_barrier(0);
                        accS[0] = MFMA32(ua[ks & 1], ub0[ks & 1], accS[0]); accS[1] = MFMA32(ua[ks & 1], ub1[ks & 1], accS[1]);
                        __builtin_amdgcn_sched_barrier(0);
                    }
                }
                asm volatile("s_waitcnt lgkmcnt(0)" ::: "memory");
                {
                    const int sn = s + 1 < 34 ? s + 1 : 33;
                    const bf16* kp_; const bf16* vp_; SCAN_SRC(sn, kp_, vp_); (void)vp_;
#pragma unroll
                    for (int i = 0; i < 8; ++i) dma16_untracked(kp_ + (unsigned)((((i >> 1) * 16 + 2 * w + ((lz & 3) >> 1)) * 64 + ((16 * i + (lz >> 2)) & 31) + 32 * (lz & 1)) * 8), F.lds + KSLAB + w * 8192 + i * 1024); }
                {
                    const int cc = fwd ? s - 2 : 33 - s;
                    const size_t obase = ((size_t)b * T + cc * CH + 32 * it) * 2048 + vcol + 32 * et;
                    GAS unsigned short* dstp = s >= 2 ? (GAS unsigned short*)((fwd ? O : Opart) + obase) : (GAS unsigned short*)(F.ws + WS_SCANDUMP) + (size_t)(32 * it) * 2048 + 32 * et;
#pragma unroll
                    for (int i = 0; i < 16; ++i) dstp[ooff + (unsigned)(((i & 3) + 8 * (i >> 2)) * 2048)] = (unsigned short)((i & 1) ? (opk[i >> 1] >> 16) : (opk[i >> 1] & 0xffffu));
                }
                WG_BAR();
            }
#undef SCAN_SRC
#undef SCAN_LOADV
#undef SCAN_DMAK
            VM_WAIT(); __syncthreads();
        }
    }
}
DI void gn_gate_rows(Frame& F, bf16* O, const bf16* G, const bf16* OP) {
    const int gw = F.vcu * 8 + F.wave, NGW = F.G * 8;
    v4u an[4], gn[4], pn[4];
    if (gw < NTOK) {
#pragma unroll
        for (int j = 0; j < 4; ++j) { an[j] = *(const GAS v4u*)(O + (size_t)gw * VTOT + 512 * j + 8 * F.lane); pn[j] = *(const GAS v4u*)(OP + (size_t)gw * VTOT + 512 * j + 8 * F.lane); gn[j] = *(const GAS v4u*)(G + (size_t)gw * VTOT + 512 * j + 8 * F.lane); } }
    for (int m = gw; m < NTOK; m += NGW) {
        bf16* op = O + (size_t)m * VTOT;
        v4u ac[4], gc[4], pc[4];
#pragma unroll
        for (int j = 0; j < 4; ++j) { ac[j] = an[j]; gc[j] = gn[j]; pc[j] = pn[j]; }
        const int mn = m + NGW;
        if (mn < NTOK) {
#pragma unroll
            for (int j = 0; j < 4; ++j) { an[j] = *(const GAS v4u*)(O + (size_t)mn * VTOT + 512 * j + 8 * F.lane); pn[j] = *(const GAS v4u*)(OP + (size_t)mn * VTOT + 512 * j + 8 * F.lane); gn[j] = *(const GAS v4u*)(G + (size_t)mn * VTOT + 512 * j + 8 * F.lane); } }
#pragma unroll
        for (int j = 0; j < 4; ++j) {
            const v4u a = ac[j], g = gc[j], q = pc[j];
            float v[8] = {bf_lo(a.x) + bf_lo(q.x), bf_hi(a.x) + bf_hi(q.x), bf_lo(a.y) + bf_lo(q.y), bf_hi(a.y) + bf_hi(q.y), bf_lo(a.z) + bf_lo(q.z), bf_hi(a.z) + bf_hi(q.z), bf_lo(a.w) + bf_lo(q.w), bf_hi(a.w) + bf_hi(q.w)};
            const float gg[8] = {bf_lo(g.x), bf_hi(g.x), bf_lo(g.y), bf_hi(g.y), bf_lo(g.z), bf_hi(g.z), bf_lo(g.w), bf_hi(g.w)};
            float ss = 0.f;
#pragma unroll
            for (int e = 0; e < 8; ++e) ss += v[e] * v[e];
            const float rstd = rsqrtf(wave_sum(ss) * (1.f / DV) + NORM_EPS);
#pragma unroll
            for (int e = 0; e < 8; ++e) v[e] = v[e] * rstd * gg[e];
            st16(op + 512 * j + 8 * F.lane, cvt_pk_bf16(v[0], v[1]), cvt_pk_bf16(v[2], v[3]), cvt_pk_bf16(v[4], v[5]), cvt_pk_bf16(v[6], v[7]));
        }
    }
}
constexpr size_t WS_WPRIME = 156 * MiB, WS_CPART = WS_MOD + 1 * MiB;
DI void router_prescale(Frame& F, const float* norms, const float* router) {
    const float* MOD = (const float*)(F.ws + WS_MOD);
    bf16* WP = (bf16*)(F.ws + WS_WPRIME); float* CP = (float*)(F.ws + WS_CPART);
    const int gt = F.vcu * 512 + F.tid, NT = F.G * 512;
    for (int i = gt; i < 2 * NB * D * NE; i += NT) {
        const int e = i & 63, k = (i >> 6) & 1023, b = (i >> 16) & 7, l = i >> 19;
        const float v = norms[(l * 4 + 2) * D + k] * (1.f + MOD[(size_t)(l * 9 + b) * 6144 + 4 * D + k]) * router[((size_t)l * D + k) * NE + e];
        const bf16 hi = f2bf(v), lo = f2bf(v - bf2f(hi));
        const size_t o = (size_t)(l * NB + b) * 131072 + ((size_t)((e >> 5) * 64 + (k >> 4)) * 64 + (e & 31) + 32 * ((k >> 3) & 1)) * 8 + (k & 7);
        WP[o] = hi; WP[o + 65536] = lo;
    }
    const int gw = F.vcu * 8 + F.wave, NGW = F.G * 8;
    for (int t = gw; t < 2 * NB * 16; t += NGW) {
        const int ch = t & 15, b = (t >> 4) & 7, l = t >> 7;
        float a = 0.f;
#pragma unroll 8
        for (int kk = 0; kk < 64; ++kk) { const int k = ch * 64 + kk; a += MOD[(size_t)(l * 9 + b) * 6144 + 3 * D + k] * router[((size_t)l * D + k) * NE + F.lane]; }
        CP[(size_t)t * 64 + F.lane] = a;
    }
}
DI void rows_router(Frame& F, int layer, const float* hin, const bf16* Y, bf16* U, const float* norms, const float* mbias, float* hout, const int variant = 0, const int cl = 0) {
    const float* MOD = (const float*)(F.ws + WS_MOD) + (size_t)layer * 9 * 6144;
    const float* nrm = norms + (size_t)layer * 4 * D;
    constexpr int UP = 2064;
    LAS unsigned char* uhi = F.lds + RING_OFF; LAS unsigned char* ulo = uhi + 32 * UP;
    LAS float* plg = (LAS float*)uhi;
    LAS float* rstdl = (LAS float*)(ulo + 32 * UP);
    LAS int* bcnt = (LAS int*)(rstdl + 32); LAS int* bbase = bcnt + 64;
    LAS int* park = bbase + 64;
    const int lane = F.lane, w = F.wave;
    const float mybias = mbias[layer * NE + lane];
    unsigned char* lb = F.ws + WS_LIST;
    if (F.tid < 64) bcnt[F.tid] = 0;
    int nblk = 0;
    float yA[16], hA[16], yB[16], hB[16];
    if (F.vcu < NTOK / 32 && !(variant & 1)) { const int mf = F.vcu * 32 + w * 4;
        ld_row_bf16(Y + (size_t)mf * D, lane, yA); ld_row_f32(hin + (size_t)mf * D, lane, hA); ld_row_bf16(Y + (size_t)(mf + 1) * D, lane, yB); ld_row_f32(hin + (size_t)(mf + 1) * D, lane, hB); }
    for (int blk = F.vcu; blk < NTOK / 32; blk += F.G, ++nblk) {
        const int m0 = blk * 32, b = m0 / T;
        const float* mb = MOD + (size_t)b * 6144;
        float csum = 0.f;
        { const float* cp = (const float*)(F.ws + WS_CPART) + (size_t)((layer * NB + b) * 16) * 64 + lane;
#pragma unroll
          for (int ch = 0; ch < 16; ++ch) csum += cp[ch * 64]; }
        if (!(variant & 1)) {
            float gg[16], av[16], bv[16];
            { float t1[16], t2[16]; ld_row_f32(nrm + D, lane, t1); ld_row_f32(mb + 2 * D, lane, t2);
#pragma unroll
              for (int i = 0; i < 16; ++i) gg[i] = t1[i] * t2[i];
              ld_row_f32(nrm + 2 * D, lane, t1); ld_row_f32(mb + 4 * D, lane, t2); ld_row_f32(mb + 3 * D, lane, bv);
#pragma unroll
              for (int i = 0; i < 16; ++i) av[i] = t1[i] * (1.f + t2[i]); }
            const int mnext = (blk + F.G) * 32;
            const bool hasnext = blk + F.G < NTOK / 32;
#pragma unroll
            for (int rr = 0; rr < 4; ++rr) {
                const int rl = w * 4 + rr, m = m0 + rl;
                float y[16], h[16], u[16];
#pragma unroll
                for (int i = 0; i < 16; ++i) { y[i] = (rr & 1) ? yB[i] : yA[i]; h[i] = (rr & 1) ? hB[i] : hA[i]; }
                {
                    const int mr = rr < 2 ? m + 2 : mnext + w * 4 + (rr - 2);
                    if (rr < 2 || hasnext) {
                        if (rr & 1) { ld_row_bf16(Y + (size_t)mr * D, lane, yB); ld_row_f32(hin + (size_t)mr * D, lane, hB); }
                        else        { ld_row_bf16(Y + (size_t)mr * D, lane, yA); ld_row_f32(hin + (size_t)mr * D, lane, hA); }
                    }
                }
                const float rs1 = rsqrtf(row_sumsq(y) * (1.f / D) + NORM_EPS);
#pragma unroll
                for (int i = 0; i < 16; ++i) h[i] += gg[i] * (y[i] * rs1);
                st_row_f32(hout + (size_t)m * D, lane, h);
                const float rs2 = rsqrtf(row_sumsq(h) * (1.f / D) + NORM_EPS);
#pragma unroll
                for (int i = 0; i < 16; ++i) u[i] = h[i] * rs2 * av[i] + bv[i];
                st_row_bf16(U + (size_t)m * D, lane, u);
#pragma unroll
                for (int j = 0; j < 2; ++j) {
                    unsigned hh[4], ll[4];
#pragma unroll
                    for (int e = 0; e < 4; ++e) { const float x0 = h[8 * j + 2 * e], x1 = h[8 * j + 2 * e + 1]; const unsigned ph = cvt_pk_bf16(x0, x1); hh[e] = ph; ll[e] = cvt_pk_bf16(x0 - bf_lo(ph), x1 - bf_hi(ph)); }
                    *(LAS v4u*)(uhi + rl * UP + (512 * j + 8 * lane) * 2) = (v4u){hh[0], hh[1], hh[2], hh[3]};
                    *(LAS v4u*)(ulo + rl * UP + (512 * j + 8 * lane) * 2) = (v4u){ll[0], ll[1], ll[2], ll[3]};
                }
                if (lane == 0) rstdl[rl] = rs2;
            }
        }
        bf16x8 bh[16], bl[16];
        if (!(variant & 2)) {
            const int kq = w >> 1, et = w & 1;
            const bf16* wph = (const bf16*)(F.ws + WS_WPRIME) + (size_t)(layer * NB + b) * 131072 + ((size_t)(et * 64 + 16 * kq) * 64 + lane) * 8;
#pragma unroll
            for (int ks = 0; ks < 16; ++ks) { bh[ks] = *(const GAS bf16x8*)(wph + 512 * ks); bl[ks] = *(const GAS bf16x8*)(wph + 65536 + 512 * ks); }
            __builtin_amdgcn_sched_barrier(0);
        }
        WG_BAR();
        if (!(variant & 2)) {
            const int kq = w >> 1, et = w & 1, r = lane & 31, h5 = lane >> 5;
            f32x16 acc;
#pragma unroll
            for (int i = 0; i < 16; ++i) acc[i] = 0.f;
#pragma unroll
            for (int ks = 0; ks < 16; ++ks) {
                const bf16x8 ah = *(const LAS bf16x8*)(uhi + r * UP + (256 * kq + 16 * ks + 8 * h5) * 2), al = *(const LAS bf16x8*)(ulo + r * UP + (256 * kq + 16 * ks + 8 * h5) * 2);
                acc = MFMA32(ah, bh[ks], acc); acc = MFMA32(ah, bl[ks], acc); acc = MFMA32(al, bh[ks], acc);
            }
            __syncthreads();
#pragma unroll
            for (int i = 0; i < 16; ++i) plg[(kq * 32 + crow(i, h5)) * 65 + 32 * et + r] = acc[i];
        }
        __syncthreads();
        int lc = lane; asm volatile("" : "+v"(lc));
        float wgt[4]; int ksl[4], ipos[4];
#pragma unroll
        for (int rr = 0; rr < 4; ++rr) { ksl[rr] = -1; wgt[rr] = 0.f; ipos[rr] = 0; }
        if (!(variant & 4))
#pragma unroll
        for (int rr = 0; rr < 4; ++rr) {
            const int rl = w * 4 + rr;
            const float lg = rstdl[rl] * (plg[rl * 65 + lc] + plg[(32 + rl) * 65 + lc] + plg[(64 + rl) * 65 + lc] + plg[(96 + rl) * 65 + lc]) + csum;
            const float sc = sigmoidf_(lg), bs = sc + mybias;
            const float NINF = -__builtin_inff();
            const float m1 = grp8_max(bs);
            const bool ism = bs == m1;
            const float nm = grp8_sum(ism ? 1.f : 0.f);
            const float rest = grp8_max(ism ? NINF : bs);
            const float gs = m1 + (nm >= 2.f ? m1 : rest);
            int grk = 0; const int grp = lc >> 3;
#pragma unroll
            for (int g = 0; g < 8; ++g) { const float o = __builtin_bit_cast(float, __builtin_amdgcn_readlane(__builtin_bit_cast(int, gs), 8 * g)); grk += (o > gs || (o == gs && g < grp)) ? 1 : 0; }
            const bool gsel = grk < 4;
            float cur = gsel ? bs : NINF;
            bool sel = false;
#pragma unroll
            for (int t8 = 0; t8 < TOPK; ++t8) {
                const float mx = wave_max(cur);
                const unsigned long long eq = __builtin_amdgcn_ballot_w64(cur == mx);
                const int first = __builtin_ctzll(eq);
                const bool isf = lc == first;
                sel = sel || isf; cur = isf ? NINF : cur;
            }
            const float ssum = wave_sum(sel ? sc : 0.f);
            const unsigned long long bal = __ballot(sel);
            ksl[rr] = sel ? __popcll(bal & ((1ull << lc) - 1ull)) : -1;
            wgt[rr] = sc / ssum * 2.5f;
            ipos[rr] = sel ? __hip_atomic_fetch_add(bcnt + lc, 1, __ATOMIC_RELAXED, __HIP_MEMORY_SCOPE_WORKGROUP) : 0;
        }
#pragma unroll
        for (int rr = 0; rr < 4; ++rr) if (ksl[rr] >= 0) { const int pi = ((nblk * 32 + w * 4 + rr) * 8 + ksl[rr]) * 2; park[pi] = lc | (ipos[rr] << 8); park[pi + 1] = __builtin_bit_cast(int, wgt[rr]); }
        __syncthreads();
    }
    if (w == 0) { const int n = bcnt[lane]; bbase[lane] = n ? (int)atomicAdd(F.ctl + cnt_word(layer + cl, 0, lane), (unsigned)n) : 0; }
    __syncthreads();
    for (int k = 0; k < nblk; ++k) {
        const int m0 = (F.vcu + k * F.G) * 32;
#pragma unroll 1
        for (int rr = 0; rr < 4; ++rr) {
            const int m = m0 + w * 4 + rr;
            if (lane < 8) {
                const int pi = ((k * 32 + w * 4 + rr) * 8 + lane) * 2; const int pe = park[pi]; const float wv = __builtin_bit_cast(float, park[pi + 1]);
                const int e = pe & 0xff, pos = bbase[e] + (pe >> 8);
                ((int*)lb)[(size_t)e * ECAP + pos] = m;
                ((int*)(lb + LIST_ARR))[m * 8 + lane] = (e << 16) | pos; ((float*)(lb + 2 * LIST_ARR))[m * 8 + lane] = wv;
            }
            if (lane == 0) ((int*)lb)[(size_t)NE * ECAP + m] = m;
        }
    }
    __syncthreads();
}

DI void moe_tables(Frame& F, int layer, int slice) {
    LAS int* cum = (LAS int*)(F.lds + LDSCTL_OFF); LAS int* cnt = (LAS int*)(F.lds + LDSCTL_OFF + 272); LAS int* rb = (LAS int*)(F.lds + LDSCTL_OFF + 544);
    __syncthreads();
    if (F.wave == 0) {
        const int lane = F.lane;
        const int n = (int)__hip_atomic_load(F.ctl + cnt_word(layer, slice, lane), RLX_AGENT);
        int pb = (n + 255) >> 8, pr = n;
#pragma unroll
        for (int d = 1; d < 64; d <<= 1) {
            const int ob = __builtin_amdgcn_ds_bpermute((lane - d) << 2, pb), orr = __builtin_amdgcn_ds_bpermute((lane - d) << 2, pr);
            if (lane >= d) { pb += ob; pr += orr; }
        }
        cnt[lane] = n; cum[lane] = pb - ((n + 255) >> 8); rb[lane] = pr - n;
        if (lane == 63) { cnt[NE] = SLTOK; cum[NE] = pb; rb[NE] = pr; cum[NEX] = pb + ((SLTOK + 255) >> 8); rb[NEX] = pr + SLTOK; }
    }
    __syncthreads();
    {
        LAS unsigned char* eob = (LAS unsigned char*)(F.lds + LDSCTL_OFF + 1536); const int nb = cum[NEX];
        for (int blk = F.tid; blk < nb; blk += 512) { int e = 0, hi_ = NEX;
#pragma unroll
            for (int it = 0; it < 7; ++it) { const int mid = (e + hi_) >> 1; if (cum[mid] <= blk) e = mid; else hi_ = mid; }
            eob[blk] = (unsigned char)e; }
    }
    __syncthreads();
}
DI void moe_gemm1(Frame& F, int layer, int slice) {
    moe_tables(F, layer, slice);
    const LAS int* cum = (const LAS int*)(F.lds + LDSCTL_OFF); const LAS int* cnt = (const LAS int*)(F.lds + LDSCTL_OFF + 272); const LAS int* rb = (const LAS int*)(F.lds + LDSCTL_OFF + 544);
    unsigned char* lb = F.ws + WS_LIST + (size_t)slice * LIST_SLICE;
    pg8::Gemm g{(const bf16*)(F.ws + WS_U), (const bf16*)(F.ws + WS_W13), 1024};
    MoeOrder S{cum, cnt, rb, (const LAS unsigned char*)(F.lds + LDSCTL_OFF + 1536), (const int*)lb, 2, F.G, F.vcu, cum[NEX] * 2};
    EpiSwiGLU E{(bf16*)(F.ws + WS_ACT)};
    pg8::gemm_phase<EpiSwiGLU, MoeOrder, true>(F.lds + RING_OFF, g, S, E, F.tid, STAG_G1);
}
DI void moe_gemm2(Frame& F, int layer, int slice, int nostore = 0) {
    moe_tables(F, layer, slice);
    const LAS int* cum = (const LAS int*)(F.lds + LDSCTL_OFF); const LAS int* cnt = (const LAS int*)(F.lds + LDSCTL_OFF + 272); const LAS int* rb = (const LAS int*)(F.lds + LDSCTL_OFF + 544);
    pg8::Gemm g{(const bf16*)(F.ws + WS_ACT), (const bf16*)(F.ws + WS_W2), 256};
    MoeOrder S{cum, cnt, rb, (const LAS unsigned char*)(F.lds + LDSCTL_OFF + 1536), nullptr, 4, F.G, F.vcu, cum[NEX] * 4};
    EpiMoeOut E{F.ws + WS_Y2, nostore};
    pg8::gemm_phase<EpiMoeOut, MoeOrder, false>(F.lds + RING_OFF, g, S, E, F.tid, STAG_G2);
}
DI void moe_combine(Frame& F, int layer, int slice, bool last_layer, const float* norms) {
    moe_tables(F, layer, slice);
    const LAS int* rb = (const LAS int*)(F.lds + LDSCTL_OFF + 544);
    const int gw = F.vcu * 8 + F.wave, NGW = F.G * 8, lane = F.lane;
    const float* MOD = (const float*)(F.ws + WS_MOD);
    const unsigned char* Y2 = F.ws + WS_Y2; bf16* U = (bf16*)(F.ws + WS_UC);
    const unsigned char* lb = F.ws + WS_LIST + (size_t)slice * LIST_SLICE;
    const int* slot = (const int*)(lb + LIST_ARR); const float* wts = (const float*)(lb + 2 * LIST_ARR);
    float g3[16]; ld_rowx_f32(norms + (size_t)(layer * 4 + 3) * D, lane, g3);
    for (int ml0 = gw; ml0 < SLTOK; ml0 += 2 * NGW) {
        int lz = F.lane; asm volatile("" : "+v"(lz));
        int mm[2]; v4u rw[2][9]; float wk[2][8];
#pragma unroll
        for (int t = 0; t < 2; ++t) {
            const int ml = ml0 + t * NGW; mm[t] = ml < SLTOK ? ml : ml0;
            const int sv = slot[mm[t] * 8 + (lz & 7)]; const float wv = wts[mm[t] * 8 + (lz & 7)];
            const int myrow = rb[sv >> 16] + (sv & 0xffff);
#pragma unroll
            for (int k = 0; k < 8; ++k) { const int row = __builtin_amdgcn_readlane(myrow, k); wk[t][k] = __builtin_bit_cast(float, __builtin_amdgcn_readlane(__builtin_bit_cast(int, wv), k));
                rw[t][k] = *(const GAS v4u*)(Y2 + (size_t)row * D + (unsigned)(16 * lz)); }
            rw[t][8] = *(const GAS v4u*)(Y2 + ((size_t)SLTOK * 8 + mm[t]) * D + 16 * lz);
        }
        float o[2][16];
#pragma unroll
        for (int t = 0; t < 2; ++t) {
#pragma unroll
            for (int i = 0; i < 16; ++i) o[t][i] = 0.f;
#pragma unroll
            for (int k = 0; k < 9; ++k) { const float w = k < 8 ? wk[t][k < 8 ? k : 0] : 1.f;
#pragma unroll
                for (int j = 0; j < 2; ++j) { v2u a; a.x = j ? rw[t][k].z : rw[t][k].x; a.y = j ? rw[t][k].w : rw[t][k].y;
                    const f32x2 d0 = __builtin_amdgcn_cvt_pk_f32_fp8((int)a.x, false), d1 = __builtin_amdgcn_cvt_pk_f32_fp8((int)a.x, true), d2 = __builtin_amdgcn_cvt_pk_f32_fp8((int)a.y, false), d3 = __builtin_amdgcn_cvt_pk_f32_fp8((int)a.y, true);
                    o[t][8 * j + 0] += w * d0[0]; o[t][8 * j + 1] += w * d0[1]; o[t][8 * j + 2] += w * d1[0]; o[t][8 * j + 3] += w * d1[1]; o[t][8 * j + 4] += w * d2[0]; o[t][8 * j + 5] += w * d2[1]; o[t][8 * j + 6] += w * d3[0]; o[t][8 * j + 7] += w * d3[1]; } }
        }
        float h[2][16], gf[2][16];
#pragma unroll
        for (int t = 0; t < 2; ++t) { const int m = slice * SLTOK + mm[t]; ld_rowx_f32(F.out + (size_t)m * D, lz, h[t]); ld_rowx_f32(MOD + ((size_t)(layer * 9 + m / T)) * 6144 + 5 * D, lz, gf[t]); }
#pragma unroll
        for (int t = 0; t < 2; ++t) {
            if (ml0 + t * NGW >= SLTOK) break;
            const int m = slice * SLTOK + mm[t], b = m / T;
            const float rs = rsqrtf(row_sumsq(o[t]) * (1.f / D) + NORM_EPS);
#pragma unroll
            for (int i = 0; i < 16; ++i) h[t][i] += gf[t][i] * (o[t][i] * rs * g3[i]);
            st_rowx_f32(F.out + (size_t)m * D, lz, h[t]);
            if (!last_layer) {
                const float rs2 = rsqrtf(row_sumsq(h[t]) * (1.f / D) + NORM_EPS);
                const float* mb = MOD + ((size_t)((layer + 1) * 9 + b)) * 6144;
                float u[16], ng[16], na[16], nb[16]; ld_rowx_f32(norms + (size_t)((layer + 1) * 4) * D, lz, ng); ld_rowx_f32(mb, lz, na); ld_rowx_f32(mb + D, lz, nb);
#pragma unroll
                for (int i = 0; i < 16; ++i) u[i] = h[t][i] * rs2 * ng[i] * (1.f + nb[i]) + na[i];
                st_rowx_bf16(U + (size_t)m * D, lz, u);
            }
        }
    }
}

DI void dwconv_ln(Frame& F, const bf16* Z, bf16* C, const float* dw, const float* bdwp, const float* lngp, const float* lnbp) {
    LAS float* red = (LAS float*)(F.lds + RING_OFF);
    LAS float* tot = red + 32 * 528;
    const int tid = F.tid, c0 = 2 * tid;
    const f32x2 bdw = *(const GAS f32x2*)(bdwp + c0), lg = *(const GAS f32x2*)(lngp + c0), lb = *(const GAS f32x2*)(lnbp + c0);
    for (int run = F.vcu; run < NTOK / 128; run += F.G) {
        const int mrun = run * 128, trun = mrun & (T - 1);
        unsigned z[46], zn[16];
#pragma unroll
        for (int i = 0; i < 46; ++i) { const int t = trun - 15 + i; z[i] = (t >= 0 && t < T) ? *(const GAS unsigned*)(Z + (size_t)(mrun - 15 + i) * D + c0) : 0u; }
#pragma unroll 1
        for (int j = 0; j < 8; ++j) {
            const int m0 = mrun + 16 * j, t0 = trun + 16 * j;
            if (j + 1 < 8) {
#pragma unroll
                for (int i = 0; i < 16; ++i) { const int t = t0 + 31 + i; zn[i] = (t < T) ? *(const GAS unsigned*)(Z + (size_t)(m0 + 31 + i) * D + c0) : 0u; }
            }
            f32x2 acc2[16], zz[46];
#pragma unroll
            for (int i = 0; i < 16; ++i) acc2[i] = bdw;
#pragma unroll
            for (int i = 0; i < 46; ++i) zz[i] = (f32x2){bf_lo(z[i]), bf_hi(z[i])};
            int cz = c0; asm volatile("" : "+v"(cz));
#pragma unroll
            for (int w = 0; w < 31; ++w) { const f32x2 k = *(const GAS f32x2*)(dw + w * D + cz);
#pragma unroll
                for (int i = 0; i < 16; ++i) acc2[i] = __builtin_elementwise_fma(zz[i + w], k, acc2[i]); }
            float a0[16], a1[16];
#pragma unroll
            for (int i = 0; i < 16; ++i) { a0[i] = acc2[i][0]; a1[i] = acc2[i][1]; }
            __syncthreads();
#pragma unroll
            for (int i = 0; i < 16; ++i) { red[i * 528 + tid] = a0[i] + a1[i]; red[(16 + i) * 528 + tid] = a0[i] * a0[i] + a1[i] * a1[i]; }
            __syncthreads();
            { const int st = tid >> 4, pp = tid & 15; float acc_ = 0.f;
#pragma unroll
              for (int k = 0; k < 32; ++k) acc_ += red[st * 528 + pp + 16 * k];
              acc_ += lane_xor(acc_, tid & 63, 1); acc_ += lane_xor(acc_, tid & 63, 2); acc_ += lane_xor(acc_, tid & 63, 4); acc_ += lane_xor(acc_, tid & 63, 8);
              if (pp == 0) tot[st] = acc_; }
            __syncthreads();
#pragma unroll
            for (int i = 0; i < 16; ++i) {
                const float t1 = tot[i], t2 = tot[16 + i];
                const float mu = t1 * (1.f / D), var = t2 * (1.f / D) - mu * mu, rstd = rsqrtf(fmaxf(var, 0.f) + LN_EPS);
                const float v0 = (a0[i] - mu) * rstd * lg[0] + lb[0], v1 = (a1[i] - mu) * rstd * lg[1] + lb[1];
                *(GAS unsigned*)(C + (size_t)(m0 + i) * D + c0) = cvt_pk_bf16(siluf_(v0), siluf_(v1));
            }
#pragma unroll
            for (int i = 0; i < 30; ++i) z[i] = z[i + 16];
#pragma unroll
            for (int i = 0; i < 16; ++i) z[30 + i] = zn[i];
        }
    }
}

constexpr int N_PHASES = 18;
struct Args { const float* in[26]; float* out; unsigned char* ws; int ph_lo, ph_hi; };
#define INP(i) ([&]() -> const float* { int j_ = (i); asm volatile("" : "+s"(j_)); return args.in[j_]; }())
__global__ void __launch_bounds__(512, 2) fwd_kernel(Args args) {
    extern __shared__ __attribute__((aligned(16))) unsigned char lds[];
    Frame F;
    F.lds = (LAS unsigned char*)lds;
    F.MISC = (volatile LAS unsigned*)(F.lds + MISC_OFF);
    F.tid = threadIdx.x; F.lane = F.tid & 63; F.wave = __builtin_amdgcn_readfirstlane(F.tid >> 6);
    F.G = gridDim.x; { const int bx = blockIdx.x; F.vcu = (F.G % 8 == 0) ? (bx % 8) * (F.G / 8) + bx / 8 : bx; }
    F.ws = args.ws; F.ctl = (unsigned*)(args.ws + WS_CTL); F.out = args.out;
    for (int u = F.tid; u < (LDS_BYTES - LDSCTL_OFF) / 4; u += 512) ((LAS unsigned*)(F.lds + LDSCTL_OFF))[u] = 0u;
    __syncthreads();
    const int wave_s = __builtin_amdgcn_readfirstlane(threadIdx.x >> 6);
    const int lo = args.ph_lo, hi = args.ph_hi;
    XcdBarrier bar; bar.bar = F.ctl + CW_BAR; bar.x = 0; bar.st = nullptr;
    if (hi - lo > 1) bar = xcd_barrier_post(F.ctl + CW_BAR, F.MISC + 8);
    int ph = 0;
#ifdef PROBE_A
    volatile LAS unsigned long long* stampv = (volatile LAS unsigned long long*)(F.lds + LDSCTL_OFF + 1280);
    if (blockIdx.x == 0 && F.tid == 0) stampv[0] = __builtin_amdgcn_s_memrealtime();
#define STAMP() do { if (blockIdx.x == 0 && F.tid == 0) stampv[ph + 1] = __builtin_amdgcn_s_memrealtime(); } while (0)
#else
#define STAMP() do { } while (0)
#endif
#define FRESH() do { int lz_; asm volatile("v_mbcnt_lo_u32_b32 %0, -1, 0\n\tv_mbcnt_hi_u32_b32 %0, -1, %0" : "=&v"(lz_)); F.lane = lz_; F.wave = wave_s; F.tid = wave_s * 64 + lz_;     \
        unsigned char* w_ = args.ws; float* o_ = args.out; asm volatile("" : "+s"(w_), "+s"(o_)); F.ws = w_; F.ctl = (unsigned*)(w_ + WS_CTL); F.out = o_; ws = w_; U0 = (bf16*)o_; OPART = (bf16*)o_; Ob = (bf16*)(w_ + WS_V); } while (0)
#define PH_BEGIN if (lo <= ph && ph < hi) { FRESH();
#define PH_END } if (lo <= ph && ph + 1 < hi) xcd_barrier(bar, F.tid == 0); STAMP(); ++ph;
    unsigned char* ws; bf16 *U0, *OPART, *Ob;

    PH_BEGIN mod_vectors(F, INP(I_C), INP(I_CCTX), INP(I_MODW), INP(I_MODB)); rope_tables(F); conv_small_weights(F, INP(I_RWIN), INP(I_RWOUT), INP(I_CW1), INP(I_CW2));
             conv_moe_weights(F, 0, INP(I_MW1), INP(I_MW3), INP(I_MW2), INP(I_SW1), INP(I_SW3), INP(I_SW2)); PH_END
    PH_BEGIN u_rows_layer0(F, U0, INP(I_X), INP(I_CTX), INP(I_NORMS)); router_prescale(F, INP(I_NORMS), INP(I_ROUTER)); PH_END
    PH_BEGIN
        pg8::Gemm g{U0, (const bf16*)(ws + WS_WIN), 1024}; InprojOrder S; S.init(F.G, (int)blockIdx.x);
        EpiQKVG E{ws};
        pg8::gemm_phase<EpiQKVG, InprojOrder, false>(F.lds + RING_OFF, g, S, E, F.tid, STAG_IN);
    PH_END
    PH_BEGIN retention_scores(F, INP(I_RDECAY)); PH_END
    PH_BEGIN retention_scan(F, OPART, Ob, INP(I_RDECAY)); PH_END
    PH_BEGIN gn_gate_rows(F, Ob, (const bf16*)(ws + WS_G), OPART); PH_END
    PH_BEGIN
        pg8::Gemm g{Ob, (const bf16*)(ws + WS_WOUT), 2048}; pg8::StaticOrder S; S.init(NTOK, D, F.G, (int)blockIdx.x);
        EpiBf16 E{(bf16*)(ws + WS_Y), D, nullptr};
        pg8::gemm_phase<EpiBf16, pg8::StaticOrder, false>(F.lds + RING_OFF, g, S, E, F.tid, STAG_PL);
    PH_END
#pragma unroll 1
    for (int layer = 0; layer < 2; ++layer) {
        if (layer == 1) {
            PH_BEGIN
                pg8::Gemm g{(const bf16*)(ws + WS_UC), (const bf16*)(ws + WS_CW1), 1024}; pg8::StaticOrder S; S.init(NTOK, 2048, F.G, (int)blockIdx.x);
                EpiGLU E{(bf16*)(ws + WS_Z), INP(I_CB1)};
                pg8::gemm_phase<EpiGLU, pg8::StaticOrder, false>(F.lds + RING_OFF, g, S, E, F.tid, STAG_PL);
            PH_END
            PH_BEGIN dwconv_ln(F, (const bf16*)(ws + WS_Z), (bf16*)(ws + WS_C), INP(I_CDW), INP(I_CBDW), INP(I_CLNG), INP(I_CLNB)); PH_END
            PH_BEGIN
                pg8::Gemm g{(const bf16*)(ws + WS_C), (const bf16*)(ws + WS_CW2), 1024}; pg8::StaticOrder S; S.init(NTOK, D, F.G, (int)blockIdx.x);
                EpiBf16 E{(bf16*)(ws + WS_Y1), D, INP(I_CB2)};
                pg8::gemm_phase<EpiBf16, pg8::StaticOrder, false>(F.lds + RING_OFF, g, S, E, F.tid, STAG_PL);
            PH_END
        }
        PH_BEGIN rows_router(F, layer, layer ? (const float*)F.out : INP(I_X), (const bf16*)(ws + (layer ? WS_Y1 : WS_Y)), (bf16*)(ws + WS_U), INP(I_NORMS), INP(I_MBIAS), F.out); PH_END
        PH_BEGIN moe_gemm1(F, layer, 0); PH_END
        PH_BEGIN moe_gemm2(F, layer, 0); PH_END
        PH_BEGIN moe_combine(F, layer, 0, layer == 1, INP(I_NORMS));
                 if (layer == 0) conv_moe_weights(F, 1, INP(I_MW1), INP(I_MW3), INP(I_MW2), INP(I_SW1), INP(I_SW3), INP(I_SW2)); PH_END
    }
#ifdef PROBE_A
    if (blockIdx.x == 0 && F.tid == 0) {
        const unsigned long long tend = __builtin_amdgcn_s_memrealtime();
        unsigned long long sa = 0, sb = 0;
        for (int k = 0; k < N_PHASES; ++k) { const unsigned long long d = stampv[k + 1] - stampv[k]; if ((PROBE_A >> k) & 1u) sa += d; if ((PROBE_B >> k) & 1u) sb += d; }
        if (sb) { VM_WAIT(); F.out[0] += (float)sb * 0.001f; }
        while (__builtin_amdgcn_s_memrealtime() - tend < 8ull * sa) __builtin_amdgcn_s_sleep(8);
    }
#endif
#undef PH_BEGIN
#undef PH_END
}

extern "C" void kernel_launch(void* const* d_in, const int* in_sizes, int n_in, void* d_out, int out_size, void* d_ws, size_t ws_size, hipStream_t stream) {
    static int grid = 0;
    if (grid == 0) {
        if (n_in != 26 || in_sizes[0] != NTOK * D || out_size != NTOK * D || ws_size < WS_END) {
            fprintf(stderr, "kernel_launch: unexpected shapes / workspace (n_in %d, ws %zu, need %zu); nothing launched\n", n_in, ws_size, (size_t)WS_END); grid = -1; return; }
        int dev = 0, cus = 0, per_cu = 0;
        if (hipGetDevice(&dev) != hipSuccess || hipDeviceGetAttribute(&cus, hipDeviceAttributeMultiprocessorCount, dev) != hipSuccess) { grid = -1; return; }
        if (hipFuncSetAttribute((const void*)fwd_kernel, hipFuncAttributeMaxDynamicSharedMemorySize, LDS_BYTES) != hipSuccess) { fprintf(stderr, "kernel_launch: hipFuncSetAttribute failed\n"); grid = -1; return; }
        if (hipOccupancyMaxActiveBlocksPerMultiprocessor(&per_cu, (const void*)fwd_kernel, 512, LDS_BYTES) != hipSuccess || per_cu < 1) { fprintf(stderr, "kernel_launch: occupancy query says %d\n", per_cu); }
        (void)hipGetLastError();
        if (cus < 160) { fprintf(stderr, "kernel_launch: %d CUs: this kernel's per-workgroup tables are sized for >= 160 workgroups; nothing launched\n", cus); grid = -1; return; }
        grid = cus;
    }
    if (grid < 0) return;
    (void)hipMemsetAsync((char*)d_ws + WS_CTL, 0, CTL_ZERO_BYTES, stream);
    Args a{};
    for (int i = 0; i < 26; ++i) a.in[i] = (const float*)d_in[i];
    a.out = (float*)d_out; a.ws = (unsigned char*)d_ws;
#if MK_ONE_LAUNCH
    a.ph_lo = 0; a.ph_hi = N_PHASES;
    hipLaunchKernelGGL(fwd_kernel, dim3(grid), dim3(512), LDS_BYTES, stream, a);
#else
    for (int p = 0; p < N_PHASES; ++p) { a.ph_lo = p; a.ph_hi = p + 1; hipLaunchKernelGGL(fwd_kernel, dim3(grid), dim3(512), LDS_BYTES, stream, a); }
#endif
}
```

```cpp
#include <hip/hip_runtime.h>
#include <cstdio>
#include <cstdint>

#define STAG_G1 0
#define STAG_G2 0
#define STAG_IN 0
#define STAG_PL 0
#ifndef MK_ONE_LAUNCH
#define MK_ONE_LAUNCH 1
#endif

#define GAS __attribute__((address_space(1)))
#define LAS __attribute__((address_space(3)))
typedef unsigned short bf16;
typedef unsigned v4u __attribute__((ext_vector_type(4)));
typedef unsigned v2u __attribute__((ext_vector_type(2)));
typedef float f32x4 __attribute__((ext_vector_type(4)));
typedef float f32x2 __attribute__((ext_vector_type(2)));
typedef float f32x16 __attribute__((ext_vector_type(16)));
typedef short bf16x8 __attribute__((ext_vector_type(8)));
typedef short s16x4 __attribute__((ext_vector_type(4)));
typedef GAS unsigned gu32;
#define RLX_AGENT __ATOMIC_RELAXED, __HIP_MEMORY_SCOPE_AGENT
#define LDS_WAIT() asm volatile("s_waitcnt lgkmcnt(0)" ::: "memory")
#define VM_WAIT() asm volatile("s_waitcnt vmcnt(0)" ::: "memory")
#define DI __device__ __forceinline__

constexpr int D = 1024, NB = 8, T = 4096, NTOK = NB * T, LCTX = 256, NCTX = NB * LCTX;
constexpr int NH = 4, DK = 256, DV = 512, VTOT = 2048, RIN = 6144;
constexpr int NE = 64, TOPK = 8, EH = 256;
constexpr int CH = 128, NCHUNK = T / CH;
constexpr int NSLICE = 1, SLTOK = NTOK / NSLICE;
constexpr int ECAP = SLTOK;
constexpr int NEX = NE + 1;
constexpr int ACT_ROUTED = SLTOK * TOPK + NE * 256;
constexpr float NORM_EPS = 1e-6f, LN_EPS = 1e-5f;

typedef __bf16 bf16x2_hw __attribute__((ext_vector_type(2)));
typedef float f32x2_hw __attribute__((ext_vector_type(2)));
DI unsigned cvt_pk_bf16(float lo, float hi) { const f32x2_hw v = {lo, hi}; const bf16x2_hw r = __builtin_convertvector(v, bf16x2_hw); return __builtin_bit_cast(unsigned, r); }
DI float bf_lo(unsigned u) { return __uint_as_float(u << 16); }
DI float bf_hi(unsigned u) { return __uint_as_float(u & 0xffff0000u); }
DI float bf2f(bf16 b) { return __uint_as_float(((unsigned)b) << 16); }
DI bf16 f2bf(float f) { return (bf16)(cvt_pk_bf16(f, 0.f) & 0xffffu); }
DI float wave_sum(float v) {
    int x = __builtin_bit_cast(int, v);
#define WS_STEP(ctrl, rmask) x = __builtin_bit_cast(int, __builtin_bit_cast(float, x) + __builtin_bit_cast(float, __builtin_amdgcn_update_dpp(0, x, ctrl, rmask, 0xf, false)))
    WS_STEP(0x111, 0xf); WS_STEP(0x112, 0xf); WS_STEP(0x114, 0xf); WS_STEP(0x118, 0xf); WS_STEP(0x142, 0xa); WS_STEP(0x143, 0xc);
#undef WS_STEP
    return __builtin_bit_cast(float, __builtin_amdgcn_readlane(x, 63));
}
DI float wave_max(float v) {
    int x = __builtin_bit_cast(int, v);
#define WM_STEP(ctrl, rmask) x = __builtin_bit_cast(int, fmaxf(__builtin_bit_cast(float, x), __builtin_bit_cast(float, __builtin_amdgcn_update_dpp((int)0xff800000, x, ctrl, rmask, 0xf, false))))
    WM_STEP(0x111, 0xf); WM_STEP(0x112, 0xf); WM_STEP(0x114, 0xf); WM_STEP(0x118, 0xf); WM_STEP(0x142, 0xa); WM_STEP(0x143, 0xc);
#undef WM_STEP
    return __builtin_bit_cast(float, __builtin_amdgcn_readlane(x, 63));
}
#define G8_DPP(x, ctrl) __builtin_bit_cast(float, __builtin_amdgcn_update_dpp(0, __builtin_bit_cast(int, x), ctrl, 0xf, 0xf, false))
DI float grp8_max(float x) { x = fmaxf(x, G8_DPP(x, 0xB1)); x = fmaxf(x, G8_DPP(x, 0x4E)); x = fmaxf(x, G8_DPP(x, 0x141)); return x; }
DI float grp8_sum(float x) { x += G8_DPP(x, 0xB1); x += G8_DPP(x, 0x4E); x += G8_DPP(x, 0x141); return x; }
DI float lane_xor(float v, int lane, int d) { return __builtin_bit_cast(float, __builtin_amdgcn_ds_bpermute((lane ^ d) << 2, __builtin_bit_cast(int, v))); }
DI float sigmoidf_(float x) { return __builtin_amdgcn_rcpf(1.f + __expf(-x)); }
DI float siluf_(float x) { return x * __builtin_amdgcn_rcpf(1.f + __expf(-x)); }

namespace pg8 {
constexpr int BM = 256, BK = 64, HALF = 128, HTB = HALF * BK * 2, STAGE_BYTES = 8 * HTB, NXCD = 8, WGM = 8;
DI int lds_byte(int r, int c) { const int st = (r >> 4) * 2 + (c >> 5), rr = r & 15, cc = c & 31, ob = rr * 64 + cc * 2; return st * 1024 + (ob ^ (((ob >> 9) & 1) << 5)); }
DI void stage_rc(int b, int& R, int& C) { const int st = b / 1024, sb = b % 1024, swz = sb ^ (((sb >> 9) & 1) << 5); R = (st >> 1) * 16 + swz / 64; C = (st & 1) * 32 + (swz % 64) / 2; }
DI int perm32(int rho) { const int n = rho >> 4, i = rho & 15; return 8 * (i >> 2) + 4 * n + (i & 3); }

struct Unit { int pm, pn, e0, e1; };
struct Gemm { const bf16* A; const bf16* Bt; int K; };

struct StaticOrder {
    int nM, nN, nwg, G, c;
    DI void init(int M, int N, int G_, int c_) { nM = M / BM; nN = N / BM; nwg = nM * nN; G = G_; c = c_; }
    DI bool next(int i, Unit& u) const {
        const long L = (long)i * G + c; if (L >= nwg) return false;
        int wgid = (int)L; { const int q = nwg / NXCD, r = nwg % NXCD, xcd = wgid % NXCD, off = wgid / NXCD; wgid = (xcd < r ? xcd * (q + 1) : r * (q + 1) + (xcd - r) * q) + off; }
        const int nig = WGM * nN, gid = wgid / nig, fm = gid * WGM, gsz = (nM - fm) < WGM ? (nM - fm) : WGM;
        u.pm = fm + ((wgid % nig) % gsz); u.pn = (wgid % nig) / gsz; u.e0 = 0; u.e1 = 0; return true;
    }
    DI int a_row(const Unit&, int) const { return 0; }
};

template <class Epi, class Sched, bool GATHER>
DI void gemm_phase(LAS unsigned char* lds, const Gemm g, const Sched& S, const Epi& E, const int tid, const int stagger_us = 0) {
    if (stagger_us > 0 && (S.c & 1)) {
#pragma unroll 1
        for (int i_ = 0; i_ < stagger_us / 2; ++i_) __builtin_amdgcn_s_sleep(64); }
    const int wid = __builtin_amdgcn_readfirstlane(tid >> 6), lane = tid & 63, wr = wid >> 2, wc = wid & 3, fr = lane & 15, fq = lane >> 4;
    const int K = g.K, nt = K / BK;
    unsigned voffB[2], vA[2][2], nvA[2][2]; int Rr[2], Cc[2];
#pragma unroll
    for (int i = 0; i < 2; ++i) { int R, C; stage_rc(tid * 16 + i * 8192, R, C); const int Rb = Epi::PERM ? ((R & ~31) + perm32(R & 31)) : R;
        voffB[i] = (unsigned)(Rb * K + C) * 2u; Rr[i] = R; Cc[i] = C; }
    const size_t kstep = (size_t)(BK * 2);
    const size_t hstep = (size_t)HALF * K * 2;
    const size_t tstep = 2 * hstep;
    const unsigned ldsw = (unsigned)wid * 1024u;
    const int aoff = lds_byte(wr * 64 + fr, fq * 8), boff = lds_byte(wc * 32 + fr, fq * 8);
#define PG8_SETV(u, v) do { _Pragma("unroll") for (int _h = 0; _h < 2; ++_h) _Pragma("unroll") for (int _i = 0; _i < 2; ++_i) \
        (v)[_h][_i] = GATHER ? (unsigned)(S.a_row((u), _h * 128 + Rr[_i]) * K + Cc[_i]) * 2u : (unsigned)((_h * 128 + Rr[_i]) * K + Cc[_i]) * 2u; } while (0)
#define PG8_SA(b, h) (((b) * 2 + (h)) * HTB)
#define PG8_SB(b, h) ((4 + (b) * 2 + (h)) * HTB)
#define PG8_STAGE(bufoff, gbase, voff) do { _Pragma("unroll") for (int _i = 0; _i < 2; ++_i) \
        __builtin_amdgcn_global_load_lds((const unsigned*)((const char*)(gbase) + (voff)[_i]), (LAS unsigned*)(lds + (bufoff) + ldsw + _i * 8192), 16, 0, 0); } while (0)
#define PG8_LDA(dst, b, h) do { _Pragma("unroll") for (int m = 0; m < 4; ++m) _Pragma("unroll") for (int k = 0; k < 2; ++k) dst[m][k] = *(const LAS bf16x8*)(lds + PG8_SA(b, h) + aoff + m * 2048 + k * 1024); } while (0)
#define PG8_LDB(dst, b, h) do { _Pragma("unroll") for (int n = 0; n < 2; ++n) _Pragma("unroll") for (int k = 0; k < 2; ++k) dst[n][k] = *(const LAS bf16x8*)(lds + PG8_SB(b, h) + boff + n * 2048 + k * 1024); } while (0)
#define PG8_MMA(ai, bj, At, Bt) do { __builtin_amdgcn_s_setprio(1); _Pragma("unroll") for (int m = 0; m < 4; ++m) _Pragma("unroll") for (int n = 0; n < 2; ++n) _Pragma("unroll") for (int k = 0; k < 2; ++k) \
        acc[ai][bj][m][n] = __builtin_amdgcn_mfma_f32_16x16x32_bf16(Bt[n][k], At[m][k], acc[ai][bj][m][n], 0, 0, 0); __builtin_amdgcn_s_setprio(0); } while (0)
#define PG8_WAIT_V(n) asm volatile("s_waitcnt vmcnt(" #n ")" ::: "memory")
#define PG8_WAIT_L(n) asm volatile("s_waitcnt lgkmcnt(" #n ")" ::: "memory")
#define PG8_BAR __builtin_amdgcn_s_barrier()
#define PG8_SCHED __builtin_amdgcn_sched_barrier(0)
    Unit cur, nxt; int ui = 0;
    if (!S.next(0, cur)) return;
    f32x4 acc[2][2][4][2];
#pragma unroll
    for (int a = 0; a < 2; ++a)
#pragma unroll
        for (int b = 0; b < 2; ++b)
#pragma unroll
            for (int m = 0; m < 4; ++m)
#pragma unroll
                for (int n = 0; n < 2; ++n) acc[a][b][m][n] = (f32x4){0.f, 0.f, 0.f, 0.f};
    bf16x8 At[4][2], B0[2][2], B1[2][2];
    PG8_SETV(cur, vA);
    const char* cA = GATHER ? (const char*)g.A : (const char*)g.A + (size_t)cur.pm * tstep; const char* cB = (const char*)g.Bt + (size_t)cur.pn * tstep;
    PG8_STAGE(PG8_SB(0, 0), cB, voffB); PG8_STAGE(PG8_SB(0, 1), cB + hstep, voffB); PG8_STAGE(PG8_SA(0, 0), cA, vA[0]); PG8_STAGE(PG8_SA(0, 1), cA, vA[1]);
    if (wr == 1) PG8_BAR;
    PG8_WAIT_V(2); PG8_BAR;
    PG8_STAGE(PG8_SB(1, 0), cB + kstep, voffB); PG8_STAGE(PG8_SA(1, 0), cA + kstep, vA[0]); PG8_STAGE(PG8_SB(1, 1), cB + hstep + kstep, voffB);
    PG8_WAIT_V(6); PG8_BAR;
    for (;;) {
        const bool has_next = S.next(ui + 1, nxt);
        const char* nA = has_next ? (GATHER ? (const char*)g.A : (const char*)g.A + (size_t)nxt.pm * tstep) : cA; const char* nB = has_next ? (const char*)g.Bt + (size_t)nxt.pn * tstep : cB;
        if (GATHER) { if (has_next) { PG8_SETV(nxt, nvA); } else {
#pragma unroll
            for (int h = 0; h < 2; ++h)
#pragma unroll
                for (int i = 0; i < 2; ++i) nvA[h][i] = vA[h][i]; } }
#pragma unroll 1
        for (int t = 0; t < nt; t += 2) {
            const bool last = (t == nt - 2);
            const char* a1 = cA + (size_t)(t + 1) * kstep;
            const char* a2 = last ? nA : cA + (size_t)(t + 2) * kstep; const char* b2 = last ? nB : cB + (size_t)(t + 2) * kstep;
            const char* a3 = a2 + kstep; const char* b3 = b2 + kstep;
            unsigned s2[2][2];
#pragma unroll
            for (int h = 0; h < 2; ++h)
#pragma unroll
                for (int i = 0; i < 2; ++i) s2[h][i] = (GATHER && last) ? nvA[h][i] : vA[h][i];
            PG8_LDB(B0, 0, 0); PG8_LDB(B1, 0, 1); PG8_SCHED; PG8_LDA(At, 0, 0); PG8_STAGE(PG8_SA(1, 1), a1, vA[1]);
            PG8_WAIT_V(8); PG8_WAIT_L(0); PG8_BAR; PG8_MMA(0, 0, At, B0); PG8_MMA(0, 1, At, B1); PG8_BAR; PG8_SCHED;
            PG8_LDA(At, 0, 1); PG8_STAGE(PG8_SB(0, 0), b2, voffB); PG8_STAGE(PG8_SB(0, 1), b2 + hstep, voffB); PG8_STAGE(PG8_SA(0, 0), a2, s2[0]);
            PG8_WAIT_V(8); PG8_WAIT_L(0); PG8_BAR; PG8_MMA(1, 0, At, B0); PG8_MMA(1, 1, At, B1); PG8_BAR; PG8_SCHED;
            PG8_LDB(B0, 1, 0); PG8_LDB(B1, 1, 1); PG8_SCHED; PG8_LDA(At, 1, 0); PG8_STAGE(PG8_SA(0, 1), a2, s2[1]);
            PG8_WAIT_V(8); PG8_WAIT_L(0); PG8_BAR; PG8_MMA(0, 0, At, B0); PG8_MMA(0, 1, At, B1); PG8_BAR; PG8_SCHED;
            PG8_LDA(At, 1, 1); PG8_STAGE(PG8_SB(1, 0), b3, voffB); PG8_STAGE(PG8_SB(1, 1), b3 + hstep, voffB); PG8_STAGE(PG8_SA(1, 0), a3, s2[0]);
            PG8_WAIT_V(8); PG8_WAIT_L(0); PG8_BAR; PG8_MMA(1, 0, At, B0); PG8_MMA(1, 1, At, B1); PG8_BAR; PG8_SCHED;
        }
        if (wr == 0) PG8_BAR;
        { int tz = tid; asm volatile("" : "+v"(tz));
          const int wid2 = __builtin_amdgcn_readfirstlane(tz >> 6), lane2 = tz & 63;
          E(acc, cur, wid2 >> 2, wid2 & 3, lane2 & 15, lane2 >> 4); }
        if (!has_next) break;
#pragma unroll
        for (int a = 0; a < 2; ++a)
#pragma unroll
            for (int b = 0; b < 2; ++b)
#pragma unroll
                for (int m = 0; m < 4; ++m)
#pragma unroll
                    for (int n = 0; n < 2; ++n) acc[a][b][m][n] = (f32x4){0.f, 0.f, 0.f, 0.f};
        cur = nxt; cA = nA; cB = nB; ++ui;
        if (GATHER) {
#pragma unroll
            for (int h = 0; h < 2; ++h)
#pragma unroll
                for (int i = 0; i < 2; ++i) vA[h][i] = nvA[h][i]; }
        if (wr == 1) PG8_BAR;
    }
    PG8_WAIT_V(0);
    PG8_BAR;
#undef PG8_SETV
#undef PG8_SA
#undef PG8_SB
#undef PG8_STAGE
#undef PG8_LDA
#undef PG8_LDB
#undef PG8_MMA
#undef PG8_WAIT_V
#undef PG8_WAIT_L
#undef PG8_BAR
#undef PG8_SCHED
}
}
using pg8::Unit;

constexpr size_t MiB = 1u << 20;
constexpr size_t WS_CTL = 0, CTL_ZERO_BYTES = 2 * MiB;
constexpr size_t WS_MOD = 2 * MiB;
constexpr size_t WS_ROPE = 4 * MiB;
constexpr size_t WS_WIN = 10 * MiB, WS_WOUT = 22 * MiB, WS_CW1 = 26 * MiB, WS_CW2 = 30 * MiB;
constexpr size_t WS_W13 = 32 * MiB, WS_W2 = 97 * MiB;
constexpr size_t WS_LIST = 130 * MiB;
constexpr size_t LIST_ARR = (size_t)NEX * ECAP * 4, LIST_SLICE = 3 * LIST_ARR;
constexpr size_t WS_BIG = 160 * MiB;
constexpr size_t WS_Q = WS_BIG, WS_K = WS_Q + 64 * MiB, WS_V = WS_K + 64 * MiB, WS_G = WS_V + 128 * MiB;
constexpr size_t WS_KC = 544 * MiB, WS_VC = 548 * MiB, WS_P = 560 * MiB;
constexpr size_t WS_Y = WS_BIG;
constexpr size_t WS_ACT = WS_BIG;
constexpr size_t WS_Y2 = WS_BIG + 152 * MiB;
constexpr size_t WS_U = WS_Y2;
constexpr size_t WS_UC = WS_BIG;
constexpr size_t WS_Z = WS_BIG + 64 * MiB, WS_C = WS_BIG + 128 * MiB, WS_Y1 = WS_BIG + 216 * MiB;
constexpr size_t WS_END = 600 * MiB;
static_assert(WS_LIST + NSLICE * LIST_SLICE <= WS_BIG, "lists");
static_assert(WS_ACT + (size_t)(ACT_ROUTED + SLTOK) * 512 <= WS_Y2, "act");
static_assert(WS_Y2 + (size_t)SLTOK * 9 * 1024 <= WS_END, "y2");
static_assert(WS_W13 + (size_t)NEX * 512 * 1024 * 2 <= WS_W2 && WS_W2 + (size_t)NEX * 1024 * 256 * 2 <= WS_LIST, "moe w");
constexpr int CW_TMO = 0, CW_CODE = 1;
constexpr int CW_BAR = 4096;
constexpr int CW_CNT = 16384;
DI int cnt_word(int layer, int slice, int e) { return CW_CNT + ((layer * NSLICE + slice) * NE + e) * 16; }

constexpr int RING_OFF = 0, RING_BYTES = 131072;
constexpr int LDSCTL_OFF = 148480, MISC_OFF = LDSCTL_OFF + 1024;
constexpr int LDS_BYTES = 152576;

#define XB_TMO      128
#define XB_XCNT(j)  (256  + 64 * (j))
#define XB_XSUB(j)  (1280 + 64 * (j))
#define XB_XGEN(j)  (2304 + 64 * (j))
#define XB_TOP      3328
#define XB_TOPGEN   3392
#define XCD_BAR_WORDS 3456
#define XB_SPIN_CAP (1u << 18)
DI unsigned xb_ld(unsigned* p)              { return __hip_atomic_load(p, __ATOMIC_RELAXED, __HIP_MEMORY_SCOPE_AGENT); }
DI unsigned xb_add(unsigned* p, unsigned v) { return __hip_atomic_fetch_add(p, v, __ATOMIC_RELAXED, __HIP_MEMORY_SCOPE_AGENT); }
DI unsigned xb_xcc_id() { return (unsigned)__builtin_amdgcn_s_getreg((3 << 11) | 20) & 0xFu; }
#define XB_SPIN(cond, bar) do { unsigned _sp = 0; while (cond) { __builtin_amdgcn_s_sleep(1); \
    if ((++_sp & 255u) == 0u) { if (xb_ld(&(bar)[XB_TMO])) break; if (_sp > XB_SPIN_CAP) { atomicAdd(&(bar)[XB_TMO], 1u); break; } } } } while (0)
struct XcdBarrier { unsigned* bar; unsigned x; volatile LAS unsigned* st; };
DI XcdBarrier xcd_barrier_post(unsigned* bar, volatile LAS unsigned* st) {
    XcdBarrier b; b.bar = bar; b.x = xb_xcc_id(); b.st = st;
    if (threadIdx.x == 0) (void)xb_add(&bar[XB_XCNT(b.x)], 1u);
    return b;
}
DI void xcd_barrier_complete(unsigned* bar, unsigned x, unsigned& nloc, unsigned& nx) {
    const unsigned G = gridDim.x * gridDim.y * gridDim.z;
    unsigned sum, cnt, mine, sp = 0u;
    for (;;) {
        sum = 0u; cnt = 0u; mine = 0u;
#pragma unroll
        for (unsigned j = 0; j < 16; ++j) { const unsigned c = xb_ld(&bar[XB_XCNT(j)]); sum += c; cnt += (c > 0u) ? 1u : 0u; mine = (j == x) ? c : mine; }
        if (sum == G) break;
        __builtin_amdgcn_s_sleep(1);
        if ((++sp & 255u) == 0u) { if (xb_ld(&bar[XB_TMO])) break; if (sp > XB_SPIN_CAP) { atomicAdd(&bar[XB_TMO], 1u); break; } }
    }
    nloc = mine > 0u ? mine : 1u; nx = cnt > 0u ? cnt : 1u;
}
DI void xcd_barrier(const XcdBarrier& b, const bool leader) {
    asm volatile("s_waitcnt vmcnt(0)" ::: "memory");
    __syncthreads();
    if (leader) {
        unsigned* bar = b.bar;
        __builtin_amdgcn_s_waitcnt(0);
        unsigned nloc = b.st[0], nx = b.st[1];
        if (nloc == 0u) { xcd_barrier_complete(bar, b.x, nloc, nx); b.st[0] = nloc; b.st[1] = nx; }
        const unsigned old = xb_add(&bar[XB_XSUB(b.x)], 1u);
        const unsigned gen = old / nloc;
        if (old + 1u == (gen + 1u) * nloc) {
            __builtin_amdgcn_fence(__ATOMIC_RELEASE, "agent");
            asm volatile("s_waitcnt vmcnt(0)" ::: "memory");
            const unsigned og = xb_add(&bar[XB_TOP], 1u);
            const unsigned tg = og / nx;
            if (og + 1u == (tg + 1u) * nx) xb_add(&bar[XB_TOPGEN], 1u);
            else XB_SPIN(xb_ld(&bar[XB_TOPGEN]) == tg, bar);
            __builtin_amdgcn_fence(__ATOMIC_ACQUIRE, "agent");
            xb_add(&bar[XB_XGEN(b.x)], 1u);
            asm volatile("s_waitcnt vmcnt(0)" ::: "memory");
        } else {
            XB_SPIN(xb_ld(&bar[XB_XGEN(b.x)]) == gen, bar);
            __builtin_amdgcn_fence(__ATOMIC_ACQUIRE, "agent");
            asm volatile("s_waitcnt vmcnt(0)" ::: "memory");
        }
    }
    __syncthreads();
}

struct Frame {
    LAS unsigned char* lds;
    volatile LAS unsigned* MISC;
    unsigned* ctl;
    unsigned char* ws;
    int tid, lane, wave, vcu, G;
    float* out;
};
enum { I_X = 0, I_C, I_CTX, I_CCTX, I_MODW, I_MODB, I_NORMS, I_RWIN, I_RWOUT, I_RDECAY, I_CW1, I_CB1, I_CDW, I_CBDW, I_CLNG, I_CLNB, I_CW2, I_CB2,
       I_ROUTER, I_MBIAS, I_MW1, I_MW3, I_MW2, I_SW1, I_SW3, I_SW2 };

typedef const f32x4 (&AccRef)[2][2][4][2];
DI void st16(bf16* p, unsigned a, unsigned b, unsigned c, unsigned d) { v4u o; o.x = a; o.y = b; o.z = c; o.w = d; *(GAS v4u*)p = o; }

struct EpiQKVG {
    static constexpr bool PERM = true;
    unsigned char* ws;
    DI void operator()(AccRef acc, const Unit& u, int wr, int wc, int fr, int fq) const {
        const bool ctx = u.pm >= 128;
        const int rbase = u.pm * 256 + wr * 64 + fr, cw = wc * 32 + 8 * fq, pn = u.pn;
        if (pn < 8) {
            const bool isq = pn < 4; const int head = pn & 3;
            const size_t doff = ctx ? WS_KC : (isq ? WS_Q : WS_K);
            bf16* dst = (bf16*)(ws + doff);
            const int bb = ctx ? u.pm - 128 : u.pm >> 4, nch = ctx ? 2 : NCHUNK;
            const float* cs = (const float*)(ws + WS_ROPE) + (ctx ? 2 * T * 128 : 0);
            const int snoff = ctx ? LCTX * 128 : T * 128;
            const float sc = isq ? 0.0625f : 1.f;
#pragma unroll
            for (int ai = 0; ai < 2; ++ai)
#pragma unroll
                for (int m = 0; m < 4; ++m) {
                    const int row = rbase + ai * 128 + m * 16, rr = ctx ? row - NTOK : row, t = ctx ? (rr & (LCTX - 1)) : (row & (T - 1));
#pragma unroll
                    for (int bj = 0; bj < 2; ++bj) {
                        const int p0 = bj * 64 + wc * 16 + 4 * fq;
                        const f32x4 c = *(const GAS f32x4*)(cs + (size_t)t * 128 + p0), s = *(const GAS f32x4*)(cs + snoff + (size_t)t * 128 + p0);
                        const f32x4 v0 = acc[ai][bj][m][0], v1 = acc[ai][bj][m][1];
                        const float o0 = (v0[0] * c[0] - v0[1] * s[0]) * sc, o1 = (v0[0] * s[0] + v0[1] * c[0]) * sc;
                        const float o2 = (v0[2] * c[1] - v0[3] * s[1]) * sc, o3 = (v0[2] * s[1] + v0[3] * c[1]) * sc;
                        const float o4 = (v1[0] * c[2] - v1[1] * s[2]) * sc, o5 = (v1[0] * s[2] + v1[1] * c[2]) * sc;
                        const float o6 = (v1[2] * c[3] - v1[3] * s[3]) * sc, o7 = (v1[2] * s[3] + v1[3] * c[3]) * sc;
                        const int chunk = ctx ? ai : ((2 * u.pm + ai) & (NCHUNK - 1)), itq = wr * 2 + (m >> 1), rq = (m & 1) * 16 + fr, ksq = bj * 8 + wc * 2 + (fq >> 1);
                        st16(dst + ((((size_t)(bb * nch + chunk) * NH + head) * 4 + itq) * 16 + ksq) * 512 + (rq + 32 * (fq & 1)) * 8, cvt_pk_bf16(o0, o1), cvt_pk_bf16(o2, o3), cvt_pk_bf16(o4, o5), cvt_pk_bf16(o6, o7));
                    }
                }
        } else {
            const bool isg = pn >= 16; const int ct = (pn - (isg ? 16 : 8)) * 256;
            const size_t doff = isg ? WS_G : (ctx ? WS_VC : WS_V);
            bf16* dst = (bf16*)(ws + doff);
#pragma unroll
            for (int ai = 0; ai < 2; ++ai)
#pragma unroll
                for (int m = 0; m < 4; ++m) {
                    const int row = rbase + ai * 128 + m * 16, rr = ctx ? row - NTOK : row;
#pragma unroll
                    for (int bj = 0; bj < 2; ++bj) {
                        f32x4 v0 = acc[ai][bj][m][0], v1 = acc[ai][bj][m][1];
                        if (isg) {
#pragma unroll
                            for (int e = 0; e < 4; ++e) { v0[e] = siluf_(v0[e]); v1[e] = siluf_(v1[e]); }
                        }
                        st16(dst + (size_t)rr * 2048 + ct + bj * 128 + cw, cvt_pk_bf16(v0[0], v0[1]), cvt_pk_bf16(v0[2], v0[3]), cvt_pk_bf16(v1[0], v1[1]), cvt_pk_bf16(v1[2], v1[3]));
                    }
                }
        }
    }
};
struct InprojOrder {
    pg8::StaticOrder so; int G, c;
    DI void init(int G_, int c_) { so.init(NTOK, RIN, G_, c_); G = G_; c = c_; }
    DI bool next(int i, Unit& u) const {
        const int L = i * G + c;
        if (L < 3072) return so.next(i, u);
        const int l2 = L - 3072; if (l2 >= 96) return false;
        u.pm = 128 + l2 / 12; u.pn = 4 + l2 % 12; u.e0 = 0; u.e1 = 0; return true;
    }
    DI int a_row(const Unit&, int) const { return 0; }
};
struct EpiBf16 {
    static constexpr bool PERM = true;
    bf16* O; int ldc; const float* bias;
    DI void operator()(AccRef acc, const Unit& u, int wr, int wc, int fr, int fq) const {
        const int rbase = u.pm * 256 + wr * 64 + fr, cbase = u.pn * 256 + wc * 32 + 8 * fq;
#pragma unroll
        for (int bj = 0; bj < 2; ++bj) {
            f32x4 b0 = (f32x4){0.f, 0.f, 0.f, 0.f}, b1 = b0;
            if (bias) { b0 = *(const GAS f32x4*)(bias + cbase + bj * 128); b1 = *(const GAS f32x4*)(bias + cbase + bj * 128 + 4); }
#pragma unroll
            for (int ai = 0; ai < 2; ++ai)
#pragma unroll
                for (int m = 0; m < 4; ++m) {
                    const f32x4 v0 = acc[ai][bj][m][0] + b0, v1 = acc[ai][bj][m][1] + b1;
                    st16(O + (size_t)(rbase + ai * 128 + m * 16) * ldc + cbase + bj * 128, cvt_pk_bf16(v0[0], v0[1]), cvt_pk_bf16(v0[2], v0[3]), cvt_pk_bf16(v1[0], v1[1]), cvt_pk_bf16(v1[2], v1[3]));
                }
        }
    }
};
struct EpiGLU {
    static constexpr bool PERM = true;
    bf16* Z; const float* b1;
    DI void operator()(AccRef acc, const Unit& u, int wr, int wc, int fr, int fq) const {
        const int rbase = u.pm * 256 + wr * 64 + fr, cc = u.pn * 128 + wc * 32 + 8 * fq;
        const f32x4 ba0 = *(const GAS f32x4*)(b1 + cc), ba1 = *(const GAS f32x4*)(b1 + cc + 4), bg0 = *(const GAS f32x4*)(b1 + 1024 + cc), bg1 = *(const GAS f32x4*)(b1 + 1024 + cc + 4);
#pragma unroll
        for (int ai = 0; ai < 2; ++ai)
#pragma unroll
            for (int m = 0; m < 4; ++m) {
                const f32x4 a0 = acc[ai][0][m][0] + ba0, a1 = acc[ai][0][m][1] + ba1, g0 = acc[ai][1][m][0] + bg0, g1 = acc[ai][1][m][1] + bg1;
                f32x4 o0, o1;
#pragma unroll
                for (int e = 0; e < 4; ++e) { o0[e] = a0[e] * sigmoidf_(g0[e]); o1[e] = a1[e] * sigmoidf_(g1[e]); }
                st16(Z + (size_t)(rbase + ai * 128 + m * 16) * 1024 + cc, cvt_pk_bf16(o0[0], o0[1]), cvt_pk_bf16(o0[2], o0[3]), cvt_pk_bf16(o1[0], o1[1]), cvt_pk_bf16(o1[2], o1[3]));
            }
    }
};
struct MoeOrder {
    const LAS int* cum; const LAS int* cnt; const LAS int* rb; const LAS unsigned char* eob; const int* ltok; int npn, G, c, total;
    DI bool next(int i, Unit& u) const {
        const int L = i * G + c; if (L >= total) return false;
        const int blk = L / npn, sub = L - blk * npn;
        const int e = eob[blk];
        const int bi = blk - cum[e];
        u.pm = blk; u.pn = e * npn + sub; const int left = cnt[e] - bi * 256; u.e1 = left < 256 ? left : 256;
        u.e0 = ltok ? e * ECAP + bi * 256 : rb[e] + bi * 256;
        return true;
    }
    DI int a_row(const Unit& u, int r) const { return r < u.e1 ? ltok[u.e0 + r] : 0; }
};
struct EpiSwiGLU {
    static constexpr bool PERM = true;
    bf16* ACT;
    DI void operator()(AccRef acc, const Unit& u, int wr, int wc, int fr, int fq) const {
        const int rbase = u.pm * 256 + wr * 64 + fr, cc = (u.pn & 1) * 128 + wc * 32 + 8 * fq;
#pragma unroll
        for (int ai = 0; ai < 2; ++ai)
#pragma unroll
            for (int m = 0; m < 4; ++m) {
                const f32x4 a0 = acc[ai][0][m][0], a1 = acc[ai][0][m][1], g0 = acc[ai][1][m][0], g1 = acc[ai][1][m][1];
                f32x4 o0, o1;
#pragma unroll
                for (int e = 0; e < 4; ++e) { o0[e] = siluf_(a0[e]) * g0[e]; o1[e] = siluf_(a1[e]) * g1[e]; }
                st16(ACT + (size_t)(rbase + ai * 128 + m * 16) * 256 + cc, cvt_pk_bf16(o0[0], o0[1]), cvt_pk_bf16(o0[2], o0[3]), cvt_pk_bf16(o1[0], o1[1]), cvt_pk_bf16(o1[2], o1[3]));
            }
    }
};
struct EpiMoeOut {
    static constexpr bool PERM = true;
    unsigned char* Y2; int nostore;
    DI void operator()(AccRef acc, const Unit& u, int wr, int wc, int fr, int fq) const {
        const int ch = ((u.pn & 3) * 16 + wc * 4 + fq) * 16;
        if (nostore) { if (acc[0][0][0][0][0] != 12345.678f || acc[1][1][3][1][3] != 321.f) return; }
#pragma unroll
        for (int ai = 0; ai < 2; ++ai)
#pragma unroll
            for (int m = 0; m < 4; ++m) {
                const int r = ai * 128 + wr * 64 + m * 16 + fr;
                if (r < u.e1) {
                    unsigned pk[4];
#pragma unroll
                    for (int bj = 0; bj < 2; ++bj) {
                        const f32x4 v0 = acc[ai][bj][m][0], v1 = acc[ai][bj][m][1];
                        int p0 = __builtin_amdgcn_cvt_pk_fp8_f32(v0[0], v0[1], 0, false); p0 = __builtin_amdgcn_cvt_pk_fp8_f32(v0[2], v0[3], p0, true);
                        int p1 = __builtin_amdgcn_cvt_pk_fp8_f32(v1[0], v1[1], 0, false); p1 = __builtin_amdgcn_cvt_pk_fp8_f32(v1[2], v1[3], p1, true);
                        pk[2 * bj] = (unsigned)p0; pk[2 * bj + 1] = (unsigned)p1;
                    }
                    *(GAS v4u*)(Y2 + (size_t)(u.e0 + r) * 1024 + ch) = (v4u){pk[0], pk[1], pk[2], pk[3]};
                }
            }
    }
};

struct TrItem { const float* src; bf16* dst; int ldsrc, Kd; };
DI void tr_load(const TrItem& t, float (&tv)[32], int lane) {
#pragma unroll
    for (int i = 0; i < 32; ++i) { const int kk = 2 * i + (lane >> 5); tv[i] = t.src[(size_t)kk * t.ldsrc + (lane & 31)]; }
}
DI void tr_store(const TrItem& t, const float (&tv)[32], LAS float* scr, int lane) {
#pragma unroll
    for (int i = 0; i < 32; ++i) { const int kk = 2 * i + (lane >> 5); scr[kk * 33 + (lane & 31)] = tv[i]; }
    LDS_WAIT(); asm volatile("" ::: "memory");
    const int c = lane & 7;
#pragma unroll
    for (int j = 0; j < 4; ++j) { const int n = (lane >> 3) + 8 * j; const LAS float* s = scr + (8 * c) * 33 + n;
        v4u o; o.x = cvt_pk_bf16(s[0 * 33], s[1 * 33]); o.y = cvt_pk_bf16(s[2 * 33], s[3 * 33]); o.z = cvt_pk_bf16(s[4 * 33], s[5 * 33]); o.w = cvt_pk_bf16(s[6 * 33], s[7 * 33]);
        *(GAS v4u*)(t.dst + (size_t)n * t.Kd + 8 * c) = o; }
    LDS_WAIT(); asm volatile("" ::: "memory");
}
DI TrItem tr_mk(const float* src, int ldsrc, int k0, int scol0, bf16* dst, int Kd, int drow0) { TrItem t; t.src = src + (size_t)k0 * ldsrc + scol0; t.dst = dst + (size_t)drow0 * Kd + k0; t.ldsrc = ldsrc; t.Kd = Kd; return t; }
template <class MK> DI void tr_run(int it0, int step, int n, LAS float* scr, int lane, MK mk) {
    float ta[32], tb[32];
    TrItem ia, ib;
    if (it0 < n) { ia = mk(it0); tr_load(ia, ta, lane); }
    for (int it = it0; it < n; it += 2 * step) {
        const bool hb = it + step < n;
        if (hb) { ib = mk(it + step); tr_load(ib, tb, lane); }
        tr_store(ia, ta, scr, lane);
        if (hb) {
            if (it + 2 * step < n) { ia = mk(it + 2 * step); tr_load(ia, ta, lane); }
            tr_store(ib, tb, scr, lane);
        }
    }
}
DI void conv_moe_weights(Frame& F, int layer, const float* mw1, const float* mw3, const float* mw2, const float* sw1, const float* sw3, const float* sw2) {
    LAS float* scr = (LAS float*)(F.lds + RING_OFF + F.wave * 16384);
    const int gw = F.vcu * 8 + F.wave, NGW = F.G * 8;
    bf16* W13 = (bf16*)(F.ws + WS_W13); bf16* W2 = (bf16*)(F.ws + WS_W2);
    constexpr int I13 = 16 * 16, I2 = 4 * 32, PER = I13 + I2;
    tr_run(gw, NGW, NEX * PER, scr, F.lane, [&](int it) -> TrItem {
        const int e = it / PER, r = it - e * PER;
        if (r < I13) {
            const int kb = r >> 4, nb = r & 15;
            const float* s1 = e < NE ? mw1 + ((size_t)(layer * NE + e) << 18) : sw1 + ((size_t)layer << 18);
            const float* s3 = e < NE ? mw3 + ((size_t)(layer * NE + e) << 18) : sw3 + ((size_t)layer << 18);
            const float* src = (nb & 7) < 4 ? s1 : s3;
            return tr_mk(src, 256, kb * 64, 128 * (nb >> 3) + 32 * (nb & 3), W13, 1024, e * 512 + nb * 32);
        } else {
            const int r2 = r - I13, kb = r2 >> 5, nb = r2 & 31;
            const float* src = e < NE ? mw2 + ((size_t)(layer * NE + e) << 18) : sw2 + ((size_t)layer << 18);
            return tr_mk(src, 1024, kb * 64, nb * 32, W2, 256, e * 1024 + nb * 32);
        }
    });
}
DI void conv_small_weights(Frame& F, const float* rwin, const float* rwout, const float* cw1, const float* cw2) {
    LAS float* scr = (LAS float*)(F.lds + RING_OFF + F.wave * 16384);
    const int gw = F.vcu * 8 + F.wave, NGW = F.G * 8;
    constexpr int I_IN = 16 * 192, I_OUT = 32 * 32, I_C1 = 16 * 64, I_C2 = 16 * 32, TOT = I_IN + I_OUT + I_C1 + I_C2;
    unsigned char* ws = F.ws;
    tr_run(gw, NGW, TOT, scr, F.lane, [&](int it) -> TrItem {
        int r = it;
        if (r < I_IN) { const int kb = r / 192, nb = r % 192; return tr_mk(rwin, RIN, kb * 64, nb * 32, (bf16*)(ws + WS_WIN), 1024, nb * 32); } r -= I_IN;
        if (r < I_OUT) { const int kb = r >> 5, nb = r & 31; return tr_mk(rwout, 1024, kb * 64, nb * 32, (bf16*)(ws + WS_WOUT), 2048, nb * 32); } r -= I_OUT;
        if (r < I_C1) { const int kb = r >> 6, nb = r & 63; const int sc0 = ((nb & 7) < 4 ? 0 : 1024) + 128 * (nb >> 3) + 32 * (nb & 3);
            return tr_mk(cw1, 2048, kb * 64, sc0, (bf16*)(ws + WS_CW1), 1024, nb * 32); } r -= I_C1;
        { const int kb = r >> 5, nb = r & 31; return tr_mk(cw2, 1024, kb * 64, nb * 32, (bf16*)(ws + WS_CW2), 1024, nb * 32); }
    });
}
DI void rope_tables(Frame& F) {
    float* csL = (float*)(F.ws + WS_ROPE); float* snL = csL + T * 128; float* csC = snL + T * 128; float* snC = csC + LCTX * 128;
    const int gt = F.vcu * 512 + F.tid, NT = F.G * 512;
    for (int i = gt; i < (T + LCTX) * 128; i += NT) {
        const int t = i >> 7, p = i & 127;
        int ax, ii, dd; if (p < 32) { ax = 0; ii = p; dd = 64; } else if (p < 80) { ax = 1; ii = p - 32; dd = 96; } else { ax = 2; ii = p - 80; dd = 96; }
        const float inv = exp2f(-13.287712379549449f * (float)(2 * ii) / (float)dd);
        int pos;
        if (t < T) pos = ax == 0 ? LCTX : (ax == 1 ? (t >> 6) : (t & 63)); else pos = ax == 0 ? (t - T) : 0;
        const float ang = (float)pos * inv;
        const float rev = ang * 0.15915494309189535f;
        const float fr = rev - floorf(rev);
        const float s = __builtin_amdgcn_sinf(fr), c = __builtin_amdgcn_cosf(fr);
        if (t < T) { csL[i] = c; snL[i] = s; } else { csC[i - T * 128] = c; snC[i - T * 128] = s; }
    }
}
DI void mod_vectors(Frame& F, const float* cin, const float* cctx, const float* modw, const float* modb) {
    LAS float* sl = (LAS float*)(F.lds + RING_OFF);
    LAS float* red = sl + 9 * 1024;
    if (F.vcu >= 192) return;
    for (int i = F.tid; i < 9 * 1024; i += 512) { const float v = i < 8192 ? cin[i] : cctx[i - 8192]; sl[i] = siluf_(v); }
    __syncthreads();
    float* MOD = (float*)(F.ws + WS_MOD);
    for (int it = F.vcu; it < 192; it += F.G) {
        const int l = it / 96, cb = (it % 96) * 64;
        const float* w = modw + (size_t)l * 1024 * 6144 + cb + F.lane;
        float a[9];
#pragma unroll
        for (int b = 0; b < 9; ++b) a[b] = 0.f;
        const int k0 = F.wave * 128;
#pragma unroll 8
        for (int k = 0; k < 128; ++k) { const float wv = w[(size_t)(k0 + k) * 6144];
#pragma unroll
            for (int b = 0; b < 9; ++b) a[b] += sl[b * 1024 + k0 + k] * wv; }
#pragma unroll
        for (int b = 0; b < 9; ++b) red[(F.wave * 9 + b) * 64 + F.lane] = a[b];
        __syncthreads();
        for (int o = F.tid; o < 9 * 64; o += 512) { const int b = o >> 6, c = o & 63; float s = modb[l * 6144 + cb + c];
#pragma unroll
            for (int w8 = 0; w8 < 8; ++w8) s += red[(w8 * 9 + b) * 64 + c];
            MOD[(size_t)(l * 9 + b) * 6144 + cb + c] = s; }
        __syncthreads();
    }
}

DI void ld_row_f32(const float* p, int lane, float (&v)[16]) {
#pragma unroll
    for (int j = 0; j < 2; ++j) { const f32x4 a = *(const GAS f32x4*)(p + 512 * j + 8 * lane), b = *(const GAS f32x4*)(p + 512 * j + 8 * lane + 4);
#pragma unroll
        for (int e = 0; e < 4; ++e) { v[8 * j + e] = a[e]; v[8 * j + 4 + e] = b[e]; } }
}
DI void st_row_f32(float* p, int lane, const float (&v)[16]) {
#pragma unroll
    for (int j = 0; j < 2; ++j) { *(GAS f32x4*)(p + 512 * j + 8 * lane) = (f32x4){v[8 * j], v[8 * j + 1], v[8 * j + 2], v[8 * j + 3]}; *(GAS f32x4*)(p + 512 * j + 8 * lane + 4) = (f32x4){v[8 * j + 4], v[8 * j + 5], v[8 * j + 6], v[8 * j + 7]}; }
}
DI void ld_row_bf16(const bf16* p, int lane, float (&v)[16]) {
#pragma unroll
    for (int j = 0; j < 2; ++j) { const v4u a = *(const GAS v4u*)(p + 512 * j + 8 * lane);
        v[8 * j + 0] = bf_lo(a.x); v[8 * j + 1] = bf_hi(a.x); v[8 * j + 2] = bf_lo(a.y); v[8 * j + 3] = bf_hi(a.y); v[8 * j + 4] = bf_lo(a.z); v[8 * j + 5] = bf_hi(a.z); v[8 * j + 6] = bf_lo(a.w); v[8 * j + 7] = bf_hi(a.w); }
}
DI void ld_row_fp8(const unsigned char* p, int lane, float (&v)[16]) {
#pragma unroll
    for (int j = 0; j < 2; ++j) { const v2u a = *(const GAS v2u*)(p + 512 * j + 8 * lane);
        const f32x2 d0 = __builtin_amdgcn_cvt_pk_f32_fp8((int)a.x, false), d1 = __builtin_amdgcn_cvt_pk_f32_fp8((int)a.x, true), d2 = __builtin_amdgcn_cvt_pk_f32_fp8((int)a.y, false), d3 = __builtin_amdgcn_cvt_pk_f32_fp8((int)a.y, true);
        v[8 * j + 0] = d0[0]; v[8 * j + 1] = d0[1]; v[8 * j + 2] = d1[0]; v[8 * j + 3] = d1[1]; v[8 * j + 4] = d2[0]; v[8 * j + 5] = d2[1]; v[8 * j + 6] = d3[0]; v[8 * j + 7] = d3[1]; }
}
DI void st_row_bf16(bf16* p, int lane, const float (&v)[16]) {
#pragma unroll
    for (int j = 0; j < 2; ++j) st16(p + 512 * j + 8 * lane, cvt_pk_bf16(v[8 * j], v[8 * j + 1]), cvt_pk_bf16(v[8 * j + 2], v[8 * j + 3]), cvt_pk_bf16(v[8 * j + 4], v[8 * j + 5]), cvt_pk_bf16(v[8 * j + 6], v[8 * j + 7]));
}
DI int colx(int lane, int j) { return (lane >> 4) * 256 + (lane & 15) * 8 + 128 * j; }
DI void ld_rowx_f32(const float* p, int lane, float (&v)[16]) {
#pragma unroll
    for (int j = 0; j < 2; ++j) { const f32x4 a = *(const GAS f32x4*)(p + colx(lane, j)), b = *(const GAS f32x4*)(p + colx(lane, j) + 4);
#pragma unroll
        for (int e = 0; e < 4; ++e) { v[8 * j + e] = a[e]; v[8 * j + 4 + e] = b[e]; } }
}
DI void st_rowx_f32(float* p, int lane, const float (&v)[16]) {
#pragma unroll
    for (int j = 0; j < 2; ++j) { *(GAS f32x4*)(p + colx(lane, j)) = (f32x4){v[8 * j], v[8 * j + 1], v[8 * j + 2], v[8 * j + 3]}; *(GAS f32x4*)(p + colx(lane, j) + 4) = (f32x4){v[8 * j + 4], v[8 * j + 5], v[8 * j + 6], v[8 * j + 7]}; }
}
DI void st_rowx_bf16(bf16* p, int lane, const float (&v)[16]) {
#pragma unroll
    for (int j = 0; j < 2; ++j) st16(p + colx(lane, j), cvt_pk_bf16(v[8 * j], v[8 * j + 1]), cvt_pk_bf16(v[8 * j + 2], v[8 * j + 3]), cvt_pk_bf16(v[8 * j + 4], v[8 * j + 5]), cvt_pk_bf16(v[8 * j + 6], v[8 * j + 7]));
}
DI float row_sumsq(const float (&v)[16]) { float s = 0.f;
#pragma unroll
    for (int i = 0; i < 16; ++i) s += v[i] * v[i];
    return wave_sum(s); }
DI void norm_mod(const float (&x)[16], float rstd, const float* nw, const float* sh, const float* sc, int lane, float (&u)[16]) {
    float g[16], a[16], b[16]; ld_row_f32(nw, lane, g); ld_row_f32(sh, lane, a); ld_row_f32(sc, lane, b);
#pragma unroll
    for (int i = 0; i < 16; ++i) u[i] = x[i] * rstd * g[i] * (1.f + b[i]) + a[i];
}
DI void u_rows_layer0(Frame& F, bf16* U, const float* xin, const float* ctxin, const float* norms) {
    const int gw = F.vcu * 8 + F.wave, NGW = F.G * 8;
    const float* MOD = (const float*)(F.ws + WS_MOD);
    float av[16], bv[16]; int bcur = -1;
    float xn[16];
    if (gw < NTOK + NCTX) ld_row_f32(gw < NTOK ? xin + (size_t)gw * D : ctxin + (size_t)(gw - NTOK) * D, F.lane, xn);
    for (int m = gw; m < NTOK + NCTX; m += NGW) {
        const bool lat = m < NTOK; const int b = lat ? m / T : 8;
        float x[16], u[16];
#pragma unroll
        for (int i = 0; i < 16; ++i) x[i] = xn[i];
        const int mn = m + NGW;
        if (mn < NTOK + NCTX) ld_row_f32(mn < NTOK ? xin + (size_t)mn * D : ctxin + (size_t)(mn - NTOK) * D, F.lane, xn);
        if (b != bcur) {
            bcur = b; const float* mb = MOD + (size_t)b * 6144; float t1[16], t2[16];
            ld_row_f32(norms, F.lane, t1); ld_row_f32(mb + 1024, F.lane, t2); ld_row_f32(mb, F.lane, bv);
#pragma unroll
            for (int i = 0; i < 16; ++i) av[i] = t1[i] * (1.f + t2[i]);
        }
        const float rstd = rsqrtf(row_sumsq(x) * (1.f / D) + NORM_EPS);
#pragma unroll
        for (int i = 0; i < 16; ++i) u[i] = x[i] * rstd * av[i] + bv[i];
        st_row_bf16(U + (size_t)m * D, F.lane, u);
    }
}

#define MFMA32(a, b, c) __builtin_amdgcn_mfma_f32_32x32x16_bf16((a), (b), (c), 0, 0, 0)
DI int crow(int reg, int h5) { return (reg & 3) + 8 * (reg >> 2) + 4 * h5; }
DI float log2_gamma(const float* decay, int dir, int head) { const float x = decay[dir * NH + head]; return -log2f(1.f + expf(-x)); }

DI void retention_scores(Frame& F, const float* decay) {
    const bf16* Q = (const bf16*)(F.ws + WS_Q); const bf16* K = (const bf16*)(F.ws + WS_K); bf16* P = (bf16*)(F.ws + WS_P);
    const int lane = F.lane, r = lane & 31, h5 = lane >> 5;
    for (int unit = F.vcu; unit < NB * NH * NCHUNK; unit += F.G) {
        const int bh = unit >> 5, c = unit & 31, b = bh >> 2, head = bh & 3;
        const float lf = log2_gamma(decay, 0, head), lb = log2_gamma(decay, 1, head);
        bf16* Pt = P + (size_t)unit * CH * CH;
        {
            const bf16* kb = K + ((size_t)(b * NCHUNK + c) * NH + head) * 32768 + lane * 8;
            const bf16* qb = Q + ((size_t)(b * NCHUNK + c) * NH + head) * 32768 + lane * 8;
            __syncthreads();
#pragma unroll
            for (int i = 0; i < 8; ++i) { const int pc = F.wave + 8 * i;
                __builtin_amdgcn_global_load_lds((const unsigned*)(kb + (size_t)pc * 512), (LAS unsigned*)(F.lds + RING_OFF + pc * 1024), 16, 0, 0);
                __builtin_amdgcn_global_load_lds((const unsigned*)(qb + (size_t)pc * 512), (LAS unsigned*)(F.lds + RING_OFF + 65536 + pc * 1024), 16, 0, 0); }
            VM_WAIT(); __syncthreads();
        }
#pragma unroll
        for (int tt = 0; tt < 2; ++tt) {
            const int tile = F.wave * 2 + tt, jt = tile >> 2, it = tile & 3;
            const LAS unsigned char* kp = F.lds + RING_OFF + (jt * 16) * 1024 + lane * 16;
            const LAS unsigned char* qp = F.lds + RING_OFF + 65536 + (it * 16) * 1024 + lane * 16;
            f32x16 acc;
#pragma unroll
            for (int i = 0; i < 16; ++i) acc[i] = 0.f;
#pragma unroll
            for (int s = 0; s < 16; ++s) { const bf16x8 a = *(const LAS bf16x8*)(kp + 1024 * s), bq = *(const LAS bf16x8*)(qp + 1024 * s); acc = MFMA32(a, bq, acc); }
            const int i = 32 * it + r;
#pragma unroll
            for (int g = 0; g < 4; ++g) {
                float o[4];
#pragma unroll
                for (int e = 0; e < 4; ++e) { const int j = 32 * jt + 8 * g + 4 * h5 + e; const int dd = i - j;
                    const float w = dd > 0 ? exp2f(lf * (float)dd) : (dd < 0 ? exp2f(lb * (float)(-dd)) : 2.f);
                    o[e] = acc[4 * g + e] * w; }
                v2u pk; pk.x = cvt_pk_bf16(o[0], o[1]); pk.y = cvt_pk_bf16(o[2], o[3]);
                *(GAS v2u*)(Pt + ((size_t)(it * 8 + 2 * jt + (g >> 1)) * 64 + r + 32 * (g & 1)) * 8 + 4 * h5) = pk;
            }
        }
    }
}

DI void dma16_untracked(const void* g, const LAS unsigned char* l) {
    const unsigned la = __builtin_amdgcn_readfirstlane((unsigned)(__UINTPTR_TYPE__)l);
    asm volatile("s_mov_b32 m0, %1\n\ts_nop 0\n\tglobal_load_lds_dwordx4 %0, off" :: "v"(g), "s"(la) : "memory", "m0");
}
constexpr size_t WS_SCANDUMP = 130 * MiB;
constexpr int KSLAB = 0, VPITCH = 192, SPITCH = 528;
constexpr int VIMG = 65536, VSIMG = VIMG + 128 * VPITCH, SIMG = VSIMG + 128 * VPITCH, SCAN_LDS_END = SIMG + 64 * SPITCH;
static_assert(SCAN_LDS_END <= LDSCTL_OFF, "scan LDS");
typedef LAS s16x4 lds_s16x4;
DI const LAS unsigned char* tr_lane_base(const LAS unsigned char* img, int pitch, int lane) {
    const int h5 = lane >> 5, blk = (lane >> 4) & 1, q = (lane & 15) >> 2, p = lane & 3;
    return img + (8 * h5 + q) * pitch + (16 * blk + 4 * p) * 2;
}
DI bf16x8 tr_frag(const LAS unsigned char* lane_base, int off, int pitch) {
    const s16x4 lo = __builtin_amdgcn_ds_read_tr16_b64_v4i16((lds_s16x4*)(lane_base + off));
    const s16x4 hi = __builtin_amdgcn_ds_read_tr16_b64_v4i16((lds_s16x4*)(lane_base + off + 4 * pitch));
    return __builtin_shufflevector(lo, hi, 0, 1, 2, 3, 4, 5, 6, 7);
}
#define WG_BAR() do { asm volatile("s_waitcnt lgkmcnt(0)" ::: "memory"); __builtin_amdgcn_s_barrier(); asm volatile("" ::: "memory"); } while (0)
DI void retention_scan(Frame& F, bf16* Opart, bf16* O, const float* decay, const int variant = 0) {
    const bf16* Qg = (const bf16*)(F.ws + WS_Q); const bf16* Kg = (const bf16*)(F.ws + WS_K); const bf16* Vg = (const bf16*)(F.ws + WS_V);
    const bf16* KCg = (const bf16*)(F.ws + WS_KC); const bf16* VCg = (const bf16*)(F.ws + WS_VC); const bf16* Pg = (const bf16*)(F.ws + WS_P);
    const int lane = F.lane, w = F.wave, tid = F.tid;
    const int it = w >> 1, et = w & 1;
    const LAS unsigned char* trK = tr_lane_base(F.lds + KSLAB + w * 8192, 64, lane);
    const LAS unsigned char* trV = tr_lane_base(F.lds + VIMG, VPITCH, lane);
    const LAS unsigned char* trVS = tr_lane_base(F.lds + VSIMG, VPITCH, lane);
    for (int unit = F.vcu; unit < NB * NH * 8; unit += F.G) {
        const int bh = unit >> 3, eb = unit & 7, b = bh >> 2, head = bh & 3;
        const int vcol = head * DV + eb * 64;
#pragma unroll
        for (int pass = 0; pass < 2; ++pass) {
            const bool fwd = pass == 1;
            const float l2g = log2_gamma(decay, fwd ? 0 : 1, head);
            const float gC = exp2f(l2g * (float)CH);
            f32x16 accS[2];
#pragma unroll
            for (int i = 0; i < 16; ++i) { accS[0][i] = 0.f; accS[1][i] = 0.f; }
            v4u vreg[2];
#define SCAN_SRC(s, kp, vp) do { if ((s) < 2) { const int cc = fwd ? (s) : 1 - (s); kp = KCg + ((size_t)(b * 2 + cc) * NH + head) * 32768; vp = VCg + ((size_t)b * LCTX + cc * CH) * 2048 + vcol; } \
                else { const int cc = fwd ? (s) - 2 : 33 - (s); kp = Kg + ((size_t)(b * NCHUNK + cc) * NH + head) * 32768; vp = Vg + ((size_t)b * T + cc * CH) * 2048 + vcol; } } while (0)
#define SCAN_LOADV(s) do { const bf16* kp_; const bf16* vp_; SCAN_SRC(s, kp_, vp_); (void)kp_; \
                _Pragma("unroll") for (int i = 0; i < 2; ++i) vreg[i] = *(const GAS v4u*)(vp_ + (size_t)((tid >> 3) + 64 * i) * 2048 + (tid & 7) * 8); } while (0)
#define SCAN_DMAK(s) do { const bf16* kp_; const bf16* vp_; SCAN_SRC(s, kp_, vp_); (void)vp_; \
                _Pragma("unroll") for (int i = 0; i < 8; ++i) dma16_untracked(kp_ + (unsigned)((((i >> 1) * 16 + 2 * w + ((lane & 3) >> 1)) * 64 + ((16 * i + (lane >> 2)) & 31) + 32 * (lane & 1)) * 8), \
                    F.lds + KSLAB + w * 8192 + i * 1024); } while (0)
            bf16x8 qf[16], pf[8];
            { int lane_ = lane, tid_ = tid; asm volatile("" : "+v"(lane_), "+v"(tid_));
              const int lane = lane_, tid = tid_; (void)lane; (void)tid;
              SCAN_LOADV(0); asm volatile("" : "+v"(vreg[0]), "+v"(vreg[1]));
              SCAN_DMAK(0); }
#pragma unroll 1
            for (int s = 0; s < 34; ++s) {
                int lz = lane, tz = tid; asm volatile("" : "+v"(lz), "+v"(tz));
                const int r = lz & 31, h5 = lz >> 5;
                const unsigned ooff = (unsigned)(4 * h5) * 2048u + (unsigned)r;
#pragma unroll
                for (int i = 0; i < 2; ++i) {
                    const int row = (tz >> 3) + 64 * i;
                    const float dec = exp2f(l2g * (float)(fwd ? (CH - 1 - row) : row));
                    const v4u x = vreg[i]; v4u o;
                    o.x = cvt_pk_bf16(bf_lo(x.x) * dec, bf_hi(x.x) * dec); o.y = cvt_pk_bf16(bf_lo(x.y) * dec, bf_hi(x.y) * dec);
                    o.z = cvt_pk_bf16(bf_lo(x.z) * dec, bf_hi(x.z) * dec); o.w = cvt_pk_bf16(bf_lo(x.w) * dec, bf_hi(x.w) * dec);
                    *(LAS v4u*)(F.lds + VIMG + row * VPITCH + (tz & 7) * 16) = x;
                    *(LAS v4u*)(F.lds + VSIMG + row * VPITCH + (tz & 7) * 16) = o;
                }
#pragma unroll
                for (int e2 = 0; e2 < 2; ++e2)
#pragma unroll
                    for (int g = 0; g < 4; ++g) { v2u pk; pk.x = cvt_pk_bf16(accS[e2][4 * g], accS[e2][4 * g + 1]); pk.y = cvt_pk_bf16(accS[e2][4 * g + 2], accS[e2][4 * g + 3]);
                        *(LAS v2u*)(F.lds + SIMG + (32 * e2 + r) * SPITCH + (32 * w + 8 * g + 4 * h5) * 2) = pk; }
                WG_BAR();
                unsigned opk[8];
#pragma unroll
                for (int i = 0; i < 8; ++i) opk[i] = 0u;
                if (s >= 2 && !(variant & 1)) {
                    f32x16 accO;
#pragma unroll
                    for (int i = 0; i < 16; ++i) accO[i] = 0.f;
                    {
                        const LAS unsigned char* sp_ = F.lds + SIMG + (32 * et + r) * SPITCH + 16 * h5;
                        bf16x8 sb[2][4];
#pragma unroll
                        for (int j = 0; j < 4; ++j) sb[0][j] = *(const LAS bf16x8*)(sp_ + 32 * j);
#pragma unroll
                        for (int g = 0; g < 4; ++g) {
                            if (g < 3) {
#pragma unroll
                                for (int j = 0; j < 4; ++j) sb[(g + 1) & 1][j] = *(const LAS bf16x8*)(sp_ + 32 * (4 * (g + 1) + j)); }
                            __builtin_amdgcn_sched_barrier(0);
#pragma unroll
                            for (int j = 0; j < 4; ++j) accO = MFMA32(qf[4 * g + j], sb[g & 1][j], accO);
                            __builtin_amdgcn_sched_barrier(0);
                        }
                    }
                    {
                        float qd_lo[4], qd_hi[4];
#pragma unroll
                        for (int i = 0; i < 4; ++i) { qd_lo[i] = exp2f(l2g * (float)(fwd ? 32 * it + 4 * h5 + i + 1 : CH - 32 * it - 4 * h5 - i)); qd_hi[i] = exp2f(l2g * (float)(fwd ? 8 * i : -8 * i)); }
#pragma unroll
                        for (int i = 0; i < 16; ++i) accO[i] *= qd_lo[i & 3] * qd_hi[i >> 2];
                    }
                    if (fwd) {
                        bf16x8 vb[2][4];
#pragma unroll
                        for (int j = 0; j < 4; ++j) vb[0][j] = tr_frag(trV + 64 * et, 16 * j * VPITCH, VPITCH);
#pragma unroll
                        for (int g = 0; g < 2; ++g) {
                            if (g < 1) {
#pragma unroll
                                for (int j = 0; j < 4; ++j) vb[1][j] = tr_frag(trV + 64 * et, 16 * (4 + j) * VPITCH, VPITCH); }
                            __builtin_amdgcn_sched_barrier(0);
#pragma unroll
                            for (int j = 0; j < 4; ++j) accO = MFMA32(pf[4 * g + j], vb[g][j], accO);
                            __builtin_amdgcn_sched_barrier(0);
                        }
                    }
#pragma unroll
                    for (int i = 0; i < 8; ++i) opk[i] = cvt_pk_bf16(accO[2 * i], accO[2 * i + 1]);
                }
                {
                    const int sn = s + 1 < 34 ? s + 1 : 33;
                    const bf16* kp_; const bf16* vp_; SCAN_SRC(sn, kp_, vp_); (void)kp_;
#pragma unroll
                    for (int i = 0; i < 2; ++i) vreg[i] = *(const GAS v4u*)(vp_ + (unsigned)(((tz >> 3) + 64 * i) * 2048 + (tz & 7) * 8));
                    const int cq = sn >= 2 ? (fwd ? sn - 2 : 33 - sn) : (fwd ? 0 : 31);
                    const bf16* qn = Qg + ((((size_t)(b * NCHUNK + cq) * NH + head) * 4 + it) * 16) * 512;
                    const unsigned qoff = (unsigned)lz * 8u;
#pragma unroll
                    for (int ks = 0; ks < 16; ++ks) qf[ks] = *(const GAS bf16x8*)(qn + qoff + 512 * ks);
                    if (fwd) {
                        const bf16* pn = Pg + ((size_t)(bh * NCHUNK + cq) * CH * CH) + (size_t)(it * 8) * 512;
#pragma unroll
                        for (int ks = 0; ks < 8; ++ks) pf[ks] = *(const GAS bf16x8*)(pn + qoff + 512 * ks);
                    }
                }
                if (s == 0) { if (fwd) asm volatile("s_waitcnt vmcnt(26)" ::: "memory"); else asm volatile("s_waitcnt vmcnt(18)" ::: "memory"); }
                else { if (fwd) asm volatile("s_waitcnt vmcnt(42)" ::: "memory"); else asm volatile("s_waitcnt vmcnt(34)" ::: "memory"); }
#pragma unroll
                for (int i = 0; i < 16; ++i) { accS[0][i] *= gC; accS[1][i] *= gC; }
                if (!(variant & 2))
                {
                    bf16x8 ua[2], ub0[2], ub1[2];
                    ua[0] = tr_frag(trK, 0, 64); ub0[0] = tr_frag(trVS, 0, VPITCH); ub1[0] = tr_frag(trVS, 64, VPITCH);
#pragma unroll
                    for (int ks = 0; ks < 8; ++ks) {
                        if (ks < 7) { ua[(ks + 1) & 1] = tr_frag(trK, 16 * (ks + 1) * 64, 64); ub0[(ks + 1) & 1] = tr_frag(trVS, 16 * (ks + 1) * VPITCH, VPITCH); ub1[(ks + 1) & 1] = tr_frag(trVS, 16 * (ks + 1) * VPITCH + 64, VPITCH); }
                        __builtin_amdgcn_sched_barrier(0);
                        accS[0] = MFMA32(ua[ks & 1], ub0[ks & 1], accS[0]); accS[1] = MFMA32(ua[ks & 1], ub1[ks & 1], accS[1]);
                        __builtin_amdgcn_sched_barrier(0);
                    }
                }
                asm volatile("s_waitcnt lgkmcnt(0)" ::: "memory");
                {
                    const int sn = s + 1 < 34 ? s + 1 : 33;
                    const bf16* kp_; const bf16* vp_; SCAN_SRC(sn, kp_, vp_); (void)vp_;
#pragma unroll
                    for (int i = 0; i < 8; ++i) dma16_untracked(kp_ + (unsigned)((((i >> 1) * 16 + 2 * w + ((lz & 3) >> 1)) * 64 + ((16 * i + (lz >> 2)) & 31) + 32 * (lz & 1)) * 8), F.lds + KSLAB + w * 8192 + i * 1024); }
                {
                    const int cc = fwd ? s - 2 : 33 - s;
                    const size_t obase = ((size_t)b * T + cc * CH + 32 * it) * 2048 + vcol + 32 * et;
                    GAS unsigned short* dstp = s >= 2 ? (GAS unsigned short*)((fwd ? O : Opart) + obase) : (GAS unsigned short*)(F.ws + WS_SCANDUMP) + (size_t)(32 * it) * 2048 + 32 * et;
#pragma unroll
                    for (int i = 0; i < 16; ++i) dstp[ooff + (unsigned)(((i & 3) + 8 * (i >> 2)) * 2048)] = (unsigned short)((i & 1) ? (opk[i >> 1] >> 16) : (opk[i >> 1] & 0xffffu));
                }
                WG_BAR();
            }
#undef SCAN_SRC
#undef SCAN_LOADV
#undef SCAN_DMAK
            VM_WAIT(); __syncthreads();
        }
    }
}
DI void gn_gate_rows(Frame& F, bf16* O, const bf16* G, const bf16* OP) {
    const int gw = F.vcu * 8 + F.wave, NGW = F.G * 8;
    v4u an[4], gn[4], pn[4];
    if (gw < NTOK) {
#pragma unroll
        for (int j = 0; j < 4; ++j) { an[j] = *(const GAS v4u*)(O + (size_t)gw * VTOT + 512 * j + 8 * F.lane); pn[j] = *(const GAS v4u*)(OP + (size_t)gw * VTOT + 512 * j + 8 * F.lane); gn[j] = *(const GAS v4u*)(G + (size_t)gw * VTOT + 512 * j + 8 * F.lane); } }
    for (int m = gw; m < NTOK; m += NGW) {
        bf16* op = O + (size_t)m * VTOT;
        v4u ac[4], gc[4], pc[4];
#pragma unroll
        for (int j = 0; j < 4; ++j) { ac[j] = an[j]; gc[j] = gn[j]; pc[j] = pn[j]; }
        const int mn = m + NGW;
        if (mn < NTOK) {
#pragma unroll
            for (int j = 0; j < 4; ++j) { an[j] = *(const GAS v4u*)(O + (size_t)mn * VTOT + 512 * j + 8 * F.lane); pn[j] = *(const GAS v4u*)(OP + (size_t)mn * VTOT + 512 * j + 8 * F.lane); gn[j] = *(const GAS v4u*)(G + (size_t)mn * VTOT + 512 * j + 8 * F.lane); } }
#pragma unroll
        for (int j = 0; j < 4; ++j) {
            const v4u a = ac[j], g = gc[j], q = pc[j];
            float v[8] = {bf_lo(a.x) + bf_lo(q.x), bf_hi(a.x) + bf_hi(q.x), bf_lo(a.y) + bf_lo(q.y), bf_hi(a.y) + bf_hi(q.y), bf_lo(a.z) + bf_lo(q.z), bf_hi(a.z) + bf_hi(q.z), bf_lo(a.w) + bf_lo(q.w), bf_hi(a.w) + bf_hi(q.w)};
            const float gg[8] = {bf_lo(g.x), bf_hi(g.x), bf_lo(g.y), bf_hi(g.y), bf_lo(g.z), bf_hi(g.z), bf_lo(g.w), bf_hi(g.w)};
            float ss = 0.f;
#pragma unroll
            for (int e = 0; e < 8; ++e) ss += v[e] * v[e];
            const float rstd = rsqrtf(wave_sum(ss) * (1.f / DV) + NORM_EPS);
#pragma unroll
            for (int e = 0; e < 8; ++e) v[e] = v[e] * rstd * gg[e];
            st16(op + 512 * j + 8 * F.lane, cvt_pk_bf16(v[0], v[1]), cvt_pk_bf16(v[2], v[3]), cvt_pk_bf16(v[4], v[5]), cvt_pk_bf16(v[6], v[7]));
        }
    }
}
constexpr size_t WS_WPRIME = 156 * MiB, WS_CPART = WS_MOD + 1 * MiB;
DI void router_prescale(Frame& F, const float* norms, const float* router) {
    const float* MOD = (const float*)(F.ws + WS_MOD);
    bf16* WP = (bf16*)(F.ws + WS_WPRIME); float* CP = (float*)(F.ws + WS_CPART);
    const int gt = F.vcu * 512 + F.tid, NT = F.G * 512;
    for (int i = gt; i < 2 * NB * D * NE; i += NT) {
        const int e = i & 63, k = (i >> 6) & 1023, b = (i >> 16) & 7, l = i >> 19;
        const float v = norms[(l * 4 + 2) * D + k] * (1.f + MOD[(size_t)(l * 9 + b) * 6144 + 4 * D + k]) * router[((size_t)l * D + k) * NE + e];
        const bf16 hi = f2bf(v), lo = f2bf(v - bf2f(hi));
        const size_t o = (size_t)(l * NB + b) * 131072 + ((size_t)((e >> 5) * 64 + (k >> 4)) * 64 + (e & 31) + 32 * ((k >> 3) & 1)) * 8 + (k & 7);
        WP[o] = hi; WP[o + 65536] = lo;
    }
    const int gw = F.vcu * 8 + F.wave, NGW = F.G * 8;
    for (int t = gw; t < 2 * NB * 16; t += NGW) {
        const int ch = t & 15, b = (t >> 4) & 7, l = t >> 7;
        float a = 0.f;
#pragma unroll 8
        for (int kk = 0; kk < 64; ++kk) { const int k = ch * 64 + kk; a += MOD[(size_t)(l * 9 + b) * 6144 + 3 * D + k] * router[((size_t)l * D + k) * NE + F.lane]; }
        CP[(size_t)t * 64 + F.lane] = a;
    }
}
DI void rows_router(Frame& F, int layer, const float* hin, const bf16* Y, bf16* U, const float* norms, const float* mbias, float* hout, const int variant = 0, const int cl = 0) {
    const float* MOD = (const float*)(F.ws + WS_MOD) + (size_t)layer * 9 * 6144;
    const float* nrm = norms + (size_t)layer * 4 * D;
    constexpr int UP = 2064;
    LAS unsigned char* uhi = F.lds + RING_OFF; LAS unsigned char* ulo = uhi + 32 * UP;
    LAS float* plg = (LAS float*)uhi;
    LAS float* rstdl = (LAS float*)(ulo + 32 * UP);
    LAS int* bcnt = (LAS int*)(rstdl + 32); LAS int* bbase = bcnt + 64;
    LAS int* park = bbase + 64;
    const int lane = F.lane, w = F.wave;
    const float mybias = mbias[layer * NE + lane];
    unsigned char* lb = F.ws + WS_LIST;
    if (F.tid < 64) bcnt[F.tid] = 0;
    int nblk = 0;
    float yA[16], hA[16], yB[16], hB[16];
    if (F.vcu < NTOK / 32 && !(variant & 1)) { const int mf = F.vcu * 32 + w * 4;
        ld_row_bf16(Y + (size_t)mf * D, lane, yA); ld_row_f32(hin + (size_t)mf * D, lane, hA); ld_row_bf16(Y + (size_t)(mf + 1) * D, lane, yB); ld_row_f32(hin + (size_t)(mf + 1) * D, lane, hB); }
    for (int blk = F.vcu; blk < NTOK / 32; blk += F.G, ++nblk) {
        const int m0 = blk * 32, b = m0 / T;
        const float* mb = MOD + (size_t)b * 6144;
        float csum = 0.f;
        { const float* cp = (const float*)(F.ws + WS_CPART) + (size_t)((layer * NB + b) * 16) * 64 + lane;
#pragma unroll
          for (int ch = 0; ch < 16; ++ch) csum += cp[ch * 64]; }
        if (!(variant & 1)) {
            float gg[16], av[16], bv[16];
            { float t1[16], t2[16]; ld_row_f32(nrm + D, lane, t1); ld_row_f32(mb + 2 * D, lane, t2);
#pragma unroll
              for (int i = 0; i < 16; ++i) gg[i] = t1[i] * t2[i];
              ld_row_f32(nrm + 2 * D, lane, t1); ld_row_f32(mb + 4 * D, lane, t2); ld_row_f32(mb + 3 * D, lane, bv);
#pragma unroll
              for (int i = 0; i < 16; ++i) av[i] = t1[i] * (1.f + t2[i]); }
            const int mnext = (blk + F.G) * 32;
            const bool hasnext = blk + F.G < NTOK / 32;
#pragma unroll
            for (int rr = 0; rr < 4; ++rr) {
                const int rl = w * 4 + rr, m = m0 + rl;
                float y[16], h[16], u[16];
#pragma unroll
                for (int i = 0; i < 16; ++i) { y[i] = (rr & 1) ? yB[i] : yA[i]; h[i] = (rr & 1) ? hB[i] : hA[i]; }
                {
                    const int mr = rr < 2 ? m + 2 : mnext + w * 4 + (rr - 2);
                    if (rr < 2 || hasnext) {
                        if (rr & 1) { ld_row_bf16(Y + (size_t)mr * D, lane, yB); ld_row_f32(hin + (size_t)mr * D, lane, hB); }
                        else        { ld_row_bf16(Y + (size_t)mr * D, lane, yA); ld_row_f32(hin + (size_t)mr * D, lane, hA); }
                    }
                }
                const float rs1 = rsqrtf(row_sumsq(y) * (1.f / D) + NORM_EPS);
#pragma unroll
                for (int i = 0; i < 16; ++i) h[i] += gg[i] * (y[i] * rs1);
                st_row_f32(hout + (size_t)m * D, lane, h);
                const float rs2 = rsqrtf(row_sumsq(h) * (1.f / D) + NORM_EPS);
#pragma unroll
                for (int i = 0; i < 16; ++i) u[i] = h[i] * rs2 * av[i] + bv[i];
                st_row_bf16(U + (size_t)m * D, lane, u);
#pragma unroll
                for (int j = 0; j < 2; ++j) {
                    unsigned hh[4], ll[4];
#pragma unroll
                    for (int e = 0; e < 4; ++e) { const float x0 = h[8 * j + 2 * e], x1 = h[8 * j + 2 * e + 1]; const unsigned ph = cvt_pk_bf16(x0, x1); hh[e] = ph; ll[e] = cvt_pk_bf16(x0 - bf_lo(ph), x1 - bf_hi(ph)); }
                    *(LAS v4u*)(uhi + rl * UP + (512 * j + 8 * lane) * 2) = (v4u){hh[0], hh[1], hh[2], hh[3]};
                    *(LAS v4u*)(ulo + rl * UP + (512 * j + 8 * lane) * 2) = (v4u){ll[0], ll[1], ll[2], ll[3]};
                }
                if (lane == 0) rstdl[rl] = rs2;
            }
        }
        __syncthreads();
        if (!(variant & 2)) {
            const int kq = w >> 1, et = w & 1, r = lane & 31, h5 = lane >> 5;
            const bf16* wph = (const bf16*)(F.ws + WS_WPRIME) + (size_t)(layer * NB + b) * 131072 + ((size_t)(et * 64 + 16 * kq) * 64 + lane) * 8;
            f32x16 acc;
#pragma unroll
            for (int i = 0; i < 16; ++i) acc[i] = 0.f;
            bf16x8 bh[16], bl[16];
#pragma unroll
            for (int ks = 0; ks < 16; ++ks) { bh[ks] = *(const GAS bf16x8*)(wph + 512 * ks); bl[ks] = *(const GAS bf16x8*)(wph + 65536 + 512 * ks); }
            __builtin_amdgcn_sched_barrier(0);
#pragma unroll
            for (int ks = 0; ks < 16; ++ks) {
                const bf16x8 ah = *(const LAS bf16x8*)(uhi + r * UP + (256 * kq + 16 * ks + 8 * h5) * 2), al = *(const LAS bf16x8*)(ulo + r * UP + (256 * kq + 16 * ks + 8 * h5) * 2);
                acc = MFMA32(ah, bh[ks], acc); acc = MFMA32(ah, bl[ks], acc); acc = MFMA32(al, bh[ks], acc);
            }
            __syncthreads();
#pragma unroll
            for (int i = 0; i < 16; ++i) plg[(kq * 32 + crow(i, h5)) * 65 + 32 * et + r] = acc[i];
        }
        __syncthreads();
        int lc = lane; asm volatile("" : "+v"(lc));
        float wgt[4]; int ksl[4], ipos[4];
#pragma unroll
        for (int rr = 0; rr < 4; ++rr) { ksl[rr] = -1; wgt[rr] = 0.f; ipos[rr] = 0; }
        if (!(variant & 4))
#pragma unroll
        for (int rr = 0; rr < 4; ++rr) {
            const int rl = w * 4 + rr;
            const float lg = rstdl[rl] * (plg[rl * 65 + lc] + plg[(32 + rl) * 65 + lc] + plg[(64 + rl) * 65 + lc] + plg[(96 + rl) * 65 + lc]) + csum;
            const float sc = sigmoidf_(lg), bs = sc + mybias;
            const float NINF = -__builtin_inff();
            const float m1 = grp8_max(bs);
            const bool ism = bs == m1;
            const float nm = grp8_sum(ism ? 1.f : 0.f);
            const float rest = grp8_max(ism ? NINF : bs);
            const float gs = m1 + (nm >= 2.f ? m1 : rest);
            int grk = 0; const int grp = lc >> 3;
#pragma unroll
            for (int g = 0; g < 8; ++g) { const float o = __builtin_bit_cast(float, __builtin_amdgcn_readlane(__builtin_bit_cast(int, gs), 8 * g)); grk += (o > gs || (o == gs && g < grp)) ? 1 : 0; }
            const bool gsel = grk < 4;
            float cur = gsel ? bs : NINF;
            bool sel = false;
#pragma unroll
            for (int t8 = 0; t8 < TOPK; ++t8) {
                const float mx = wave_max(cur);
                const unsigned long long eq = __builtin_amdgcn_ballot_w64(cur == mx);
                const int first = __builtin_ctzll(eq);
                const bool isf = lc == first;
                sel = sel || isf; cur = isf ? NINF : cur;
            }
            const float ssum = wave_sum(sel ? sc : 0.f);
            const unsigned long long bal = __ballot(sel);
            ksl[rr] = sel ? __popcll(bal & ((1ull << lc) - 1ull)) : -1;
            wgt[rr] = sc / ssum * 2.5f;
            ipos[rr] = sel ? __hip_atomic_fetch_add(bcnt + lc, 1, __ATOMIC_RELAXED, __HIP_MEMORY_SCOPE_WORKGROUP) : 0;
        }
#pragma unroll
        for (int rr = 0; rr < 4; ++rr) if (ksl[rr] >= 0) { const int pi = ((nblk * 32 + w * 4 + rr) * 8 + ksl[rr]) * 2; park[pi] = lc | (ipos[rr] << 8); park[pi + 1] = __builtin_bit_cast(int, wgt[rr]); }
        __syncthreads();
    }
    if (w == 0) { const int n = bcnt[lane]; bbase[lane] = n ? (int)atomicAdd(F.ctl + cnt_word(layer + cl, 0, lane), (unsigned)n) : 0; }
    __syncthreads();
    for (int k = 0; k < nblk; ++k) {
        const int m0 = (F.vcu + k * F.G) * 32;
#pragma unroll 1
        for (int rr = 0; rr < 4; ++rr) {
            const int m = m0 + w * 4 + rr;
            if (lane < 8) {
                const int pi = ((k * 32 + w * 4 + rr) * 8 + lane) * 2; const int pe = park[pi]; const float wv = __builtin_bit_cast(float, park[pi + 1]);
                const int e = pe & 0xff, pos = bbase[e] + (pe >> 8);
                ((int*)lb)[(size_t)e * ECAP + pos] = m;
                ((int*)(lb + LIST_ARR))[m * 8 + lane] = (e << 16) | pos; ((float*)(lb + 2 * LIST_ARR))[m * 8 + lane] = wv;
            }
            if (lane == 0) ((int*)lb)[(size_t)NE * ECAP + m] = m;
        }
    }
    __syncthreads();
}

DI void moe_tables(Frame& F, int layer, int slice) {
    LAS int* cum = (LAS int*)(F.lds + LDSCTL_OFF); LAS int* cnt = (LAS int*)(F.lds + LDSCTL_OFF + 272); LAS int* rb = (LAS int*)(F.lds + LDSCTL_OFF + 544);
    __syncthreads();
    if (F.wave == 0) {
        const int lane = F.lane;
        const int n = (int)__hip_atomic_load(F.ctl + cnt_word(layer, slice, lane), RLX_AGENT);
        int pb = (n + 255) >> 8, pr = n;
#pragma unroll
        for (int d = 1; d < 64; d <<= 1) {
            const int ob = __builtin_amdgcn_ds_bpermute((lane - d) << 2, pb), orr = __builtin_amdgcn_ds_bpermute((lane - d) << 2, pr);
            if (lane >= d) { pb += ob; pr += orr; }
        }
        cnt[lane] = n; cum[lane] = pb - ((n + 255) >> 8); rb[lane] = pr - n;
        if (lane == 63) { cnt[NE] = SLTOK; cum[NE] = pb; rb[NE] = pr; cum[NEX] = pb + ((SLTOK + 255) >> 8); rb[NEX] = pr + SLTOK; }
    }
    __syncthreads();
    {
        LAS unsigned char* eob = (LAS unsigned char*)(F.lds + LDSCTL_OFF + 1536); const int nb = cum[NEX];
        for (int blk = F.tid; blk < nb; blk += 512) { int e = 0, hi_ = NEX;
#pragma unroll
            for (int it = 0; it < 7; ++it) { const int mid = (e + hi_) >> 1; if (cum[mid] <= blk) e = mid; else hi_ = mid; }
            eob[blk] = (unsigned char)e; }
    }
    __syncthreads();
}
DI void moe_gemm1(Frame& F, int layer, int slice) {
    moe_tables(F, layer, slice);
    const LAS int* cum = (const LAS int*)(F.lds + LDSCTL_OFF); const LAS int* cnt = (const LAS int*)(F.lds + LDSCTL_OFF + 272); const LAS int* rb = (const LAS int*)(F.lds + LDSCTL_OFF + 544);
    unsigned char* lb = F.ws + WS_LIST + (size_t)slice * LIST_SLICE;
    pg8::Gemm g{(const bf16*)(F.ws + WS_U), (const bf16*)(F.ws + WS_W13), 1024};
    MoeOrder S{cum, cnt, rb, (const LAS unsigned char*)(F.lds + LDSCTL_OFF + 1536), (const int*)lb, 2, F.G, F.vcu, cum[NEX] * 2};
    EpiSwiGLU E{(bf16*)(F.ws + WS_ACT)};
    pg8::gemm_phase<EpiSwiGLU, MoeOrder, true>(F.lds + RING_OFF, g, S, E, F.tid, STAG_G1);
}
DI void moe_gemm2(Frame& F, int layer, int slice, int nostore = 0) {
    moe_tables(F, layer, slice);
    const LAS int* cum = (const LAS int*)(F.lds + LDSCTL_OFF); const LAS int* cnt = (const LAS int*)(F.lds + LDSCTL_OFF + 272); const LAS int* rb = (const LAS int*)(F.lds + LDSCTL_OFF + 544);
    pg8::Gemm g{(const bf16*)(F.ws + WS_ACT), (const bf16*)(F.ws + WS_W2), 256};
    MoeOrder S{cum, cnt, rb, (const LAS unsigned char*)(F.lds + LDSCTL_OFF + 1536), nullptr, 4, F.G, F.vcu, cum[NEX] * 4};
    EpiMoeOut E{F.ws + WS_Y2, nostore};
    pg8::gemm_phase<EpiMoeOut, MoeOrder, false>(F.lds + RING_OFF, g, S, E, F.tid, STAG_G2);
}
DI void moe_combine(Frame& F, int layer, int slice, bool last_layer, const float* norms) {
    moe_tables(F, layer, slice);
    const LAS int* rb = (const LAS int*)(F.lds + LDSCTL_OFF + 544);
    const int gw = F.vcu * 8 + F.wave, NGW = F.G * 8, lane = F.lane;
    const float* MOD = (const float*)(F.ws + WS_MOD);
    const unsigned char* Y2 = F.ws + WS_Y2; bf16* U = (bf16*)(F.ws + WS_UC);
    const unsigned char* lb = F.ws + WS_LIST + (size_t)slice * LIST_SLICE;
    const int* slot = (const int*)(lb + LIST_ARR); const float* wts = (const float*)(lb + 2 * LIST_ARR);
    float g3[16]; ld_rowx_f32(norms + (size_t)(layer * 4 + 3) * D, lane, g3);
    for (int ml0 = gw; ml0 < SLTOK; ml0 += 2 * NGW) {
        int lz = F.lane; asm volatile("" : "+v"(lz));
        int mm[2]; v4u rw[2][9]; float wk[2][8];
#pragma unroll
        for (int t = 0; t < 2; ++t) {
            const int ml = ml0 + t * NGW; mm[t] = ml < SLTOK ? ml : ml0;
            const int sv = slot[mm[t] * 8 + (lz & 7)]; const float wv = wts[mm[t] * 8 + (lz & 7)];
            const int myrow = rb[sv >> 16] + (sv & 0xffff);
#pragma unroll
            for (int k = 0; k < 8; ++k) { const int row = __builtin_amdgcn_readlane(myrow, k); wk[t][k] = __builtin_bit_cast(float, __builtin_amdgcn_readlane(__builtin_bit_cast(int, wv), k));
                rw[t][k] = *(const GAS v4u*)(Y2 + (size_t)row * D + (unsigned)(16 * lz)); }
            rw[t][8] = *(const GAS v4u*)(Y2 + ((size_t)SLTOK * 8 + mm[t]) * D + 16 * lz);
        }
        float o[2][16];
#pragma unroll
        for (int t = 0; t < 2; ++t) {
#pragma unroll
            for (int i = 0; i < 16; ++i) o[t][i] = 0.f;
#pragma unroll
            for (int k = 0; k < 9; ++k) { const float w = k < 8 ? wk[t][k < 8 ? k : 0] : 1.f;
#pragma unroll
                for (int j = 0; j < 2; ++j) { v2u a; a.x = j ? rw[t][k].z : rw[t][k].x; a.y = j ? rw[t][k].w : rw[t][k].y;
                    const f32x2 d0 = __builtin_amdgcn_cvt_pk_f32_fp8((int)a.x, false), d1 = __builtin_amdgcn_cvt_pk_f32_fp8((int)a.x, true), d2 = __builtin_amdgcn_cvt_pk_f32_fp8((int)a.y, false), d3 = __builtin_amdgcn_cvt_pk_f32_fp8((int)a.y, true);
                    o[t][8 * j + 0] += w * d0[0]; o[t][8 * j + 1] += w * d0[1]; o[t][8 * j + 2] += w * d1[0]; o[t][8 * j + 3] += w * d1[1]; o[t][8 * j + 4] += w * d2[0]; o[t][8 * j + 5] += w * d2[1]; o[t][8 * j + 6] += w * d3[0]; o[t][8 * j + 7] += w * d3[1]; } }
        }
        float h[2][16], gf[2][16];
#pragma unroll
        for (int t = 0; t < 2; ++t) { const int m = slice * SLTOK + mm[t]; ld_rowx_f32(F.out + (size_t)m * D, lz, h[t]); ld_rowx_f32(MOD + ((size_t)(layer * 9 + m / T)) * 6144 + 5 * D, lz, gf[t]); }
#pragma unroll
        for (int t = 0; t < 2; ++t) {
            if (ml0 + t * NGW >= SLTOK) break;
            const int m = slice * SLTOK + mm[t], b = m / T;
            const float rs = rsqrtf(row_sumsq(o[t]) * (1.f / D) + NORM_EPS);
#pragma unroll
            for (int i = 0; i < 16; ++i) h[t][i] += gf[t][i] * (o[t][i] * rs * g3[i]);
            st_rowx_f32(F.out + (size_t)m * D, lz, h[t]);
            if (!last_layer) {
                const float rs2 = rsqrtf(row_sumsq(h[t]) * (1.f / D) + NORM_EPS);
                const float* mb = MOD + ((size_t)((layer + 1) * 9 + b)) * 6144;
                float u[16], ng[16], na[16], nb[16]; ld_rowx_f32(norms + (size_t)((layer + 1) * 4) * D, lz, ng); ld_rowx_f32(mb, lz, na); ld_rowx_f32(mb + D, lz, nb);
#pragma unroll
                for (int i = 0; i < 16; ++i) u[i] = h[t][i] * rs2 * ng[i] * (1.f + nb[i]) + na[i];
                st_rowx_bf16(U + (size_t)m * D, lz, u);
            }
        }
    }
}

DI void dwconv_ln(Frame& F, const bf16* Z, bf16* C, const float* dw, const float* bdwp, const float* lngp, const float* lnbp) {
    LAS float* red = (LAS float*)(F.lds + RING_OFF);
    LAS float* tot = red + 32 * 528;
    const int tid = F.tid, c0 = 2 * tid;
    const f32x2 bdw = *(const GAS f32x2*)(bdwp + c0), lg = *(const GAS f32x2*)(lngp + c0), lb = *(const GAS f32x2*)(lnbp + c0);
    f32x2 kk[31];
#pragma unroll
    for (int w = 0; w < 31; ++w) kk[w] = *(const GAS f32x2*)(dw + w * D + c0);
    for (int run = F.vcu; run < NTOK / 128; run += F.G) {
        const int mrun = run * 128, trun = mrun & (T - 1);
        f32x2 zz[46]; unsigned zn[16];
        { unsigned z[46];
#pragma unroll
          for (int i = 0; i < 46; ++i) { const int t = trun - 15 + i; z[i] = (t >= 0 && t < T) ? *(const GAS unsigned*)(Z + (size_t)(mrun - 15 + i) * D + c0) : 0u; }
#pragma unroll
          for (int i = 0; i < 46; ++i) zz[i] = (f32x2){bf_lo(z[i]), bf_hi(z[i])}; }
#pragma unroll 1
        for (int j = 0; j < 8; ++j) {
            const int m0 = mrun + 16 * j, t0 = trun + 16 * j;
            if (j + 1 < 8) {
#pragma unroll
                for (int i = 0; i < 16; ++i) { const int t = t0 + 31 + i; zn[i] = (t < T) ? *(const GAS unsigned*)(Z + (size_t)(m0 + 31 + i) * D + c0) : 0u; }
            }
            f32x2 acc2[16];
#pragma unroll
            for (int i = 0; i < 16; ++i) acc2[i] = bdw;
#pragma unroll
            for (int w = 0; w < 31; ++w)
#pragma unroll
                for (int i = 0; i < 16; ++i) acc2[i] = __builtin_elementwise_fma(zz[i + w], kk[w], acc2[i]);
            __syncthreads();
#pragma unroll
            for (int i = 0; i < 16; ++i) { red[i * 528 + tid] = acc2[i][0] + acc2[i][1]; red[(16 + i) * 528 + tid] = acc2[i][0] * acc2[i][0] + acc2[i][1] * acc2[i][1]; }
            __syncthreads();
            { const int tk = tid >> 5, which = (tid >> 4) & 1, pp = tid & 15; float acc_ = 0.f;
              const LAS float* rp = red + (which * 16 + tk) * 528 + pp;
#pragma unroll
              for (int k = 0; k < 32; ++k) acc_ += rp[16 * k];
              acc_ += lane_xor(acc_, tid & 63, 1); acc_ += lane_xor(acc_, tid & 63, 2); acc_ += lane_xor(acc_, tid & 63, 4); acc_ += lane_xor(acc_, tid & 63, 8);
              const float oth = lane_xor(acc_, tid & 63, 16);
              if ((tid & 31) == 0) { const float mu = acc_ * (1.f / D), var = oth * (1.f / D) - mu * mu; tot[2 * tk] = mu; tot[2 * tk + 1] = rsqrtf(fmaxf(var, 0.f) + LN_EPS); } }
            __syncthreads();
#pragma unroll
            for (int i = 0; i < 16; ++i) {
                const float mu = tot[2 * i], rstd = tot[2 * i + 1];
                const float v0 = (acc2[i][0] - mu) * rstd * lg[0] + lb[0], v1 = (acc2[i][1] - mu) * rstd * lg[1] + lb[1];
                *(GAS unsigned*)(C + (size_t)(m0 + i) * D + c0) = cvt_pk_bf16(siluf_(v0), siluf_(v1));
            }
#pragma unroll
            for (int i = 0; i < 30; ++i) zz[i] = zz[i + 16];
#pragma unroll
            for (int i = 0; i < 16; ++i) zz[30 + i] = (f32x2){bf_lo(zn[i]), bf_hi(zn[i])};
        }
    }
}

constexpr int N_PHASES = 18;
struct Args { const float* in[26]; float* out; unsigned char* ws; int ph_lo, ph_hi; };
#define INP(i) ([&]() -> const float* { int j_ = (i); asm volatile("" : "+s"(j_)); return args.in[j_]; }())
__global__ void __launch_bounds__(512, 2) fwd_kernel(Args args) {
    extern __shared__ __attribute__((aligned(16))) unsigned char lds[];
    Frame F;
    F.lds = (LAS unsigned char*)lds;
    F.MISC = (volatile LAS unsigned*)(F.lds + MISC_OFF);
    F.tid = threadIdx.x; F.lane = F.tid & 63; F.wave = __builtin_amdgcn_readfirstlane(F.tid >> 6);
    F.G = gridDim.x; { const int bx = blockIdx.x; F.vcu = (F.G % 8 == 0) ? (bx % 8) * (F.G / 8) + bx / 8 : bx; }
    F.ws = args.ws; F.ctl = (unsigned*)(args.ws + WS_CTL); F.out = args.out;
    for (int u = F.tid; u < (LDS_BYTES - LDSCTL_OFF) / 4; u += 512) ((LAS unsigned*)(F.lds + LDSCTL_OFF))[u] = 0u;
    __syncthreads();
    const int wave_s = __builtin_amdgcn_readfirstlane(threadIdx.x >> 6);
    const int lo = args.ph_lo, hi = args.ph_hi;
    XcdBarrier bar; bar.bar = F.ctl + CW_BAR; bar.x = 0; bar.st = nullptr;
    if (hi - lo > 1) bar = xcd_barrier_post(F.ctl + CW_BAR, F.MISC + 8);
    int ph = 0;
#ifdef PROBE_A
    volatile LAS unsigned long long* stampv = (volatile LAS unsigned long long*)(F.lds + LDSCTL_OFF + 1280);
    if (blockIdx.x == 0 && F.tid == 0) stampv[0] = __builtin_amdgcn_s_memrealtime();
#define STAMP() do { if (blockIdx.x == 0 && F.tid == 0) stampv[ph + 1] = __builtin_amdgcn_s_memrealtime(); } while (0)
#else
#define STAMP() do { } while (0)
#endif
#define FRESH() do { int lz_; asm volatile("v_mbcnt_lo_u32_b32 %0, -1, 0\n\tv_mbcnt_hi_u32_b32 %0, -1, %0" : "=&v"(lz_)); F.lane = lz_; F.wave = wave_s; F.tid = wave_s * 64 + lz_;     \
        unsigned char* w_ = args.ws; float* o_ = args.out; asm volatile("" : "+s"(w_), "+s"(o_)); F.ws = w_; F.ctl = (unsigned*)(w_ + WS_CTL); F.out = o_; ws = w_; U0 = (bf16*)o_; OPART = (bf16*)o_; Ob = (bf16*)(w_ + WS_V); } while (0)
#define PH_BEGIN if (lo <= ph && ph < hi) { FRESH();
#define PH_END } if (lo <= ph && ph + 1 < hi) xcd_barrier(bar, F.tid == 0); STAMP(); ++ph;
    unsigned char* ws; bf16 *U0, *OPART, *Ob;

    PH_BEGIN mod_vectors(F, INP(I_C), INP(I_CCTX), INP(I_MODW), INP(I_MODB)); rope_tables(F); conv_small_weights(F, INP(I_RWIN), INP(I_RWOUT), INP(I_CW1), INP(I_CW2));
             conv_moe_weights(F, 0, INP(I_MW1), INP(I_MW3), INP(I_MW2), INP(I_SW1), INP(I_SW3), INP(I_SW2)); PH_END
    PH_BEGIN u_rows_layer0(F, U0, INP(I_X), INP(I_CTX), INP(I_NORMS)); router_prescale(F, INP(I_NORMS), INP(I_ROUTER)); PH_END
    PH_BEGIN
        pg8::Gemm g{U0, (const bf16*)(ws + WS_WIN), 1024}; InprojOrder S; S.init(F.G, (int)blockIdx.x);
        EpiQKVG E{ws};
        pg8::gemm_phase<EpiQKVG, InprojOrder, false>(F.lds + RING_OFF, g, S, E, F.tid, STAG_IN);
    PH_END
    PH_BEGIN retention_scores(F, INP(I_RDECAY)); PH_END
    PH_BEGIN retention_scan(F, OPART, Ob, INP(I_RDECAY)); PH_END
    PH_BEGIN gn_gate_rows(F, Ob, (const bf16*)(ws + WS_G), OPART); PH_END
    PH_BEGIN
        pg8::Gemm g{Ob, (const bf16*)(ws + WS_WOUT), 2048}; pg8::StaticOrder S; S.init(NTOK, D, F.G, (int)blockIdx.x);
        EpiBf16 E{(bf16*)(ws + WS_Y), D, nullptr};
        pg8::gemm_phase<EpiBf16, pg8::StaticOrder, false>(F.lds + RING_OFF, g, S, E, F.tid, STAG_PL);
    PH_END
#pragma unroll 1
    for (int layer = 0; layer < 2; ++layer) {
        if (layer == 1) {
            PH_BEGIN
                pg8::Gemm g{(const bf16*)(ws + WS_UC), (const bf16*)(ws + WS_CW1), 1024}; pg8::StaticOrder S; S.init(NTOK, 2048, F.G, (int)blockIdx.x);
                EpiGLU E{(bf16*)(ws + WS_Z), INP(I_CB1)};
                pg8::gemm_phase<EpiGLU, pg8::StaticOrder, false>(F.lds + RING_OFF, g, S, E, F.tid, STAG_PL);
            PH_END
            PH_BEGIN dwconv_ln(F, (const bf16*)(ws + WS_Z), (bf16*)(ws + WS_C), INP(I_CDW), INP(I_CBDW), INP(I_CLNG), INP(I_CLNB)); PH_END
            PH_BEGIN
                pg8::Gemm g{(const bf16*)(ws + WS_C), (const bf16*)(ws + WS_CW2), 1024}; pg8::StaticOrder S; S.init(NTOK, D, F.G, (int)blockIdx.x);
                EpiBf16 E{(bf16*)(ws + WS_Y1), D, INP(I_CB2)};
                pg8::gemm_phase<EpiBf16, pg8::StaticOrder, false>(F.lds + RING_OFF, g, S, E, F.tid, STAG_PL);
            PH_END
        }
        PH_BEGIN rows_router(F, layer, layer ? (const float*)F.out : INP(I_X), (const bf16*)(ws + (layer ? WS_Y1 : WS_Y)), (bf16*)(ws + WS_U), INP(I_NORMS), INP(I_MBIAS), F.out); PH_END
        PH_BEGIN moe_gemm1(F, layer, 0); PH_END
        PH_BEGIN moe_gemm2(F, layer, 0); PH_END
        PH_BEGIN moe_combine(F, layer, 0, layer == 1, INP(I_NORMS));
                 if (layer == 0) conv_moe_weights(F, 1, INP(I_MW1), INP(I_MW3), INP(I_MW2), INP(I_SW1), INP(I_SW3), INP(I_SW2)); PH_END
    }
#ifdef PROBE_A
    if (blockIdx.x == 0 && F.tid == 0) {
        const unsigned long long tend = __builtin_amdgcn_s_memrealtime();
        unsigned long long sa = 0, sb = 0;
        for (int k = 0; k < N_PHASES; ++k) { const unsigned long long d = stampv[k + 1] - stampv[k]; if ((PROBE_A >> k) & 1u) sa += d; if ((PROBE_B >> k) & 1u) sb += d; }
        if (sb) { VM_WAIT(); F.out[0] += (float)sb * 0.001f; }
        while (__builtin_amdgcn_s_memrealtime() - tend < 8ull * sa) __builtin_amdgcn_s_sleep(8);
    }
#endif
#undef PH_BEGIN
#undef PH_END
}

extern "C" void kernel_launch(void* const* d_in, const int* in_sizes, int n_in, void* d_out, int out_size, void* d_ws, size_t ws_size, hipStream_t stream) {
    static int grid = 0;
    if (grid == 0) {
        if (n_in != 26 || in_sizes[0] != NTOK * D || out_size != NTOK * D || ws_size < WS_END) {
            fprintf(stderr, "kernel_launch: unexpected shapes / workspace (n_in %d, ws %zu, need %zu); nothing launched\n", n_in, ws_size, (size_t)WS_END); grid = -1; return; }
        int dev = 0, cus = 0, per_cu = 0;
        if (hipGetDevice(&dev) != hipSuccess || hipDeviceGetAttribute(&cus, hipDeviceAttributeMultiprocessorCount, dev) != hipSuccess) { grid = -1; return; }
        if (hipFuncSetAttribute((const void*)fwd_kernel, hipFuncAttributeMaxDynamicSharedMemorySize, LDS_BYTES) != hipSuccess) { fprintf(stderr, "kernel_launch: hipFuncSetAttribute failed\n"); grid = -1; return; }
        if (hipOccupancyMaxActiveBlocksPerMultiprocessor(&per_cu, (const void*)fwd_kernel, 512, LDS_BYTES) != hipSuccess || per_cu < 1) { fprintf(stderr, "kernel_launch: occupancy query says %d\n", per_cu); }
        (void)hipGetLastError();
        if (cus < 160) { fprintf(stderr, "kernel_launch: %d CUs: this kernel's per-workgroup tables are sized for >= 160 workgroups; nothing launched\n", cus); grid = -1; return; }
        grid = cus;
    }
    if (grid < 0) return;
    (void)hipMemsetAsync((char*)d_ws + WS_CTL, 0, CTL_ZERO_BYTES, stream);
    Args a{};
    for (int i = 0; i < 26; ++i) a.in[i] = (const float*)d_in[i];
    a.out = (float*)d_out; a.ws = (unsigned char*)d_ws;
#if MK_ONE_LAUNCH
    a.ph_lo = 0; a.ph_hi = N_PHASES;
    hipLaunchKernelGGL(fwd_kernel, dim3(grid), dim3(512), LDS_BYTES, stream, a);
#else
    for (int p = 0; p < N_PHASES; ++p) { a.ph_lo = p; a.ph_hi = p + 1; hipLaunchKernelGGL(fwd_kernel, dim3(grid), dim3(512), LDS_BYTES, stream, a); }
#endif
}
```

```cpp
#include <hip/hip_runtime.h>
#include <cstdio>
#include <cstdint>

#define STAG_G1 0
#define STAG_G2 0
#define STAG_IN 0
#define STAG_PL 0
#ifndef MK_ONE_LAUNCH
#define MK_ONE_LAUNCH 1
#endif

#define GAS __attribute__((address_space(1)))
#define LAS __attribute__((address_space(3)))
typedef unsigned short bf16;
typedef unsigned v4u __attribute__((ext_vector_type(4)));
typedef unsigned v2u __attribute__((ext_vector_type(2)));
typedef float f32x4 __attribute__((ext_vector_type(4)));
typedef float f32x2 __attribute__((ext_vector_type(2)));
typedef float f32x16 __attribute__((ext_vector_type(16)));
typedef short bf16x8 __attribute__((ext_vector_type(8)));
typedef short s16x4 __attribute__((ext_vector_type(4)));
typedef GAS unsigned gu32;
#define RLX_AGENT __ATOMIC_RELAXED, __HIP_MEMORY_SCOPE_AGENT
#define LDS_WAIT() asm volatile("s_waitcnt lgkmcnt(0)" ::: "memory")
#define VM_WAIT() asm volatile("s_waitcnt vmcnt(0)" ::: "memory")
#define DI __device__ __forceinline__

constexpr int D = 1024, NB = 8, T = 4096, NTOK = NB * T, LCTX = 256, NCTX = NB * LCTX;
constexpr int NH = 4, DK = 256, DV = 512, VTOT = 2048, RIN = 6144;
constexpr int NE = 64, TOPK = 8, EH = 256;
constexpr int CH = 128, NCHUNK = T / CH;
constexpr int NSLICE = 1, SLTOK = NTOK / NSLICE;
constexpr int ECAP = SLTOK;
constexpr int NEX = NE + 1;
constexpr int ACT_ROUTED = SLTOK * TOPK + NE * 256;
constexpr float NORM_EPS = 1e-6f, LN_EPS = 1e-5f;

typedef __bf16 bf16x2_hw __attribute__((ext_vector_type(2)));
typedef float f32x2_hw __attribute__((ext_vector_type(2)));
DI unsigned cvt_pk_bf16(float lo, float hi) { const f32x2_hw v = {lo, hi}; const bf16x2_hw r = __builtin_convertvector(v, bf16x2_hw); return __builtin_bit_cast(unsigned, r); }
DI float bf_lo(unsigned u) { return __uint_as_float(u << 16); }
DI float bf_hi(unsigned u) { return __uint_as_float(u & 0xffff0000u); }
DI float bf2f(bf16 b) { return __uint_as_float(((unsigned)b) << 16); }
DI bf16 f2bf(float f) { return (bf16)(cvt_pk_bf16(f, 0.f) & 0xffffu); }
DI float wave_sum(float v) {
    int x = __builtin_bit_cast(int, v);
#define WS_STEP(ctrl, rmask) x = __builtin_bit_cast(int, __builtin_bit_cast(float, x) + __builtin_bit_cast(float, __builtin_amdgcn_update_dpp(0, x, ctrl, rmask, 0xf, false)))
    WS_STEP(0x111, 0xf); WS_STEP(0x112, 0xf); WS_STEP(0x114, 0xf); WS_STEP(0x118, 0xf); WS_STEP(0x142, 0xa); WS_STEP(0x143, 0xc);
#undef WS_STEP
    return __builtin_bit_cast(float, __builtin_amdgcn_readlane(x, 63));
}
DI float wave_max(float v) {
    int x = __builtin_bit_cast(int, v);
#define WM_STEP(ctrl, rmask) x = __builtin_bit_cast(int, fmaxf(__builtin_bit_cast(float, x), __builtin_bit_cast(float, __builtin_amdgcn_update_dpp((int)0xff800000, x, ctrl, rmask, 0xf, false))))
    WM_STEP(0x111, 0xf); WM_STEP(0x112, 0xf); WM_STEP(0x114, 0xf); WM_STEP(0x118, 0xf); WM_STEP(0x142, 0xa); WM_STEP(0x143, 0xc);
#undef WM_STEP
    return __builtin_bit_cast(float, __builtin_amdgcn_readlane(x, 63));
}
#define G8_DPP(x, ctrl) __builtin_bit_cast(float, __builtin_amdgcn_update_dpp(0, __builtin_bit_cast(int, x), ctrl, 0xf, 0xf, false))
DI float grp8_max(float x) { x = fmaxf(x, G8_DPP(x, 0xB1)); x = fmaxf(x, G8_DPP(x, 0x4E)); x = fmaxf(x, G8_DPP(x, 0x141)); return x; }
DI float grp8_sum(float x) { x += G8_DPP(x, 0xB1); x += G8_DPP(x, 0x4E); x += G8_DPP(x, 0x141); return x; }
DI float lane_xor(float v, int lane, int d) { return __builtin_bit_cast(float, __builtin_amdgcn_ds_bpermute((lane ^ d) << 2, __builtin_bit_cast(int, v))); }
DI float sigmoidf_(float x) { return __builtin_amdgcn_rcpf(1.f + __expf(-x)); }
DI float siluf_(float x) { return x * __builtin_amdgcn_rcpf(1.f + __expf(-x)); }

namespace pg8 {
constexpr int BM = 256, BK = 64, HALF = 128, HTB = HALF * BK * 2, STAGE_BYTES = 8 * HTB, NXCD = 8, WGM = 8;
DI int lds_byte(int r, int c) { const int st = (r >> 4) * 2 + (c >> 5), rr = r & 15, cc = c & 31, ob = rr * 64 + cc * 2; return st * 1024 + (ob ^ (((ob >> 9) & 1) << 5)); }
DI void stage_rc(int b, int& R, int& C) { const int st = b / 1024, sb = b % 1024, swz = sb ^ (((sb >> 9) & 1) << 5); R = (st >> 1) * 16 + swz / 64; C = (st & 1) * 32 + (swz % 64) / 2; }
DI int perm32(int rho) { const int n = rho >> 4, i = rho & 15; return 8 * (i >> 2) + 4 * n + (i & 3); }

struct Unit { int pm, pn, e0, e1; };
struct Gemm { const bf16* A; const bf16* Bt; int K; };

struct StaticOrder {
    int nM, nN, nwg, G, c;
    DI void init(int M, int N, int G_, int c_) { nM = M / BM; nN = N / BM; nwg = nM * nN; G = G_; c = c_; }
    DI bool next(int i, Unit& u) const {
        const long L = (long)i * G + c; if (L >= nwg) return false;
        int wgid = (int)L; { const int q = nwg / NXCD, r = nwg % NXCD, xcd = wgid % NXCD, off = wgid / NXCD; wgid = (xcd < r ? xcd * (q + 1) : r * (q + 1) + (xcd - r) * q) + off; }
        const int nig = WGM * nN, gid = wgid / nig, fm = gid * WGM, gsz = (nM - fm) < WGM ? (nM - fm) : WGM;
        u.pm = fm + ((wgid % nig) % gsz); u.pn = (wgid % nig) / gsz; u.e0 = 0; u.e1 = 0; return true;
    }
    DI int a_row(const Unit&, int) const { return 0; }
};

template <class Epi, class Sched, bool GATHER>
DI void gemm_phase(LAS unsigned char* lds, const Gemm g, const Sched& S, const Epi& E, const int tid, const int stagger_us = 0) {
    if (stagger_us > 0 && (S.c & 1)) {
#pragma unroll 1
        for (int i_ = 0; i_ < stagger_us / 2; ++i_) __builtin_amdgcn_s_sleep(64); }
    const int wid = __builtin_amdgcn_readfirstlane(tid >> 6), lane = tid & 63, wr = wid >> 2, wc = wid & 3, fr = lane & 15, fq = lane >> 4;
    const int K = g.K, nt = K / BK;
    unsigned voffB[2], vA[2][2], nvA[2][2]; int Rr[2], Cc[2];
#pragma unroll
    for (int i = 0; i < 2; ++i) { int R, C; stage_rc(tid * 16 + i * 8192, R, C); const int Rb = Epi::PERM ? ((R & ~31) + perm32(R & 31)) : R;
        voffB[i] = (unsigned)(Rb * K + C) * 2u; Rr[i] = R; Cc[i] = C; }
    const size_t kstep = (size_t)(BK * 2);
    const size_t hstep = (size_t)HALF * K * 2;
    const size_t tstep = 2 * hstep;
    const unsigned ldsw = (unsigned)wid * 1024u;
    const int aoff = lds_byte(wr * 64 + fr, fq * 8), boff = lds_byte(wc * 32 + fr, fq * 8);
#define PG8_SETV(u, v) do { _Pragma("unroll") for (int _h = 0; _h < 2; ++_h) _Pragma("unroll") for (int _i = 0; _i < 2; ++_i) \
        (v)[_h][_i] = GATHER ? (unsigned)(S.a_row((u), _h * 128 + Rr[_i]) * K + Cc[_i]) * 2u : (unsigned)((_h * 128 + Rr[_i]) * K + Cc[_i]) * 2u; } while (0)
#define PG8_SA(b, h) (((b) * 2 + (h)) * HTB)
#define PG8_SB(b, h) ((4 + (b) * 2 + (h)) * HTB)
#define PG8_STAGE(bufoff, gbase, voff) do { _Pragma("unroll") for (int _i = 0; _i < 2; ++_i) \
        __builtin_amdgcn_global_load_lds((const unsigned*)((const char*)(gbase) + (voff)[_i]), (LAS unsigned*)(lds + (bufoff) + ldsw + _i * 8192), 16, 0, 0); } while (0)
#define PG8_LDA(dst, b, h) do { _Pragma("unroll") for (int m = 0; m < 4; ++m) _Pragma("unroll") for (int k = 0; k < 2; ++k) dst[m][k] = *(const LAS bf16x8*)(lds + PG8_SA(b, h) + aoff + m * 2048 + k * 1024); } while (0)
#define PG8_LDB(dst, b, h) do { _Pragma("unroll") for (int n = 0; n < 2; ++n) _Pragma("unroll") for (int k = 0; k < 2; ++k) dst[n][k] = *(const LAS bf16x8*)(lds + PG8_SB(b, h) + boff + n * 2048 + k * 1024); } while (0)
#define PG8_MMA(ai, bj, At, Bt) do { __builtin_amdgcn_s_setprio(1); _Pragma("unroll") for (int m = 0; m < 4; ++m) _Pragma("unroll") for (int n = 0; n < 2; ++n) _Pragma("unroll") for (int k = 0; k < 2; ++k) \
        acc[ai][bj][m][n] = __builtin_amdgcn_mfma_f32_16x16x32_bf16(Bt[n][k], At[m][k], acc[ai][bj][m][n], 0, 0, 0); __builtin_amdgcn_s_setprio(0); } while (0)
#define PG8_WAIT_V(n) asm volatile("s_waitcnt vmcnt(" #n ")" ::: "memory")
#define PG8_WAIT_L(n) asm volatile("s_waitcnt lgkmcnt(" #n ")" ::: "memory")
#define PG8_BAR __builtin_amdgcn_s_barrier()
#define PG8_SCHED __builtin_amdgcn_sched_barrier(0)
    Unit cur, nxt; int ui = 0;
    if (!S.next(0, cur)) return;
    f32x4 acc[2][2][4][2];
#pragma unroll
    for (int a = 0; a < 2; ++a)
#pragma unroll
        for (int b = 0; b < 2; ++b)
#pragma unroll
            for (int m = 0; m < 4; ++m)
#pragma unroll
                for (int n = 0; n < 2; ++n) acc[a][b][m][n] = (f32x4){0.f, 0.f, 0.f, 0.f};
    bf16x8 At[4][2], B0[2][2], B1[2][2];
    PG8_SETV(cur, vA);
    const char* cA = GATHER ? (const char*)g.A : (const char*)g.A + (size_t)cur.pm * tstep; const char* cB = (const char*)g.Bt + (size_t)cur.pn * tstep;
    PG8_STAGE(PG8_SB(0, 0), cB, voffB); PG8_STAGE(PG8_SB(0, 1), cB + hstep, voffB); PG8_STAGE(PG8_SA(0, 0), cA, vA[0]); PG8_STAGE(PG8_SA(0, 1), cA, vA[1]);
    if (wr == 1) PG8_BAR;
    PG8_WAIT_V(2); PG8_BAR;
    PG8_STAGE(PG8_SB(1, 0), cB + kstep, voffB); PG8_STAGE(PG8_SA(1, 0), cA + kstep, vA[0]); PG8_STAGE(PG8_SB(1, 1), cB + hstep + kstep, voffB);
    PG8_WAIT_V(6); PG8_BAR;
    for (;;) {
        const bool has_next = S.next(ui + 1, nxt);
        const char* nA = has_next ? (GATHER ? (const char*)g.A : (const char*)g.A + (size_t)nxt.pm * tstep) : cA; const char* nB = has_next ? (const char*)g.Bt + (size_t)nxt.pn * tstep : cB;
        if (GATHER) { if (has_next) { PG8_SETV(nxt, nvA); } else {
#pragma unroll
            for (int h = 0; h < 2; ++h)
#pragma unroll
                for (int i = 0; i < 2; ++i) nvA[h][i] = vA[h][i]; } }
#pragma unroll 1
        for (int t = 0; t < nt; t += 2) {
            const bool last = (t == nt - 2);
            const char* a1 = cA + (size_t)(t + 1) * kstep;
            const char* a2 = last ? nA : cA + (size_t)(t + 2) * kstep; const char* b2 = last ? nB : cB + (size_t)(t + 2) * kstep;
            const char* a3 = a2 + kstep; const char* b3 = b2 + kstep;
            unsigned s2[2][2];
#pragma unroll
            for (int h = 0; h < 2; ++h)
#pragma unroll
                for (int i = 0; i < 2; ++i) s2[h][i] = (GATHER && last) ? nvA[h][i] : vA[h][i];
            PG8_LDB(B0, 0, 0); PG8_LDB(B1, 0, 1); PG8_SCHED; PG8_LDA(At, 0, 0); PG8_STAGE(PG8_SA(1, 1), a1, vA[1]);
            PG8_WAIT_V(8); PG8_WAIT_L(0); PG8_BAR; PG8_MMA(0, 0, At, B0); PG8_MMA(0, 1, At, B1); PG8_BAR; PG8_SCHED;
            PG8_LDA(At, 0, 1); PG8_STAGE(PG8_SB(0, 0), b2, voffB); PG8_STAGE(PG8_SB(0, 1), b2 + hstep, voffB); PG8_STAGE(PG8_SA(0, 0), a2, s2[0]);
            PG8_WAIT_V(8); PG8_WAIT_L(0); PG8_BAR; PG8_MMA(1, 0, At, B0); PG8_MMA(1, 1, At, B1); PG8_BAR; PG8_SCHED;
            PG8_LDB(B0, 1, 0); PG8_LDB(B1, 1, 1); PG8_SCHED; PG8_LDA(At, 1, 0); PG8_STAGE(PG8_SA(0, 1), a2, s2[1]);
            PG8_WAIT_V(8); PG8_WAIT_L(0); PG8_BAR; PG8_MMA(0, 0, At, B0); PG8_MMA(0, 1, At, B1); PG8_BAR; PG8_SCHED;
            PG8_LDA(At, 1, 1); PG8_STAGE(PG8_SB(1, 0), b3, voffB); PG8_STAGE(PG8_SB(1, 1), b3 + hstep, voffB); PG8_STAGE(PG8_SA(1, 0), a3, s2[0]);
            PG8_WAIT_V(8); PG8_WAIT_L(0); PG8_BAR; PG8_MMA(1, 0, At, B0); PG8_MMA(1, 1, At, B1); PG8_BAR; PG8_SCHED;
        }
        if (wr == 0) PG8_BAR;
        { int tz = tid; asm volatile("" : "+v"(tz));
          const int wid2 = __builtin_amdgcn_readfirstlane(tz >> 6), lane2 = tz & 63;
          E(acc, cur, wid2 >> 2, wid2 & 3, lane2 & 15, lane2 >> 4); }
        if (!has_next) break;
#pragma unroll
        for (int a = 0; a < 2; ++a)
#pragma unroll
            for (int b = 0; b < 2; ++b)
#pragma unroll
                for (int m = 0; m < 4; ++m)
#pragma unroll
                    for (int n = 0; n < 2; ++n) acc[a][b][m][n] = (f32x4){0.f, 0.f, 0.f, 0.f};
        cur = nxt; cA = nA; cB = nB; ++ui;
        if (GATHER) {
#pragma unroll
            for (int h = 0; h < 2; ++h)
#pragma unroll
                for (int i = 0; i < 2; ++i) vA[h][i] = nvA[h][i]; }
        if (wr == 1) PG8_BAR;
    }
    PG8_WAIT_V(0);
    PG8_BAR;
#undef PG8_SETV
#undef PG8_SA
#undef PG8_SB
#undef PG8_STAGE
#undef PG8_LDA
#undef PG8_LDB
#undef PG8_MMA
#undef PG8_WAIT_V
#undef PG8_WAIT_L
#undef PG8_BAR
#undef PG8_SCHED
}
}
using pg8::Unit;

constexpr size_t MiB = 1u << 20;
constexpr size_t WS_CTL = 0, CTL_ZERO_BYTES = 2 * MiB;
constexpr size_t WS_MOD = 2 * MiB;
constexpr size_t WS_ROPE = 4 * MiB;
constexpr size_t WS_WIN = 10 * MiB, WS_WOUT = 22 * MiB, WS_CW1 = 26 * MiB, WS_CW2 = 30 * MiB;
constexpr size_t WS_W13 = 32 * MiB, WS_W2 = 97 * MiB;
constexpr size_t WS_LIST = 130 * MiB;
constexpr size_t LIST_ARR = (size_t)NEX * ECAP * 4, LIST_SLICE = 3 * LIST_ARR;
constexpr size_t WS_BIG = 160 * MiB;
constexpr size_t WS_Q = WS_BIG, WS_K = WS_Q + 64 * MiB, WS_V = WS_K + 64 * MiB, WS_G = WS_V + 128 * MiB;
constexpr size_t WS_KC = 544 * MiB, WS_VC = 548 * MiB, WS_P = 560 * MiB;
constexpr size_t WS_Y = WS_BIG;
constexpr size_t WS_ACT = WS_BIG;
constexpr size_t WS_Y2 = WS_BIG + 152 * MiB;
constexpr size_t WS_U = WS_Y2;
constexpr size_t WS_UC = WS_BIG;
constexpr size_t WS_Z = WS_BIG + 64 * MiB, WS_C = WS_BIG + 128 * MiB, WS_Y1 = WS_BIG + 216 * MiB;
constexpr size_t WS_END = 600 * MiB;
static_assert(WS_LIST + NSLICE * LIST_SLICE <= WS_BIG, "lists");
static_assert(WS_ACT + (size_t)(ACT_ROUTED + SLTOK) * 512 <= WS_Y2, "act");
static_assert(WS_Y2 + (size_t)SLTOK * 9 * 1024 <= WS_END, "y2");
static_assert(WS_W13 + (size_t)NEX * 512 * 1024 * 2 <= WS_W2 && WS_W2 + (size_t)NEX * 1024 * 256 * 2 <= WS_LIST, "moe w");
constexpr int CW_TMO = 0, CW_CODE = 1;
constexpr int CW_BAR = 4096;
constexpr int CW_CNT = 16384;
DI int cnt_word(int layer, int slice, int e) { return CW_CNT + ((layer * NSLICE + slice) * NE + e) * 16; }

constexpr int RING_OFF = 0, RING_BYTES = 131072;
constexpr int LDSCTL_OFF = 148480, MISC_OFF = LDSCTL_OFF + 1024;
constexpr int LDS_BYTES = 152576;

#define XB_TMO      128
#define XB_XCNT(j)  (256  + 64 * (j))
#define XB_XSUB(j)  (1280 + 64 * (j))
#define XB_XGEN(j)  (2304 + 64 * (j))
#define XB_TOP      3328
#define XB_TOPGEN   3392
#define XCD_BAR_WORDS 3456
#define XB_SPIN_CAP (1u << 18)
DI unsigned xb_ld(unsigned* p)              { return __hip_atomic_load(p, __ATOMIC_RELAXED, __HIP_MEMORY_SCOPE_AGENT); }
DI unsigned xb_add(unsigned* p, unsigned v) { return __hip_atomic_fetch_add(p, v, __ATOMIC_RELAXED, __HIP_MEMORY_SCOPE_AGENT); }
DI unsigned xb_xcc_id() { return (unsigned)__builtin_amdgcn_s_getreg((3 << 11) | 20) & 0xFu; }
#define XB_SPIN(cond, bar) do { unsigned _sp = 0; while (cond) { __builtin_amdgcn_s_sleep(1); \
    if ((++_sp & 255u) == 0u) { if (xb_ld(&(bar)[XB_TMO])) break; if (_sp > XB_SPIN_CAP) { atomicAdd(&(bar)[XB_TMO], 1u); break; } } } } while (0)
struct XcdBarrier { unsigned* bar; unsigned x; volatile LAS unsigned* st; };
DI XcdBarrier xcd_barrier_post(unsigned* bar, volatile LAS unsigned* st) {
    XcdBarrier b; b.bar = bar; b.x = xb_xcc_id(); b.st = st;
    if (threadIdx.x == 0) (void)xb_add(&bar[XB_XCNT(b.x)], 1u);
    return b;
}
DI void xcd_barrier_complete(unsigned* bar, unsigned x, unsigned& nloc, unsigned& nx) {
    const unsigned G = gridDim.x * gridDim.y * gridDim.z;
    unsigned sum, cnt, mine, sp = 0u;
    for (;;) {
        sum = 0u; cnt = 0u; mine = 0u;
#pragma unroll
        for (unsigned j = 0; j < 16; ++j) { const unsigned c = xb_ld(&bar[XB_XCNT(j)]); sum += c; cnt += (c > 0u) ? 1u : 0u; mine = (j == x) ? c : mine; }
        if (sum == G) break;
        __builtin_amdgcn_s_sleep(1);
        if ((++sp & 255u) == 0u) { if (xb_ld(&bar[XB_TMO])) break; if (sp > XB_SPIN_CAP) { atomicAdd(&bar[XB_TMO], 1u); break; } }
    }
    nloc = mine > 0u ? mine : 1u; nx = cnt > 0u ? cnt : 1u;
}
DI void xcd_barrier(const XcdBarrier& b, const bool leader) {
    asm volatile("s_waitcnt vmcnt(0)" ::: "memory");
    __syncthreads();
    if (leader) {
        unsigned* bar = b.bar;
        __builtin_amdgcn_s_waitcnt(0);
        unsigned nloc = b.st[0], nx = b.st[1];
        if (nloc == 0u) { xcd_barrier_complete(bar, b.x, nloc, nx); b.st[0] = nloc; b.st[1] = nx; }
        const unsigned old = xb_add(&bar[XB_XSUB(b.x)], 1u);
        const unsigned gen = old / nloc;
        if (old + 1u == (gen + 1u) * nloc) {
            __builtin_amdgcn_fence(__ATOMIC_RELEASE, "agent");
            asm volatile("s_waitcnt vmcnt(0)" ::: "memory");
            const unsigned og = xb_add(&bar[XB_TOP], 1u);
            const unsigned tg = og / nx;
            if (og + 1u == (tg + 1u) * nx) xb_add(&bar[XB_TOPGEN], 1u);
            else XB_SPIN(xb_ld(&bar[XB_TOPGEN]) == tg, bar);
            __builtin_amdgcn_fence(__ATOMIC_ACQUIRE, "agent");
            xb_add(&bar[XB_XGEN(b.x)], 1u);
            asm volatile("s_waitcnt vmcnt(0)" ::: "memory");
        } else {
            XB_SPIN(xb_ld(&bar[XB_XGEN(b.x)]) == gen, bar);
            __builtin_amdgcn_fence(__ATOMIC_ACQUIRE, "agent");
            asm volatile("s_waitcnt vmcnt(0)" ::: "memory");
        }
    }
    __syncthreads();
}

struct Frame {
    LAS unsigned char* lds;
    volatile LAS unsigned* MISC;
    unsigned* ctl;
    unsigned char* ws;
    int tid, lane, wave, vcu, G;
    float* out;
};
enum { I_X = 0, I_C, I_CTX, I_CCTX, I_MODW, I_MODB, I_NORMS, I_RWIN, I_RWOUT, I_RDECAY, I_CW1, I_CB1, I_CDW, I_CBDW, I_CLNG, I_CLNB, I_CW2, I_CB2,
       I_ROUTER, I_MBIAS, I_MW1, I_MW3, I_MW2, I_SW1, I_SW3, I_SW2 };

typedef const f32x4 (&AccRef)[2][2][4][2];
DI void st16(bf16* p, unsigned a, unsigned b, unsigned c, unsigned d) { v4u o; o.x = a; o.y = b; o.z = c; o.w = d; *(GAS v4u*)p = o; }

struct EpiQKVG {
    static constexpr bool PERM = true;
    unsigned char* ws;
    DI void operator()(AccRef acc, const Unit& u, int wr, int wc, int fr, int fq) const {
        const bool ctx = u.pm >= 128;
        const int rbase = u.pm * 256 + wr * 64 + fr, cw = wc * 32 + 8 * fq, pn = u.pn;
        if (pn < 8) {
            const bool isq = pn < 4; const int head = pn & 3;
            const size_t doff = ctx ? WS_KC : (isq ? WS_Q : WS_K);
            bf16* dst = (bf16*)(ws + doff);
            const int bb = ctx ? u.pm - 128 : u.pm >> 4, nch = ctx ? 2 : NCHUNK;
            const float* cs = (const float*)(ws + WS_ROPE) + (ctx ? 2 * T * 128 : 0);
            const int snoff = ctx ? LCTX * 128 : T * 128;
            const float sc = isq ? 0.0625f : 1.f;
#pragma unroll
            for (int ai = 0; ai < 2; ++ai)
#pragma unroll
                for (int m = 0; m < 4; ++m) {
                    const int row = rbase + ai * 128 + m * 16, rr = ctx ? row - NTOK : row, t = ctx ? (rr & (LCTX - 1)) : (row & (T - 1));
#pragma unroll
                    for (int bj = 0; bj < 2; ++bj) {
                        const int p0 = bj * 64 + wc * 16 + 4 * fq;
                        const f32x4 c = *(const GAS f32x4*)(cs + (size_t)t * 128 + p0), s = *(const GAS f32x4*)(cs + snoff + (size_t)t * 128 + p0);
                        const f32x4 v0 = acc[ai][bj][m][0], v1 = acc[ai][bj][m][1];
                        const float o0 = (v0[0] * c[0] - v0[1] * s[0]) * sc, o1 = (v0[0] * s[0] + v0[1] * c[0]) * sc;
                        const float o2 = (v0[2] * c[1] - v0[3] * s[1]) * sc, o3 = (v0[2] * s[1] + v0[3] * c[1]) * sc;
                        const float o4 = (v1[0] * c[2] - v1[1] * s[2]) * sc, o5 = (v1[0] * s[2] + v1[1] * c[2]) * sc;
                        const float o6 = (v1[2] * c[3] - v1[3] * s[3]) * sc, o7 = (v1[2] * s[3] + v1[3] * c[3]) * sc;
                        const int chunk = ctx ? ai : ((2 * u.pm + ai) & (NCHUNK - 1)), itq = wr * 2 + (m >> 1), rq = (m & 1) * 16 + fr, ksq = bj * 8 + wc * 2 + (fq >> 1);
                        const size_t fo = isq ? ((((size_t)(bb * nch + chunk) * NH + head) * 8 + (4 * wr + m)) * 8 + (4 * bj + wc)) * 512 + (fr + 16 * fq) * 8
                                              : ((((size_t)(bb * nch + chunk) * NH + head) * 4 + itq) * 16 + ksq) * 512 + (rq + 32 * (fq & 1)) * 8;
                        st16(dst + fo, cvt_pk_bf16(o0, o1), cvt_pk_bf16(o2, o3), cvt_pk_bf16(o4, o5), cvt_pk_bf16(o6, o7));
                    }
                }
        } else {
            const bool isg = pn >= 16; const int ct = (pn - (isg ? 16 : 8)) * 256;
            const size_t doff = isg ? WS_G : (ctx ? WS_VC : WS_V);
            bf16* dst = (bf16*)(ws + doff);
#pragma unroll
            for (int ai = 0; ai < 2; ++ai)
#pragma unroll
                for (int m = 0; m < 4; ++m) {
                    const int row = rbase + ai * 128 + m * 16, rr = ctx ? row - NTOK : row;
#pragma unroll
                    for (int bj = 0; bj < 2; ++bj) {
                        f32x4 v0 = acc[ai][bj][m][0], v1 = acc[ai][bj][m][1];
                        if (isg) {
#pragma unroll
                            for (int e = 0; e < 4; ++e) { v0[e] = siluf_(v0[e]); v1[e] = siluf_(v1[e]); }
                        }
                        st16(dst + (size_t)rr * 2048 + ct + bj * 128 + cw, cvt_pk_bf16(v0[0], v0[1]), cvt_pk_bf16(v0[2], v0[3]), cvt_pk_bf16(v1[0], v1[1]), cvt_pk_bf16(v1[2], v1[3]));
                    }
                }
        }
    }
};
struct InprojOrder {
    pg8::StaticOrder so; int G, c;
    DI void init(int G_, int c_) { so.init(NTOK, RIN, G_, c_); G = G_; c = c_; }
    DI bool next(int i, Unit& u) const {
        const int L = i * G + c;
        if (L < 3072) return so.next(i, u);
        const int l2 = L - 3072; if (l2 >= 96) return false;
        u.pm = 128 + l2 / 12; u.pn = 4 + l2 % 12; u.e0 = 0; u.e1 = 0; return true;
    }
    DI int a_row(const Unit&, int) const { return 0; }
};
struct EpiBf16 {
    static constexpr bool PERM = true;
    bf16* O; int ldc; const float* bias;
    DI void operator()(AccRef acc, const Unit& u, int wr, int wc, int fr, int fq) const {
        const int rbase = u.pm * 256 + wr * 64 + fr, cbase = u.pn * 256 + wc * 32 + 8 * fq;
#pragma unroll
        for (int bj = 0; bj < 2; ++bj) {
            f32x4 b0 = (f32x4){0.f, 0.f, 0.f, 0.f}, b1 = b0;
            if (bias) { b0 = *(const GAS f32x4*)(bias + cbase + bj * 128); b1 = *(const GAS f32x4*)(bias + cbase + bj * 128 + 4); }
#pragma unroll
            for (int ai = 0; ai < 2; ++ai)
#pragma unroll
                for (int m = 0; m < 4; ++m) {
                    const f32x4 v0 = acc[ai][bj][m][0] + b0, v1 = acc[ai][bj][m][1] + b1;
                    st16(O + (size_t)(rbase + ai * 128 + m * 16) * ldc + cbase + bj * 128, cvt_pk_bf16(v0[0], v0[1]), cvt_pk_bf16(v0[2], v0[3]), cvt_pk_bf16(v1[0], v1[1]), cvt_pk_bf16(v1[2], v1[3]));
                }
        }
    }
};
struct EpiGLU {
    static constexpr bool PERM = true;
    bf16* Z; const float* b1;
    DI void operator()(AccRef acc, const Unit& u, int wr, int wc, int fr, int fq) const {
        const int rbase = u.pm * 256 + wr * 64 + fr, cc = u.pn * 128 + wc * 32 + 8 * fq;
        const f32x4 ba0 = *(const GAS f32x4*)(b1 + cc), ba1 = *(const GAS f32x4*)(b1 + cc + 4), bg0 = *(const GAS f32x4*)(b1 + 1024 + cc), bg1 = *(const GAS f32x4*)(b1 + 1024 + cc + 4);
#pragma unroll
        for (int ai = 0; ai < 2; ++ai)
#pragma unroll
            for (int m = 0; m < 4; ++m) {
                const f32x4 a0 = acc[ai][0][m][0] + ba0, a1 = acc[ai][0][m][1] + ba1, g0 = acc[ai][1][m][0] + bg0, g1 = acc[ai][1][m][1] + bg1;
                f32x4 o0, o1;
#pragma unroll
                for (int e = 0; e < 4; ++e) { o0[e] = a0[e] * sigmoidf_(g0[e]); o1[e] = a1[e] * sigmoidf_(g1[e]); }
                st16(Z + (size_t)(rbase + ai * 128 + m * 16) * 1024 + cc, cvt_pk_bf16(o0[0], o0[1]), cvt_pk_bf16(o0[2], o0[3]), cvt_pk_bf16(o1[0], o1[1]), cvt_pk_bf16(o1[2], o1[3]));
            }
    }
};
struct MoeOrder {
    const LAS int* cum; const LAS int* cnt; const LAS int* rb; const LAS unsigned char* eob; const int* ltok; int npn, G, c, total;
    DI bool next(int i, Unit& u) const {
        const int L = i * G + c; if (L >= total) return false;
        const int blk = L / npn, sub = L - blk * npn;
        const int e = eob[blk];
        const int bi = blk - cum[e];
        u.pm = blk; u.pn = e * npn + sub; const int left = cnt[e] - bi * 256; u.e1 = left < 256 ? left : 256;
        u.e0 = ltok ? e * ECAP + bi * 256 : rb[e] + bi * 256;
        return true;
    }
    DI int a_row(const Unit& u, int r) const { return r < u.e1 ? ltok[u.e0 + r] : 0; }
};
struct EpiSwiGLU {
    static constexpr bool PERM = true;
    bf16* ACT;
    DI void operator()(AccRef acc, const Unit& u, int wr, int wc, int fr, int fq) const {
        const int rbase = u.pm * 256 + wr * 64 + fr, cc = (u.pn & 1) * 128 + wc * 32 + 8 * fq;
#pragma unroll
        for (int ai = 0; ai < 2; ++ai)
#pragma unroll
            for (int m = 0; m < 4; ++m) {
                const f32x4 a0 = acc[ai][0][m][0], a1 = acc[ai][0][m][1], g0 = acc[ai][1][m][0], g1 = acc[ai][1][m][1];
                f32x4 o0, o1;
#pragma unroll
                for (int e = 0; e < 4; ++e) { o0[e] = siluf_(a0[e]) * g0[e]; o1[e] = siluf_(a1[e]) * g1[e]; }
                st16(ACT + (size_t)(rbase + ai * 128 + m * 16) * 256 + cc, cvt_pk_bf16(o0[0], o0[1]), cvt_pk_bf16(o0[2], o0[3]), cvt_pk_bf16(o1[0], o1[1]), cvt_pk_bf16(o1[2], o1[3]));
            }
    }
};
struct EpiMoeOut {
    static constexpr bool PERM = true;
    unsigned char* Y2; int nostore;
    DI void operator()(AccRef acc, const Unit& u, int wr, int wc, int fr, int fq) const {
        const int ch = ((u.pn & 3) * 16 + wc * 4 + fq) * 16;
        if (nostore) { if (acc[0][0][0][0][0] != 12345.678f || acc[1][1][3][1][3] != 321.f) return; }
#pragma unroll
        for (int ai = 0; ai < 2; ++ai)
#pragma unroll
            for (int m = 0; m < 4; ++m) {
                const int r = ai * 128 + wr * 64 + m * 16 + fr;
                if (r < u.e1) {
                    unsigned pk[4];
#pragma unroll
                    for (int bj = 0; bj < 2; ++bj) {
                        const f32x4 v0 = acc[ai][bj][m][0], v1 = acc[ai][bj][m][1];
                        int p0 = __builtin_amdgcn_cvt_pk_fp8_f32(v0[0], v0[1], 0, false); p0 = __builtin_amdgcn_cvt_pk_fp8_f32(v0[2], v0[3], p0, true);
                        int p1 = __builtin_amdgcn_cvt_pk_fp8_f32(v1[0], v1[1], 0, false); p1 = __builtin_amdgcn_cvt_pk_fp8_f32(v1[2], v1[3], p1, true);
                        pk[2 * bj] = (unsigned)p0; pk[2 * bj + 1] = (unsigned)p1;
                    }
                    *(GAS v4u*)(Y2 + (size_t)(u.e0 + r) * 1024 + ch) = (v4u){pk[0], pk[1], pk[2], pk[3]};
                }
            }
    }
};

struct TrItem { const float* src; bf16* dst; int ldsrc, Kd; };
DI void tr_load(const TrItem& t, float (&tv)[32], int lane) {
#pragma unroll
    for (int i = 0; i < 32; ++i) { const int kk = 2 * i + (lane >> 5); tv[i] = t.src[(size_t)kk * t.ldsrc + (lane & 31)]; }
}
DI void tr_store(const TrItem& t, const float (&tv)[32], LAS float* scr, int lane) {
#pragma unroll
    for (int i = 0; i < 32; ++i) { const int kk = 2 * i + (lane >> 5); scr[kk * 33 + (lane & 31)] = tv[i]; }
    LDS_WAIT(); asm volatile("" ::: "memory");
    const int c = lane & 7;
#pragma unroll
    for (int j = 0; j < 4; ++j) { const int n = (lane >> 3) + 8 * j; const LAS float* s = scr + (8 * c) * 33 + n;
        v4u o; o.x = cvt_pk_bf16(s[0 * 33], s[1 * 33]); o.y = cvt_pk_bf16(s[2 * 33], s[3 * 33]); o.z = cvt_pk_bf16(s[4 * 33], s[5 * 33]); o.w = cvt_pk_bf16(s[6 * 33], s[7 * 33]);
        *(GAS v4u*)(t.dst + (size_t)n * t.Kd + 8 * c) = o; }
    LDS_WAIT(); asm volatile("" ::: "memory");
}
DI TrItem tr_mk(const float* src, int ldsrc, int k0, int scol0, bf16* dst, int Kd, int drow0) { TrItem t; t.src = src + (size_t)k0 * ldsrc + scol0; t.dst = dst + (size_t)drow0 * Kd + k0; t.ldsrc = ldsrc; t.Kd = Kd; return t; }
template <class MK> DI void tr_run(int it0, int step, int n, LAS float* scr, int lane, MK mk) {
    float ta[32], tb[32];
    TrItem ia, ib;
    if (it0 < n) { ia = mk(it0); tr_load(ia, ta, lane); }
    for (int it = it0; it < n; it += 2 * step) {
        const bool hb = it + step < n;
        if (hb) { ib = mk(it + step); tr_load(ib, tb, lane); }
        tr_store(ia, ta, scr, lane);
        if (hb) {
            if (it + 2 * step < n) { ia = mk(it + 2 * step); tr_load(ia, ta, lane); }
            tr_store(ib, tb, scr, lane);
        }
    }
}
DI void conv_moe_weights(Frame& F, int layer, const float* mw1, const float* mw3, const float* mw2, const float* sw1, const float* sw3, const float* sw2) {
    LAS float* scr = (LAS float*)(F.lds + RING_OFF + F.wave * 16384);
    const int gw = F.vcu * 8 + F.wave, NGW = F.G * 8;
    bf16* W13 = (bf16*)(F.ws + WS_W13); bf16* W2 = (bf16*)(F.ws + WS_W2);
    constexpr int I13 = 16 * 16, I2 = 4 * 32, PER = I13 + I2;
    tr_run(gw, NGW, NEX * PER, scr, F.lane, [&](int it) -> TrItem {
        const int e = it / PER, r = it - e * PER;
        if (r < I13) {
            const int kb = r >> 4, nb = r & 15;
            const float* s1 = e < NE ? mw1 + ((size_t)(layer * NE + e) << 18) : sw1 + ((size_t)layer << 18);
            const float* s3 = e < NE ? mw3 + ((size_t)(layer * NE + e) << 18) : sw3 + ((size_t)layer << 18);
            const float* src = (nb & 7) < 4 ? s1 : s3;
            return tr_mk(src, 256, kb * 64, 128 * (nb >> 3) + 32 * (nb & 3), W13, 1024, e * 512 + nb * 32);
        } else {
            const int r2 = r - I13, kb = r2 >> 5, nb = r2 & 31;
            const float* src = e < NE ? mw2 + ((size_t)(layer * NE + e) << 18) : sw2 + ((size_t)layer << 18);
            return tr_mk(src, 1024, kb * 64, nb * 32, W2, 256, e * 1024 + nb * 32);
        }
    });
}
DI void conv_small_weights(Frame& F, const float* rwin, const float* rwout, const float* cw1, const float* cw2) {
    LAS float* scr = (LAS float*)(F.lds + RING_OFF + F.wave * 16384);
    const int gw = F.vcu * 8 + F.wave, NGW = F.G * 8;
    constexpr int I_IN = 16 * 192, I_OUT = 32 * 32, I_C1 = 16 * 64, I_C2 = 16 * 32, TOT = I_IN + I_OUT + I_C1 + I_C2;
    unsigned char* ws = F.ws;
    tr_run(gw, NGW, TOT, scr, F.lane, [&](int it) -> TrItem {
        int r = it;
        if (r < I_IN) { const int kb = r / 192, nb = r % 192; return tr_mk(rwin, RIN, kb * 64, nb * 32, (bf16*)(ws + WS_WIN), 1024, nb * 32); } r -= I_IN;
        if (r < I_OUT) { const int kb = r >> 5, nb = r & 31; return tr_mk(rwout, 1024, kb * 64, nb * 32, (bf16*)(ws + WS_WOUT), 2048, nb * 32); } r -= I_OUT;
        if (r < I_C1) { const int kb = r >> 6, nb = r & 63; const int sc0 = ((nb & 7) < 4 ? 0 : 1024) + 128 * (nb >> 3) + 32 * (nb & 3);
            return tr_mk(cw1, 2048, kb * 64, sc0, (bf16*)(ws + WS_CW1), 1024, nb * 32); } r -= I_C1;
        { const int kb = r >> 5, nb = r & 31; return tr_mk(cw2, 1024, kb * 64, nb * 32, (bf16*)(ws + WS_CW2), 1024, nb * 32); }
    });
}
DI void rope_tables(Frame& F) {
    float* csL = (float*)(F.ws + WS_ROPE); float* snL = csL + T * 128; float* csC = snL + T * 128; float* snC = csC + LCTX * 128;
    const int gt = F.vcu * 512 + F.tid, NT = F.G * 512;
    for (int i = gt; i < (T + LCTX) * 128; i += NT) {
        const int t = i >> 7, p = i & 127;
        int ax, ii, dd; if (p < 32) { ax = 0; ii = p; dd = 64; } else if (p < 80) { ax = 1; ii = p - 32; dd = 96; } else { ax = 2; ii = p - 80; dd = 96; }
        const float inv = exp2f(-13.287712379549449f * (float)(2 * ii) / (float)dd);
        int pos;
        if (t < T) pos = ax == 0 ? LCTX : (ax == 1 ? (t >> 6) : (t & 63)); else pos = ax == 0 ? (t - T) : 0;
        const float ang = (float)pos * inv;
        const float rev = ang * 0.15915494309189535f;
        const float fr = rev - floorf(rev);
        const float s = __builtin_amdgcn_sinf(fr), c = __builtin_amdgcn_cosf(fr);
        if (t < T) { csL[i] = c; snL[i] = s; } else { csC[i - T * 128] = c; snC[i - T * 128] = s; }
    }
}
DI void mod_vectors(Frame& F, const float* cin, const float* cctx, const float* modw, const float* modb) {
    LAS float* sl = (LAS float*)(F.lds + RING_OFF);
    LAS float* red = sl + 9 * 1024;
    if (F.vcu >= 192) return;
    for (int i = F.tid; i < 9 * 1024; i += 512) { const float v = i < 8192 ? cin[i] : cctx[i - 8192]; sl[i] = siluf_(v); }
    __syncthreads();
    float* MOD = (float*)(F.ws + WS_MOD);
    for (int it = F.vcu; it < 192; it += F.G) {
        const int l = it / 96, cb = (it % 96) * 64;
        const float* w = modw + (size_t)l * 1024 * 6144 + cb + F.lane;
        float a[9];
#pragma unroll
        for (int b = 0; b < 9; ++b) a[b] = 0.f;
        const int k0 = F.wave * 128;
#pragma unroll 8
        for (int k = 0; k < 128; ++k) { const float wv = w[(size_t)(k0 + k) * 6144];
#pragma unroll
            for (int b = 0; b < 9; ++b) a[b] += sl[b * 1024 + k0 + k] * wv; }
#pragma unroll
        for (int b = 0; b < 9; ++b) red[(F.wave * 9 + b) * 64 + F.lane] = a[b];
        __syncthreads();
        for (int o = F.tid; o < 9 * 64; o += 512) { const int b = o >> 6, c = o & 63; float s = modb[l * 6144 + cb + c];
#pragma unroll
            for (int w8 = 0; w8 < 8; ++w8) s += red[(w8 * 9 + b) * 64 + c];
            MOD[(size_t)(l * 9 + b) * 6144 + cb + c] = s; }
        __syncthreads();
    }
}

DI void ld_row_f32(const float* p, int lane, float (&v)[16]) {
#pragma unroll
    for (int j = 0; j < 2; ++j) { const f32x4 a = *(const GAS f32x4*)(p + 512 * j + 8 * lane), b = *(const GAS f32x4*)(p + 512 * j + 8 * lane + 4);
#pragma unroll
        for (int e = 0; e < 4; ++e) { v[8 * j + e] = a[e]; v[8 * j + 4 + e] = b[e]; } }
}
DI void st_row_f32(float* p, int lane, const float (&v)[16]) {
#pragma unroll
    for (int j = 0; j < 2; ++j) { *(GAS f32x4*)(p + 512 * j + 8 * lane) = (f32x4){v[8 * j], v[8 * j + 1], v[8 * j + 2], v[8 * j + 3]}; *(GAS f32x4*)(p + 512 * j + 8 * lane + 4) = (f32x4){v[8 * j + 4], v[8 * j + 5], v[8 * j + 6], v[8 * j + 7]}; }
}
DI void ld_row_bf16(const bf16* p, int lane, float (&v)[16]) {
#pragma unroll
    for (int j = 0; j < 2; ++j) { const v4u a = *(const GAS v4u*)(p + 512 * j + 8 * lane);
        v[8 * j + 0] = bf_lo(a.x); v[8 * j + 1] = bf_hi(a.x); v[8 * j + 2] = bf_lo(a.y); v[8 * j + 3] = bf_hi(a.y); v[8 * j + 4] = bf_lo(a.z); v[8 * j + 5] = bf_hi(a.z); v[8 * j + 6] = bf_lo(a.w); v[8 * j + 7] = bf_hi(a.w); }
}
DI void ld_row_fp8(const unsigned char* p, int lane, float (&v)[16]) {
#pragma unroll
    for (int j = 0; j < 2; ++j) { const v2u a = *(const GAS v2u*)(p + 512 * j + 8 * lane);
        const f32x2 d0 = __builtin_amdgcn_cvt_pk_f32_fp8((int)a.x, false), d1 = __builtin_amdgcn_cvt_pk_f32_fp8((int)a.x, true), d2 = __builtin_amdgcn_cvt_pk_f32_fp8((int)a.y, false), d3 = __builtin_amdgcn_cvt_pk_f32_fp8((int)a.y, true);
        v[8 * j + 0] = d0[0]; v[8 * j + 1] = d0[1]; v[8 * j + 2] = d1[0]; v[8 * j + 3] = d1[1]; v[8 * j + 4] = d2[0]; v[8 * j + 5] = d2[1]; v[8 * j + 6] = d3[0]; v[8 * j + 7] = d3[1]; }
}
DI void st_row_bf16(bf16* p, int lane, const float (&v)[16]) {
#pragma unroll
    for (int j = 0; j < 2; ++j) st16(p + 512 * j + 8 * lane, cvt_pk_bf16(v[8 * j], v[8 * j + 1]), cvt_pk_bf16(v[8 * j + 2], v[8 * j + 3]), cvt_pk_bf16(v[8 * j + 4], v[8 * j + 5]), cvt_pk_bf16(v[8 * j + 6], v[8 * j + 7]));
}
DI int colx(int lane, int j) { return (lane >> 4) * 256 + (lane & 15) * 8 + 128 * j; }
DI void ld_rowx_f32(const float* p, int lane, float (&v)[16]) {
#pragma unroll
    for (int j = 0; j < 2; ++j) { const f32x4 a = *(const GAS f32x4*)(p + colx(lane, j)), b = *(const GAS f32x4*)(p + colx(lane, j) + 4);
#pragma unroll
        for (int e = 0; e < 4; ++e) { v[8 * j + e] = a[e]; v[8 * j + 4 + e] = b[e]; } }
}
DI void st_rowx_f32(float* p, int lane, const float (&v)[16]) {
#pragma unroll
    for (int j = 0; j < 2; ++j) { *(GAS f32x4*)(p + colx(lane, j)) = (f32x4){v[8 * j], v[8 * j + 1], v[8 * j + 2], v[8 * j + 3]}; *(GAS f32x4*)(p + colx(lane, j) + 4) = (f32x4){v[8 * j + 4], v[8 * j + 5], v[8 * j + 6], v[8 * j + 7]}; }
}
DI void st_rowx_bf16(bf16* p, int lane, const float (&v)[16]) {
#pragma unroll
    for (int j = 0; j < 2; ++j) st16(p + colx(lane, j), cvt_pk_bf16(v[8 * j], v[8 * j + 1]), cvt_pk_bf16(v[8 * j + 2], v[8 * j + 3]), cvt_pk_bf16(v[8 * j + 4], v[8 * j + 5]), cvt_pk_bf16(v[8 * j + 6], v[8 * j + 7]));
}
DI float row_sumsq(const float (&v)[16]) { float s = 0.f;
#pragma unroll
    for (int i = 0; i < 16; ++i) s += v[i] * v[i];
    return wave_sum(s); }
DI void norm_mod(const float (&x)[16], float rstd, const float* nw, const float* sh, const float* sc, int lane, float (&u)[16]) {
    float g[16], a[16], b[16]; ld_row_f32(nw, lane, g); ld_row_f32(sh, lane, a); ld_row_f32(sc, lane, b);
#pragma unroll
    for (int i = 0; i < 16; ++i) u[i] = x[i] * rstd * g[i] * (1.f + b[i]) + a[i];
}
DI void u_rows_layer0(Frame& F, bf16* U, const float* xin, const float* ctxin, const float* norms) {
    const int gw = F.vcu * 8 + F.wave, NGW = F.G * 8;
    const float* MOD = (const float*)(F.ws + WS_MOD);
    float av[16], bv[16]; int bcur = -1;
    float xn[16];
    if (gw < NTOK + NCTX) ld_row_f32(gw < NTOK ? xin + (size_t)gw * D : ctxin + (size_t)(gw - NTOK) * D, F.lane, xn);
    for (int m = gw; m < NTOK + NCTX; m += NGW) {
        const bool lat = m < NTOK; const int b = lat ? m / T : 8;
        float x[16], u[16];
#pragma unroll
        for (int i = 0; i < 16; ++i) x[i] = xn[i];
        const int mn = m + NGW;
        if (mn < NTOK + NCTX) ld_row_f32(mn < NTOK ? xin + (size_t)mn * D : ctxin + (size_t)(mn - NTOK) * D, F.lane, xn);
        if (b != bcur) {
            bcur = b; const float* mb = MOD + (size_t)b * 6144; float t1[16], t2[16];
            ld_row_f32(norms, F.lane, t1); ld_row_f32(mb + 1024, F.lane, t2); ld_row_f32(mb, F.lane, bv);
#pragma unroll
            for (int i = 0; i < 16; ++i) av[i] = t1[i] * (1.f + t2[i]);
        }
        const float rstd = rsqrtf(row_sumsq(x) * (1.f / D) + NORM_EPS);
#pragma unroll
        for (int i = 0; i < 16; ++i) u[i] = x[i] * rstd * av[i] + bv[i];
        st_row_bf16(U + (size_t)m * D, F.lane, u);
    }
}

#define MFMA32(a, b, c) __builtin_amdgcn_mfma_f32_32x32x16_bf16((a), (b), (c), 0, 0, 0)
#define MFMA16(a, b, c) __builtin_amdgcn_mfma_f32_16x16x32_bf16((a), (b), (c), 0, 0, 0)
DI int crow(int reg, int h5) { return (reg & 3) + 8 * (reg >> 2) + 4 * h5; }
DI float log2_gamma(const float* decay, int dir, int head) { const float x = decay[dir * NH + head]; return -log2f(1.f + expf(-x)); }

DI void retention_scores(Frame& F, const float* decay) {
    const bf16* Q = (const bf16*)(F.ws + WS_Q); const bf16* K = (const bf16*)(F.ws + WS_K); bf16* P = (bf16*)(F.ws + WS_P);
    const int lane = F.lane, r = lane & 31, h5 = lane >> 5;
    for (int unit = F.vcu; unit < NB * NH * NCHUNK; unit += F.G) {
        const int bh = unit >> 5, c = unit & 31, b = bh >> 2, head = bh & 3;
        const float lf = log2_gamma(decay, 0, head), lb = log2_gamma(decay, 1, head);
        bf16* Pt = P + (size_t)unit * CH * CH;
        {
            const bf16* kb = K + ((size_t)(b * NCHUNK + c) * NH + head) * 32768 + lane * 8;
            const bf16* qb = Q + ((size_t)(b * NCHUNK + c) * NH + head) * 32768;
            __syncthreads();
#pragma unroll
            for (int i = 0; i < 8; ++i) { const int pc = F.wave + 8 * i;
                __builtin_amdgcn_global_load_lds((const unsigned*)(kb + (size_t)pc * 512), (LAS unsigned*)(F.lds + RING_OFF + pc * 1024), 16, 0, 0);
                { const int qit = pc >> 4, qks = pc & 15;
                  __builtin_amdgcn_global_load_lds((const unsigned*)(qb + (size_t)(((2 * qit + (r >> 4)) * 8 + (qks >> 1)) * 64 + (r & 15) + 16 * (2 * (qks & 1) + h5)) * 8), (LAS unsigned*)(F.lds + RING_OFF + 65536 + pc * 1024), 16, 0, 0); } }
            VM_WAIT(); __syncthreads();
        }
#pragma unroll
        for (int tt = 0; tt < 2; ++tt) {
            const int tile = F.wave * 2 + tt, jt = tile >> 2, it = tile & 3;
            const LAS unsigned char* kp = F.lds + RING_OFF + (jt * 16) * 1024 + lane * 16;
            const LAS unsigned char* qp = F.lds + RING_OFF + 65536 + (it * 16) * 1024 + lane * 16;
            f32x16 acc;
#pragma unroll
            for (int i = 0; i < 16; ++i) acc[i] = 0.f;
#pragma unroll
            for (int s = 0; s < 16; ++s) { const bf16x8 a = *(const LAS bf16x8*)(kp + 1024 * s), bq = *(const LAS bf16x8*)(qp + 1024 * s); acc = MFMA32(a, bq, acc); }
            const int i = 32 * it + r;
#pragma unroll
            for (int g = 0; g < 4; ++g) {
                float o[4];
#pragma unroll
                for (int e = 0; e < 4; ++e) { const int j = 32 * jt + 8 * g + 4 * h5 + e; const int dd = i - j;
                    const float w = dd > 0 ? exp2f(lf * (float)dd) : (dd < 0 ? exp2f(lb * (float)(-dd)) : 2.f);
                    o[e] = acc[4 * g + e] * w; }
                v2u pk; pk.x = cvt_pk_bf16(o[0], o[1]); pk.y = cvt_pk_bf16(o[2], o[3]);
                *(GAS v2u*)(Pt + ((size_t)((2 * it + (r >> 4)) * 4 + jt) * 64 + (r & 15) + 16 * g) * 8 + 4 * h5) = pk;
            }
        }
    }
}

DI void dma16_untracked(const void* g, const LAS unsigned char* l) {
    const unsigned la = __builtin_amdgcn_readfirstlane((unsigned)(__UINTPTR_TYPE__)l);
    asm volatile("s_mov_b32 m0, %1\n\ts_nop 0\n\tglobal_load_lds_dwordx4 %0, off" :: "v"(g), "s"(la) : "memory", "m0");
}
constexpr size_t WS_SCANDUMP = 130 * MiB;
constexpr int KSLAB = 0, VPITCH = 192, SPITCH = 528;
constexpr int VIMG = 65536, VSIMG = VIMG + 128 * VPITCH, SIMG = VSIMG + 128 * VPITCH, SCAN_LDS_END = SIMG + 64 * SPITCH;
static_assert(SCAN_LDS_END <= LDSCTL_OFF, "scan LDS");
typedef LAS s16x4 lds_s16x4;
DI const LAS unsigned char* tr_lane_base(const LAS unsigned char* img, int pitch, int lane) {
    const int h5 = lane >> 5, blk = (lane >> 4) & 1, q = (lane & 15) >> 2, p = lane & 3;
    return img + (8 * h5 + q) * pitch + (16 * blk + 4 * p) * 2;
}
DI bf16x8 tr_frag(const LAS unsigned char* lane_base, int off, int pitch) {
    const s16x4 lo = __builtin_amdgcn_ds_read_tr16_b64_v4i16((lds_s16x4*)(lane_base + off));
    const s16x4 hi = __builtin_amdgcn_ds_read_tr16_b64_v4i16((lds_s16x4*)(lane_base + off + 4 * pitch));
    return __builtin_shufflevector(lo, hi, 0, 1, 2, 3, 4, 5, 6, 7);
}
#define WG_BAR() do { asm volatile("s_waitcnt lgkmcnt(0)" ::: "memory"); __builtin_amdgcn_s_barrier(); asm volatile("" ::: "memory"); } while (0)
DI void retention_scan(Frame& F, bf16* Opart, bf16* O, const float* decay, const int variant = 0) {
    const bf16* Qg = (const bf16*)(F.ws + WS_Q); const bf16* Kg = (const bf16*)(F.ws + WS_K); const bf16* Vg = (const bf16*)(F.ws + WS_V);
    const bf16* KCg = (const bf16*)(F.ws + WS_KC); const bf16* VCg = (const bf16*)(F.ws + WS_VC); const bf16* Pg = (const bf16*)(F.ws + WS_P);
    const int lane = F.lane, w = F.wave, tid = F.tid;
    const int it = w >> 1, et = w & 1;
    const LAS unsigned char* trK = tr_lane_base(F.lds + KSLAB + w * 8192, 64, lane);
    const LAS unsigned char* trV = tr_lane_base(F.lds + VIMG, VPITCH, lane);
    const LAS unsigned char* trVS = tr_lane_base(F.lds + VSIMG, VPITCH, lane);
    for (int unit = F.vcu; unit < NB * NH * 8; unit += F.G) {
        const int bh = unit >> 3, eb = unit & 7, b = bh >> 2, head = bh & 3;
        const int vcol = head * DV + eb * 64;
#pragma unroll
        for (int pass = 0; pass < 2; ++pass) {
            const bool fwd = pass == 1;
            const float l2g = log2_gamma(decay, fwd ? 0 : 1, head);
            const float gC = exp2f(l2g * (float)CH);
            f32x16 accS[2];
#pragma unroll
            for (int i = 0; i < 16; ++i) { accS[0][i] = 0.f; accS[1][i] = 0.f; }
            v4u vreg[2];
#define SCAN_SRC(s, kp, vp) do { if ((s) < 2) { const int cc = fwd ? (s) : 1 - (s); kp = KCg + ((size_t)(b * 2 + cc) * NH + head) * 32768; vp = VCg + ((size_t)b * LCTX + cc * CH) * 2048 + vcol; } \
                else { const int cc = fwd ? (s) - 2 : 33 - (s); kp = Kg + ((size_t)(b * NCHUNK + cc) * NH + head) * 32768; vp = Vg + ((size_t)b * T + cc * CH) * 2048 + vcol; } } while (0)
#define SCAN_LOADV(s) do { const bf16* kp_; const bf16* vp_; SCAN_SRC(s, kp_, vp_); (void)kp_; \
                _Pragma("unroll") for (int i = 0; i < 2; ++i) vreg[i] = *(const GAS v4u*)(vp_ + (size_t)((tid >> 3) + 64 * i) * 2048 + (tid & 7) * 8); } while (0)
#define SCAN_DMAK(s) do { const bf16* kp_; const bf16* vp_; SCAN_SRC(s, kp_, vp_); (void)vp_; \
                _Pragma("unroll") for (int i = 0; i < 8; ++i) dma16_untracked(kp_ + (unsigned)((((i >> 1) * 16 + 2 * w + ((lane & 3) >> 1)) * 64 + ((16 * i + (lane >> 2)) & 31) + 32 * (lane & 1)) * 8), \
                    F.lds + KSLAB + w * 8192 + i * 1024); } while (0)
            bf16x8 qf[8], pf[4];
            { int lane_ = lane, tid_ = tid; asm volatile("" : "+v"(lane_), "+v"(tid_));
              const int lane = lane_, tid = tid_; (void)lane; (void)tid;
              SCAN_LOADV(0); asm volatile("" : "+v"(vreg[0]), "+v"(vreg[1]));
              SCAN_DMAK(0); }
#pragma unroll 1
            for (int s = 0; s < 34; ++s) {
                int lz = lane, tz = tid; asm volatile("" : "+v"(lz), "+v"(tz));
                const int r = lz & 31, h5 = lz >> 5;
                const unsigned ooff = (unsigned)(4 * h5) * 2048u + (unsigned)r;
#pragma unroll
                for (int i = 0; i < 2; ++i) {
                    const int row = (tz >> 3) + 64 * i;
                    const float dec = exp2f(l2g * (float)(fwd ? (CH - 1 - row) : row));
                    const v4u x = vreg[i]; v4u o;
                    o.x = cvt_pk_bf16(bf_lo(x.x) * dec, bf_hi(x.x) * dec); o.y = cvt_pk_bf16(bf_lo(x.y) * dec, bf_hi(x.y) * dec);
                    o.z = cvt_pk_bf16(bf_lo(x.z) * dec, bf_hi(x.z) * dec); o.w = cvt_pk_bf16(bf_lo(x.w) * dec, bf_hi(x.w) * dec);
                    *(LAS v4u*)(F.lds + VIMG + row * VPITCH + (tz & 7) * 16) = x;
                    *(LAS v4u*)(F.lds + VSIMG + row * VPITCH + (tz & 7) * 16) = o;
                }
#pragma unroll
                for (int e2 = 0; e2 < 2; ++e2)
#pragma unroll
                    for (int g = 0; g < 4; ++g) { v2u pk; pk.x = cvt_pk_bf16(accS[e2][4 * g], accS[e2][4 * g + 1]); pk.y = cvt_pk_bf16(accS[e2][4 * g + 2], accS[e2][4 * g + 3]);
                        *(LAS v2u*)(F.lds + SIMG + (32 * e2 + r) * SPITCH + (32 * w + 8 * g + 4 * h5) * 2) = pk; }
                WG_BAR();
                unsigned opk[8];
#pragma unroll
                for (int i = 0; i < 8; ++i) opk[i] = 0u;
                if (s >= 2 && !(variant & 1)) {
                    f32x4 accO[4];
#pragma unroll
                    for (int mt = 0; mt < 4; ++mt) accO[mt] = (f32x4){0.f, 0.f, 0.f, 0.f};
                    {
                        const LAS unsigned char* sp_ = F.lds + SIMG + (lz & 15) * SPITCH + 16 * (lz >> 4);
                        bf16x8 sb[2][4];
#pragma unroll
                        for (int mt = 0; mt < 4; ++mt) sb[0][mt] = *(const LAS bf16x8*)(sp_ + 16 * mt * SPITCH);
#pragma unroll
                        for (int ks = 0; ks < 8; ++ks) {
                            if (ks < 7) {
#pragma unroll
                                for (int mt = 0; mt < 4; ++mt) sb[(ks + 1) & 1][mt] = *(const LAS bf16x8*)(sp_ + 16 * mt * SPITCH + 64 * (ks + 1)); }
                            __builtin_amdgcn_sched_barrier(0);
#pragma unroll
                            for (int mt = 0; mt < 4; ++mt) accO[mt] = MFMA16(sb[ks & 1][mt], qf[ks], accO[mt]);
                            __builtin_amdgcn_sched_barrier(0);
                        }
                    }
                    {
                        const int il = 16 * w + (lz & 15);
                        const float qd = exp2f(l2g * (float)(fwd ? il + 1 : CH - il));
#pragma unroll
                        for (int mt = 0; mt < 4; ++mt) accO[mt] *= qd;
                    }
                    if (fwd) {
                        const LAS unsigned char* vp_ = F.lds + VIMG + (8 * (lz >> 4) + ((lz & 15) >> 2)) * VPITCH + 8 * (lz & 3);
                        bf16x8 vb[2][4];
#pragma unroll
                        for (int mt = 0; mt < 4; ++mt) vb[0][mt] = tr_frag(vp_, 32 * mt, VPITCH);
#pragma unroll
                        for (int ks = 0; ks < 4; ++ks) {
                            if (ks < 3) {
#pragma unroll
                                for (int mt = 0; mt < 4; ++mt) vb[(ks + 1) & 1][mt] = tr_frag(vp_, 32 * (ks + 1) * VPITCH + 32 * mt, VPITCH); }
                            __builtin_amdgcn_sched_barrier(0);
#pragma unroll
                            for (int mt = 0; mt < 4; ++mt) accO[mt] = MFMA16(vb[ks & 1][mt], pf[ks], accO[mt]);
                            __builtin_amdgcn_sched_barrier(0);
                        }
                    }
#pragma unroll
                    for (int mt = 0; mt < 4; ++mt) { opk[2 * mt] = cvt_pk_bf16(accO[mt][0], accO[mt][1]); opk[2 * mt + 1] = cvt_pk_bf16(accO[mt][2], accO[mt][3]); }
                }
                {
                    const int sn = s + 1 < 34 ? s + 1 : 33;
                    const bf16* kp_; const bf16* vp_; SCAN_SRC(sn, kp_, vp_); (void)kp_;
#pragma unroll
                    for (int i = 0; i < 2; ++i) vreg[i] = *(const GAS v4u*)(vp_ + (unsigned)(((tz >> 3) + 64 * i) * 2048 + (tz & 7) * 8));
                    const int cq = sn >= 2 ? (fwd ? sn - 2 : 33 - sn) : (fwd ? 0 : 31);
                    const bf16* qn = Qg + ((((size_t)(b * NCHUNK + cq) * NH + head) * 8 + w) * 8) * 512;
                    const unsigned qoff = (unsigned)lz * 8u;
#pragma unroll
                    for (int ks = 0; ks < 8; ++ks) qf[ks] = *(const GAS bf16x8*)(qn + qoff + 512 * ks);
                    if (fwd) {
                        const bf16* pn = Pg + ((size_t)(bh * NCHUNK + cq) * CH * CH) + (size_t)(w * 4) * 512;
#pragma unroll
                        for (int ks = 0; ks < 4; ++ks) pf[ks] = *(const GAS bf16x8*)(pn + qoff + 512 * ks);
                    }
                }
                if (s == 0) { if (fwd) asm volatile("s_waitcnt vmcnt(14)" ::: "memory"); else asm volatile("s_waitcnt vmcnt(10)" ::: "memory"); }
                else { if (fwd) asm volatile("s_waitcnt vmcnt(18)" ::: "memory"); else asm volatile("s_waitcnt vmcnt(14)" ::: "memory"); }
#pragma unroll
                for (int i = 0; i < 16; ++i) { accS[0][i] *= gC; accS[1][i] *= gC; }
                if (!(variant & 2))
                {
                    bf16x8 ua[2], ub0[2], ub1[2];
                    ua[0] = tr_frag(trK, 0, 64); ub0[0] = tr_frag(trVS, 0, VPITCH); ub1[0] = tr_frag(trVS, 64, VPITCH);
#pragma unroll
                    for (int ks = 0; ks < 8; ++ks) {
                        if (ks < 7) { ua[(ks + 1) & 1] = tr_frag(trK, 16 * (ks + 1) * 64, 64); ub0[(ks + 1) & 1] = tr_frag(trVS, 16 * (ks + 1) * VPITCH, VPITCH); ub1[(ks + 1) & 1] = tr_frag(trVS, 16 * (ks + 1) * VPITCH + 64, VPITCH); }
                        __builtin_amdgcn_sched_barrier(0);
                        accS[0] = MFMA32(ua[ks & 1], ub0[ks & 1], accS[0]); accS[1] = MFMA32(ua[ks & 1], ub1[ks & 1], accS[1]);
                        __builtin_amdgcn_sched_barrier(0);
                    }
                }
                asm volatile("s_waitcnt lgkmcnt(0)" ::: "memory");
                {
                    const int sn = s + 1 < 34 ? s + 1 : 33;
                    const bf16* kp_; const bf16* vp_; SCAN_SRC(sn, kp_, vp_); (void)vp_;
#pragma unroll
                    for (int i = 0; i < 8; ++i) dma16_untracked(kp_ + (unsigned)((((i >> 1) * 16 + 2 * w + ((lz & 3) >> 1)) * 64 + ((16 * i + (lz >> 2)) & 31) + 32 * (lz & 1)) * 8), F.lds + KSLAB + w * 8192 + i * 1024); }
                {
                    const int cc = fwd ? s - 2 : 33 - s;
                    const size_t obase = ((size_t)b * T + cc * CH + 16 * w) * 2048 + vcol;
                    GAS unsigned char* dstp = s >= 2 ? (GAS unsigned char*)((fwd ? O : Opart) + obase) : (GAS unsigned char*)(F.ws + WS_SCANDUMP) + (size_t)(16 * w) * 4096;
                    const unsigned so = (unsigned)(lz & 15) * 4096u + (unsigned)(lz >> 4) * 8u;
#pragma unroll
                    for (int mt = 0; mt < 4; ++mt) *(GAS v2u*)(dstp + so + 32 * mt) = (v2u){opk[2 * mt], opk[2 * mt + 1]};
                }
                WG_BAR();
            }
#undef SCAN_SRC
#undef SCAN_LOADV
#undef SCAN_DMAK
            VM_WAIT(); __syncthreads();
        }
    }
}
DI void gn_gate_rows(Frame& F, bf16* O, const bf16* G, const bf16* OP) {
    const int gw = F.vcu * 8 + F.wave, NGW = F.G * 8;
    v4u an[4], gn[4], pn[4];
    if (gw < NTOK) {
#pragma unroll
        for (int j = 0; j < 4; ++j) { an[j] = *(const GAS v4u*)(O + (size_t)gw * VTOT + 512 * j + 8 * F.lane); pn[j] = *(const GAS v4u*)(OP + (size_t)gw * VTOT + 512 * j + 8 * F.lane); gn[j] = *(const GAS v4u*)(G + (size_t)gw * VTOT + 512 * j + 8 * F.lane); } }
    for (int m = gw; m < NTOK; m += NGW) {
        bf16* op = O + (size_t)m * VTOT;
        v4u ac[4], gc[4], pc[4];
#pragma unroll
        for (int j = 0; j < 4; ++j) { ac[j] = an[j]; gc[j] = gn[j]; pc[j] = pn[j]; }
        const int mn = m + NGW;
        if (mn < NTOK) {
#pragma unroll
            for (int j = 0; j < 4; ++j) { an[j] = *(const GAS v4u*)(O + (size_t)mn * VTOT + 512 * j + 8 * F.lane); pn[j] = *(const GAS v4u*)(OP + (size_t)mn * VTOT + 512 * j + 8 * F.lane); gn[j] = *(const GAS v4u*)(G + (size_t)mn * VTOT + 512 * j + 8 * F.lane); } }
#pragma unroll
        for (int j = 0; j < 4; ++j) {
            const v4u a = ac[j], g = gc[j], q = pc[j];
            float v[8] = {bf_lo(a.x) + bf_lo(q.x), bf_hi(a.x) + bf_hi(q.x), bf_lo(a.y) + bf_lo(q.y), bf_hi(a.y) + bf_hi(q.y), bf_lo(a.z) + bf_lo(q.z), bf_hi(a.z) + bf_hi(q.z), bf_lo(a.w) + bf_lo(q.w), bf_hi(a.w) + bf_hi(q.w)};
            const float gg[8] = {bf_lo(g.x), bf_hi(g.x), bf_lo(g.y), bf_hi(g.y), bf_lo(g.z), bf_hi(g.z), bf_lo(g.w), bf_hi(g.w)};
            float ss = 0.f;
#pragma unroll
            for (int e = 0; e < 8; ++e) ss += v[e] * v[e];
            const float rstd = rsqrtf(wave_sum(ss) * (1.f / DV) + NORM_EPS);
#pragma unroll
            for (int e = 0; e < 8; ++e) v[e] = v[e] * rstd * gg[e];
            st16(op + 512 * j + 8 * F.lane, cvt_pk_bf16(v[0], v[1]), cvt_pk_bf16(v[2], v[3]), cvt_pk_bf16(v[4], v[5]), cvt_pk_bf16(v[6], v[7]));
        }
    }
}
constexpr size_t WS_WPRIME = 156 * MiB, WS_CPART = WS_MOD + 1 * MiB;
DI void router_prescale(Frame& F, const float* norms, const float* router) {
    const float* MOD = (const float*)(F.ws + WS_MOD);
    bf16* WP = (bf16*)(F.ws + WS_WPRIME); float* CP = (float*)(F.ws + WS_CPART);
    const int gt = F.vcu * 512 + F.tid, NT = F.G * 512;
    for (int i = gt; i < 2 * NB * D * NE; i += NT) {
        const int e = i & 63, k = (i >> 6) & 1023, b = (i >> 16) & 7, l = i >> 19;
        const float v = norms[(l * 4 + 2) * D + k] * (1.f + MOD[(size_t)(l * 9 + b) * 6144 + 4 * D + k]) * router[((size_t)l * D + k) * NE + e];
        const bf16 hi = f2bf(v), lo = f2bf(v - bf2f(hi));
        const size_t o = (size_t)(l * NB + b) * 131072 + ((size_t)((e >> 5) * 64 + (k >> 4)) * 64 + (e & 31) + 32 * ((k >> 3) & 1)) * 8 + (k & 7);
        WP[o] = hi; WP[o + 65536] = lo;
    }
    const int gw = F.vcu * 8 + F.wave, NGW = F.G * 8;
    for (int t = gw; t < 2 * NB * 16; t += NGW) {
        const int ch = t & 15, b = (t >> 4) & 7, l = t >> 7;
        float a = 0.f;
#pragma unroll 8
        for (int kk = 0; kk < 64; ++kk) { const int k = ch * 64 + kk; a += MOD[(size_t)(l * 9 + b) * 6144 + 3 * D + k] * router[((size_t)l * D + k) * NE + F.lane]; }
        CP[(size_t)t * 64 + F.lane] = a;
    }
}
DI void rows_router(Frame& F, int layer, const float* hin, const bf16* Y, bf16* U, const float* norms, const float* mbias, float* hout, const int variant = 0, const int cl = 0) {
    const float* MOD = (const float*)(F.ws + WS_MOD) + (size_t)layer * 9 * 6144;
    const float* nrm = norms + (size_t)layer * 4 * D;
    constexpr int UP = 2064;
    LAS unsigned char* uhi = F.lds + RING_OFF; LAS unsigned char* ulo = uhi + 32 * UP;
    LAS float* plg = (LAS float*)uhi;
    LAS float* rstdl = (LAS float*)(ulo + 32 * UP);
    LAS int* bcnt = (LAS int*)(rstdl + 32); LAS int* bbase = bcnt + 64;
    LAS int* park = bbase + 64;
    const int lane = F.lane, w = F.wave;
    const float mybias = mbias[layer * NE + lane];
    unsigned char* lb = F.ws + WS_LIST;
    if (F.tid < 64) bcnt[F.tid] = 0;
    int nblk = 0;
    float yA[16], hA[16], yB[16], hB[16];
    if (F.vcu < NTOK / 32 && !(variant & 1)) { const int mf = F.vcu * 32 + w * 4;
        ld_row_bf16(Y + (size_t)mf * D, lane, yA); ld_row_f32(hin + (size_t)mf * D, lane, hA); ld_row_bf16(Y + (size_t)(mf + 1) * D, lane, yB); ld_row_f32(hin + (size_t)(mf + 1) * D, lane, hB); }
    for (int blk = F.vcu; blk < NTOK / 32; blk += F.G, ++nblk) {
        const int m0 = blk * 32, b = m0 / T;
        const float* mb = MOD + (size_t)b * 6144;
        float csum = 0.f;
        { const float* cp = (const float*)(F.ws + WS_CPART) + (size_t)((layer * NB + b) * 16) * 64 + lane;
#pragma unroll
          for (int ch = 0; ch < 16; ++ch) csum += cp[ch * 64]; }
        if (!(variant & 1)) {
            float gg[16], av[16], bv[16];
            { float t1[16], t2[16]; ld_row_f32(nrm + D, lane, t1); ld_row_f32(mb + 2 * D, lane, t2);
#pragma unroll
              for (int i = 0; i < 16; ++i) gg[i] = t1[i] * t2[i];
              ld_row_f32(nrm + 2 * D, lane, t1); ld_row_f32(mb + 4 * D, lane, t2); ld_row_f32(mb + 3 * D, lane, bv);
#pragma unroll
              for (int i = 0; i < 16; ++i) av[i] = t1[i] * (1.f + t2[i]); }
            const int mnext = (blk + F.G) * 32;
            const bool hasnext = blk + F.G < NTOK / 32;
#pragma unroll
            for (int rr = 0; rr < 4; ++rr) {
                const int rl = w * 4 + rr, m = m0 + rl;
                float y[16], h[16], u[16];
#pragma unroll
                for (int i = 0; i < 16; ++i) { y[i] = (rr & 1) ? yB[i] : yA[i]; h[i] = (rr & 1) ? hB[i] : hA[i]; }
                {
                    const int mr = rr < 2 ? m + 2 : mnext + w * 4 + (rr - 2);
                    if (rr < 2 || hasnext) {
                        if (rr & 1) { ld_row_bf16(Y + (size_t)mr * D, lane, yB); ld_row_f32(hin + (size_t)mr * D, lane, hB); }
                        else        { ld_row_bf16(Y + (size_t)mr * D, lane, yA); ld_row_f32(hin + (size_t)mr * D, lane, hA); }
                    }
                }
                const float rs1 = rsqrtf(row_sumsq(y) * (1.f / D) + NORM_EPS);
#pragma unroll
                for (int i = 0; i < 16; ++i) h[i] += gg[i] * (y[i] * rs1);
                st_row_f32(hout + (size_t)m * D, lane, h);
                const float rs2 = rsqrtf(row_sumsq(h) * (1.f / D) + NORM_EPS);
#pragma unroll
                for (int i = 0; i < 16; ++i) u[i] = h[i] * rs2 * av[i] + bv[i];
                st_row_bf16(U + (size_t)m * D, lane, u);
#pragma unroll
                for (int j = 0; j < 2; ++j) {
                    unsigned hh[4], ll[4];
#pragma unroll
                    for (int e = 0; e < 4; ++e) { const float x0 = h[8 * j + 2 * e], x1 = h[8 * j + 2 * e + 1]; const unsigned ph = cvt_pk_bf16(x0, x1); hh[e] = ph; ll[e] = cvt_pk_bf16(x0 - bf_lo(ph), x1 - bf_hi(ph)); }
                    *(LAS v4u*)(uhi + rl * UP + (512 * j + 8 * lane) * 2) = (v4u){hh[0], hh[1], hh[2], hh[3]};
                    *(LAS v4u*)(ulo + rl * UP + (512 * j + 8 * lane) * 2) = (v4u){ll[0], ll[1], ll[2], ll[3]};
                }
                if (lane == 0) rstdl[rl] = rs2;
            }
        }
        __syncthreads();
        if (!(variant & 2)) {
            const int kq = w >> 1, et = w & 1, r = lane & 31, h5 = lane >> 5;
            const bf16* wph = (const bf16*)(F.ws + WS_WPRIME) + (size_t)(layer * NB + b) * 131072 + ((size_t)(et * 64 + 16 * kq) * 64 + lane) * 8;
            f32x16 acc;
#pragma unroll
            for (int i = 0; i < 16; ++i) acc[i] = 0.f;
            bf16x8 bh[16], bl[16];
#pragma unroll
            for (int ks = 0; ks < 16; ++ks) { bh[ks] = *(const GAS bf16x8*)(wph + 512 * ks); bl[ks] = *(const GAS bf16x8*)(wph + 65536 + 512 * ks); }
            __builtin_amdgcn_sched_barrier(0);
#pragma unroll
            for (int ks = 0; ks < 16; ++ks) {
                const bf16x8 ah = *(const LAS bf16x8*)(uhi + r * UP + (256 * kq + 16 * ks + 8 * h5) * 2), al = *(const LAS bf16x8*)(ulo + r * UP + (256 * kq + 16 * ks + 8 * h5) * 2);
                acc = MFMA32(ah, bh[ks], acc); acc = MFMA32(ah, bl[ks], acc); acc = MFMA32(al, bh[ks], acc);
            }
            __syncthreads();
#pragma unroll
            for (int i = 0; i < 16; ++i) plg[(kq * 32 + crow(i, h5)) * 65 + 32 * et + r] = acc[i];
        }
        __syncthreads();
        int lc = lane; asm volatile("" : "+v"(lc));
        float wgt[4]; int ksl[4], ipos[4];
#pragma unroll
        for (int rr = 0; rr < 4; ++rr) { ksl[rr] = -1; wgt[rr] = 0.f; ipos[rr] = 0; }
        if (!(variant & 4))
#pragma unroll
        for (int rr = 0; rr < 4; ++rr) {
            const int rl = w * 4 + rr;
            const float lg = rstdl[rl] * (plg[rl * 65 + lc] + plg[(32 + rl) * 65 + lc] + plg[(64 + rl) * 65 + lc] + plg[(96 + rl) * 65 + lc]) + csum;
            const float sc = sigmoidf_(lg), bs = sc + mybias;
            const float NINF = -__builtin_inff();
            const float m1 = grp8_max(bs);
            const bool ism = bs == m1;
            const float nm = grp8_sum(ism ? 1.f : 0.f);
            const float rest = grp8_max(ism ? NINF : bs);
            const float gs = m1 + (nm >= 2.f ? m1 : rest);
            int grk = 0; const int grp = lc >> 3;
#pragma unroll
            for (int g = 0; g < 8; ++g) { const float o = __builtin_bit_cast(float, __builtin_amdgcn_readlane(__builtin_bit_cast(int, gs), 8 * g)); grk += (o > gs || (o == gs && g < grp)) ? 1 : 0; }
            const bool gsel = grk < 4;
            float cur = gsel ? bs : NINF;
            bool sel = false;
#pragma unroll
            for (int t8 = 0; t8 < TOPK; ++t8) {
                const float mx = wave_max(cur);
                const unsigned long long eq = __builtin_amdgcn_ballot_w64(cur == mx);
                const int first = __builtin_ctzll(eq);
                const bool isf = lc == first;
                sel = sel || isf; cur = isf ? NINF : cur;
            }
            const float ssum = wave_sum(sel ? sc : 0.f);
            const unsigned long long bal = __ballot(sel);
            ksl[rr] = sel ? __popcll(bal & ((1ull << lc) - 1ull)) : -1;
            wgt[rr] = sc / ssum * 2.5f;
            ipos[rr] = sel ? __hip_atomic_fetch_add(bcnt + lc, 1, __ATOMIC_RELAXED, __HIP_MEMORY_SCOPE_WORKGROUP) : 0;
        }
#pragma unroll
        for (int rr = 0; rr < 4; ++rr) if (ksl[rr] >= 0) { const int pi = ((nblk * 32 + w * 4 + rr) * 8 + ksl[rr]) * 2; park[pi] = lc | (ipos[rr] << 8); park[pi + 1] = __builtin_bit_cast(int, wgt[rr]); }
        __syncthreads();
    }
    if (w == 0) { const int n = bcnt[lane]; bbase[lane] = n ? (int)atomicAdd(F.ctl + cnt_word(layer + cl, 0, lane), (unsigned)n) : 0; }
    __syncthreads();
    for (int k = 0; k < nblk; ++k) {
        const int m0 = (F.vcu + k * F.G) * 32;
#pragma unroll 1
        for (int rr = 0; rr < 4; ++rr) {
            const int m = m0 + w * 4 + rr;
            if (lane < 8) {
                const int pi = ((k * 32 + w * 4 + rr) * 8 + lane) * 2; const int pe = park[pi]; const float wv = __builtin_bit_cast(float, park[pi + 1]);
                const int e = pe & 0xff, pos = bbase[e] + (pe >> 8);
                ((int*)lb)[(size_t)e * ECAP + pos] = m;
                ((int*)(lb + LIST_ARR))[m * 8 + lane] = (e << 16) | pos; ((float*)(lb + 2 * LIST_ARR))[m * 8 + lane] = wv;
            }
            if (lane == 0) ((int*)lb)[(size_t)NE * ECAP + m] = m;
        }
    }
    __syncthreads();
}

DI void moe_tables(Frame& F, int layer, int slice) {
    LAS int* cum = (LAS int*)(F.lds + LDSCTL_OFF); LAS int* cnt = (LAS int*)(F.lds + LDSCTL_OFF + 272); LAS int* rb = (LAS int*)(F.lds + LDSCTL_OFF + 544);
    __syncthreads();
    if (F.wave == 0) {
        const int lane = F.lane;
        const int n = (int)__hip_atomic_load(F.ctl + cnt_word(layer, slice, lane), RLX_AGENT);
        int pb = (n + 255) >> 8, pr = n;
#pragma unroll
        for (int d = 1; d < 64; d <<= 1) {
            const int ob = __builtin_amdgcn_ds_bpermute((lane - d) << 2, pb), orr = __builtin_amdgcn_ds_bpermute((lane - d) << 2, pr);
            if (lane >= d) { pb += ob; pr += orr; }
        }
        cnt[lane] = n; cum[lane] = pb - ((n + 255) >> 8); rb[lane] = pr - n;
        if (lane == 63) { cnt[NE] = SLTOK; cum[NE] = pb; rb[NE] = pr; cum[NEX] = pb + ((SLTOK + 255) >> 8); rb[NEX] = pr + SLTOK; }
    }
    __syncthreads();
    {
        LAS unsigned char* eob = (LAS unsigned char*)(F.lds + LDSCTL_OFF + 1536); const int nb = cum[NEX];
        for (int blk = F.tid; blk < nb; blk += 512) { int e = 0, hi_ = NEX;
#pragma unroll
            for (int it = 0; it < 7; ++it) { const int mid = (e + hi_) >> 1; if (cum[mid] <= blk) e = mid; else hi_ = mid; }
            eob[blk] = (unsigned char)e; }
    }
    __syncthreads();
}
DI void moe_gemm1(Frame& F, int layer, int slice) {
    moe_tables(F, layer, slice);
    const LAS int* cum = (const LAS int*)(F.lds + LDSCTL_OFF); const LAS int* cnt = (const LAS int*)(F.lds + LDSCTL_OFF + 272); const LAS int* rb = (const LAS int*)(F.lds + LDSCTL_OFF + 544);
    unsigned char* lb = F.ws + WS_LIST + (size_t)slice * LIST_SLICE;
    pg8::Gemm g{(const bf16*)(F.ws + WS_U), (const bf16*)(F.ws + WS_W13), 1024};
    MoeOrder S{cum, cnt, rb, (const LAS unsigned char*)(F.lds + LDSCTL_OFF + 1536), (const int*)lb, 2, F.G, F.vcu, cum[NEX] * 2};
    EpiSwiGLU E{(bf16*)(F.ws + WS_ACT)};
    pg8::gemm_phase<EpiSwiGLU, MoeOrder, true>(F.lds + RING_OFF, g, S, E, F.tid, STAG_G1);
}
DI void moe_gemm2(Frame& F, int layer, int slice, int nostore = 0) {
    moe_tables(F, layer, slice);
    const LAS int* cum = (const LAS int*)(F.lds + LDSCTL_OFF); const LAS int* cnt = (const LAS int*)(F.lds + LDSCTL_OFF + 272); const LAS int* rb = (const LAS int*)(F.lds + LDSCTL_OFF + 544);
    pg8::Gemm g{(const bf16*)(F.ws + WS_ACT), (const bf16*)(F.ws + WS_W2), 256};
    MoeOrder S{cum, cnt, rb, (const LAS unsigned char*)(F.lds + LDSCTL_OFF + 1536), nullptr, 4, F.G, F.vcu, cum[NEX] * 4};
    EpiMoeOut E{F.ws + WS_Y2, nostore};
    pg8::gemm_phase<EpiMoeOut, MoeOrder, false>(F.lds + RING_OFF, g, S, E, F.tid, STAG_G2);
}
DI void moe_combine(Frame& F, int layer, int slice, bool last_layer, const float* norms) {
    moe_tables(F, layer, slice);
    const LAS int* rb = (const LAS int*)(F.lds + LDSCTL_OFF + 544);
    const int gw = F.vcu * 8 + F.wave, NGW = F.G * 8, lane = F.lane;
    const float* MOD = (const float*)(F.ws + WS_MOD);
    const unsigned char* Y2 = F.ws + WS_Y2; bf16* U = (bf16*)(F.ws + WS_UC);
    const unsigned char* lb = F.ws + WS_LIST + (size_t)slice * LIST_SLICE;
    const int* slot = (const int*)(lb + LIST_ARR); const float* wts = (const float*)(lb + 2 * LIST_ARR);
    float g3[16]; ld_rowx_f32(norms + (size_t)(layer * 4 + 3) * D, lane, g3);
    for (int ml0 = gw; ml0 < SLTOK; ml0 += 2 * NGW) {
        int lz = F.lane; asm volatile("" : "+v"(lz));
        int mm[2]; v4u rw[2][9]; float wk[2][8];
#pragma unroll
        for (int t = 0; t < 2; ++t) {
            const int ml = ml0 + t * NGW; mm[t] = ml < SLTOK ? ml : ml0;
            const int sv = slot[mm[t] * 8 + (lz & 7)]; const float wv = wts[mm[t] * 8 + (lz & 7)];
            const int myrow = rb[sv >> 16] + (sv & 0xffff);
#pragma unroll
            for (int k = 0; k < 8; ++k) { const int row = __builtin_amdgcn_readlane(myrow, k); wk[t][k] = __builtin_bit_cast(float, __builtin_amdgcn_readlane(__builtin_bit_cast(int, wv), k));
                rw[t][k] = *(const GAS v4u*)(Y2 + (size_t)row * D + (unsigned)(16 * lz)); }
            rw[t][8] = *(const GAS v4u*)(Y2 + ((size_t)SLTOK * 8 + mm[t]) * D + 16 * lz);
        }
        float o[2][16];
#pragma unroll
        for (int t = 0; t < 2; ++t) {
#pragma unroll
            for (int i = 0; i < 16; ++i) o[t][i] = 0.f;
#pragma unroll
            for (int k = 0; k < 9; ++k) { const float w = k < 8 ? wk[t][k < 8 ? k : 0] : 1.f;
#pragma unroll
                for (int j = 0; j < 2; ++j) { v2u a; a.x = j ? rw[t][k].z : rw[t][k].x; a.y = j ? rw[t][k].w : rw[t][k].y;
                    const f32x2 d0 = __builtin_amdgcn_cvt_pk_f32_fp8((int)a.x, false), d1 = __builtin_amdgcn_cvt_pk_f32_fp8((int)a.x, true), d2 = __builtin_amdgcn_cvt_pk_f32_fp8((int)a.y, false), d3 = __builtin_amdgcn_cvt_pk_f32_fp8((int)a.y, true);
                    o[t][8 * j + 0] += w * d0[0]; o[t][8 * j + 1] += w * d0[1]; o[t][8 * j + 2] += w * d1[0]; o[t][8 * j + 3] += w * d1[1]; o[t][8 * j + 4] += w * d2[0]; o[t][8 * j + 5] += w * d2[1]; o[t][8 * j + 6] += w * d3[0]; o[t][8 * j + 7] += w * d3[1]; } }
        }
        float h[2][16], gf[2][16];
#pragma unroll
        for (int t = 0; t < 2; ++t) { const int m = slice * SLTOK + mm[t]; ld_rowx_f32(F.out + (size_t)m * D, lz, h[t]); ld_rowx_f32(MOD + ((size_t)(layer * 9 + m / T)) * 6144 + 5 * D, lz, gf[t]); }
#pragma unroll
        for (int t = 0; t < 2; ++t) {
            if (ml0 + t * NGW >= SLTOK) break;
            const int m = slice * SLTOK + mm[t], b = m / T;
            const float rs = rsqrtf(row_sumsq(o[t]) * (1.f / D) + NORM_EPS);
#pragma unroll
            for (int i = 0; i < 16; ++i) h[t][i] += gf[t][i] * (o[t][i] * rs * g3[i]);
            st_rowx_f32(F.out + (size_t)m * D, lz, h[t]);
            if (!last_layer) {
                const float rs2 = rsqrtf(row_sumsq(h[t]) * (1.f / D) + NORM_EPS);
                const float* mb = MOD + ((size_t)((layer + 1) * 9 + b)) * 6144;
                float u[16], ng[16], na[16], nb[16]; ld_rowx_f32(norms + (size_t)((layer + 1) * 4) * D, lz, ng); ld_rowx_f32(mb, lz, na); ld_rowx_f32(mb + D, lz, nb);
#pragma unroll
                for (int i = 0; i < 16; ++i) u[i] = h[t][i] * rs2 * ng[i] * (1.f + nb[i]) + na[i];
                st_rowx_bf16(U + (size_t)m * D, lz, u);
            }
        }
    }
}

DI void dwconv_ln(Frame& F, const bf16* Z, bf16* C, const float* dw, const float* bdwp, const float* lngp, const float* lnbp) {
    LAS float* red = (LAS float*)(F.lds + RING_OFF);
    LAS float* tot = red + 32 * 528;
    const int tid = F.tid, c0 = 2 * tid;
    const f32x2 bdw = *(const GAS f32x2*)(bdwp + c0), lg = *(const GAS f32x2*)(lngp + c0), lb = *(const GAS f32x2*)(lnbp + c0);
    f32x2 kk[31];
#pragma unroll
    for (int w = 0; w < 31; ++w) kk[w] = *(const GAS f32x2*)(dw + w * D + c0);
    for (int run = F.vcu; run < NTOK / 128; run += F.G) {
        const int mrun = run * 128, trun = mrun & (T - 1);
        f32x2 zz[46]; unsigned zn[16];
        { unsigned z[46];
#pragma unroll
          for (int i = 0; i < 46; ++i) { const int t = trun - 15 + i; z[i] = (t >= 0 && t < T) ? *(const GAS unsigned*)(Z + (size_t)(mrun - 15 + i) * D + c0) : 0u; }
#pragma unroll
          for (int i = 0; i < 46; ++i) zz[i] = (f32x2){bf_lo(z[i]), bf_hi(z[i])}; }
#pragma unroll 1
        for (int j = 0; j < 8; ++j) {
            const int m0 = mrun + 16 * j, t0 = trun + 16 * j;
            if (j + 1 < 8) {
#pragma unroll
                for (int i = 0; i < 16; ++i) { const int t = t0 + 31 + i; zn[i] = (t < T) ? *(const GAS unsigned*)(Z + (size_t)(m0 + 31 + i) * D + c0) : 0u; }
            }
            f32x2 acc2[16];
#pragma unroll
            for (int i = 0; i < 16; ++i) acc2[i] = bdw;
#pragma unroll
            for (int w = 0; w < 31; ++w)
#pragma unroll
                for (int i = 0; i < 16; ++i) acc2[i] = __builtin_elementwise_fma(zz[i + w], kk[w], acc2[i]);
            __syncthreads();
#pragma unroll
            for (int i = 0; i < 16; ++i) { red[i * 528 + tid] = acc2[i][0] + acc2[i][1]; red[(16 + i) * 528 + tid] = acc2[i][0] * acc2[i][0] + acc2[i][1] * acc2[i][1]; }
            __syncthreads();
            { const int tk = tid >> 5, which = (tid >> 4) & 1, pp = tid & 15; float acc_ = 0.f;
              const LAS float* rp = red + (which * 16 + tk) * 528 + pp;
#pragma unroll
              for (int k = 0; k < 32; ++k) acc_ += rp[16 * k];
              acc_ += lane_xor(acc_, tid & 63, 1); acc_ += lane_xor(acc_, tid & 63, 2); acc_ += lane_xor(acc_, tid & 63, 4); acc_ += lane_xor(acc_, tid & 63, 8);
              const float oth = lane_xor(acc_, tid & 63, 16);
              if ((tid & 31) == 0) { const float mu = acc_ * (1.f / D), var = oth * (1.f / D) - mu * mu; tot[2 * tk] = mu; tot[2 * tk + 1] = rsqrtf(fmaxf(var, 0.f) + LN_EPS); } }
            __syncthreads();
#pragma unroll
            for (int i = 0; i < 16; ++i) {
                const float mu = tot[2 * i], rstd = tot[2 * i + 1];
                const float v0 = (acc2[i][0] - mu) * rstd * lg[0] + lb[0], v1 = (acc2[i][1] - mu) * rstd * lg[1] + lb[1];
                *(GAS unsigned*)(C + (size_t)(m0 + i) * D + c0) = cvt_pk_bf16(siluf_(v0), siluf_(v1));
            }
#pragma unroll
            for (int i = 0; i < 30; ++i) zz[i] = zz[i + 16];
#pragma unroll
            for (int i = 0; i < 16; ++i) zz[30 + i] = (f32x2){bf_lo(zn[i]), bf_hi(zn[i])};
        }
    }
}

constexpr int N_PHASES = 18;
struct Args { const float* in[26]; float* out; unsigned char* ws; int ph_lo, ph_hi; };
#define INP(i) ([&]() -> const float* { int j_ = (i); asm volatile("" : "+s"(j_)); return args.in[j_]; }())
__global__ void __launch_bounds__(512, 2) fwd_kernel(Args args) {
    extern __shared__ __attribute__((aligned(16))) unsigned char lds[];
    Frame F;
    F.lds = (LAS unsigned char*)lds;
    F.MISC = (volatile LAS unsigned*)(F.lds + MISC_OFF);
    F.tid = threadIdx.x; F.lane = F.tid & 63; F.wave = __builtin_amdgcn_readfirstlane(F.tid >> 6);
    F.G = gridDim.x; { const int bx = blockIdx.x; F.vcu = (F.G % 8 == 0) ? (bx % 8) * (F.G / 8) + bx / 8 : bx; }
    F.ws = args.ws; F.ctl = (unsigned*)(args.ws + WS_CTL); F.out = args.out;
    for (int u = F.tid; u < (LDS_BYTES - LDSCTL_OFF) / 4; u += 512) ((LAS unsigned*)(F.lds + LDSCTL_OFF))[u] = 0u;
    __syncthreads();
    const int wave_s = __builtin_amdgcn_readfirstlane(threadIdx.x >> 6);
    const int lo = args.ph_lo, hi = args.ph_hi;
    XcdBarrier bar; bar.bar = F.ctl + CW_BAR; bar.x = 0; bar.st = nullptr;
    if (hi - lo > 1) bar = xcd_barrier_post(F.ctl + CW_BAR, F.MISC + 8);
    int ph = 0;
#ifdef PROBE_A
    volatile LAS unsigned long long* stampv = (volatile LAS unsigned long long*)(F.lds + LDSCTL_OFF + 1280);
    if (blockIdx.x == 0 && F.tid == 0) stampv[0] = __builtin_amdgcn_s_memrealtime();
#define STAMP() do { if (blockIdx.x == 0 && F.tid == 0) stampv[ph + 1] = __builtin_amdgcn_s_memrealtime(); } while (0)
#else
#define STAMP() do { } while (0)
#endif
#define FRESH() do { int lz_; asm volatile("v_mbcnt_lo_u32_b32 %0, -1, 0\n\tv_mbcnt_hi_u32_b32 %0, -1, %0" : "=&v"(lz_)); F.lane = lz_; F.wave = wave_s; F.tid = wave_s * 64 + lz_;     \
        unsigned char* w_ = args.ws; float* o_ = args.out; asm volatile("" : "+s"(w_), "+s"(o_)); F.ws = w_; F.ctl = (unsigned*)(w_ + WS_CTL); F.out = o_; ws = w_; U0 = (bf16*)o_; OPART = (bf16*)o_; Ob = (bf16*)(w_ + WS_V); } while (0)
#define PH_BEGIN if (lo <= ph && ph < hi) { FRESH();
#define PH_END } if (lo <= ph && ph + 1 < hi) xcd_barrier(bar, F.tid == 0); STAMP(); ++ph;
    unsigned char* ws; bf16 *U0, *OPART, *Ob;

    PH_BEGIN mod_vectors(F, INP(I_C), INP(I_CCTX), INP(I_MODW), INP(I_MODB)); rope_tables(F); conv_small_weights(F, INP(I_RWIN), INP(I_RWOUT), INP(I_CW1), INP(I_CW2));
             conv_moe_weights(F, 0, INP(I_MW1), INP(I_MW3), INP(I_MW2), INP(I_SW1), INP(I_SW3), INP(I_SW2)); PH_END
    PH_BEGIN u_rows_layer0(F, U0, INP(I_X), INP(I_CTX), INP(I_NORMS)); router_prescale(F, INP(I_NORMS), INP(I_ROUTER)); PH_END
    PH_BEGIN
        pg8::Gemm g{U0, (const bf16*)(ws + WS_WIN), 1024}; InprojOrder S; S.init(F.G, (int)blockIdx.x);
        EpiQKVG E{ws};
        pg8::gemm_phase<EpiQKVG, InprojOrder, false>(F.lds + RING_OFF, g, S, E, F.tid, STAG_IN);
    PH_END
    PH_BEGIN retention_scores(F, INP(I_RDECAY)); PH_END
    PH_BEGIN retention_scan(F, OPART, Ob, INP(I_RDECAY)); PH_END
    PH_BEGIN gn_gate_rows(F, Ob, (const bf16*)(ws + WS_G), OPART); PH_END
    PH_BEGIN
        pg8::Gemm g{Ob, (const bf16*)(ws + WS_WOUT), 2048}; pg8::StaticOrder S; S.init(NTOK, D, F.G, (int)blockIdx.x);
        EpiBf16 E{(bf16*)(ws + WS_Y), D, nullptr};
        pg8::gemm_phase<EpiBf16, pg8::StaticOrder, false>(F.lds + RING_OFF, g, S, E, F.tid, STAG_PL);
    PH_END
#pragma unroll 1
    for (int layer = 0; layer < 2; ++layer) {
        if (layer == 1) {
            PH_BEGIN
                pg8::Gemm g{(const bf16*)(ws + WS_UC), (const bf16*)(ws + WS_CW1), 1024}; pg8::StaticOrder S; S.init(NTOK, 2048, F.G, (int)blockIdx.x);
                EpiGLU E{(bf16*)(ws + WS_Z), INP(I_CB1)};
                pg8::gemm_phase<EpiGLU, pg8::StaticOrder, false>(F.lds + RING_OFF, g, S, E, F.tid, STAG_PL);
            PH_END
            PH_BEGIN dwconv_ln(F, (const bf16*)(ws + WS_Z), (bf16*)(ws + WS_C), INP(I_CDW), INP(I_CBDW), INP(I_CLNG), INP(I_CLNB)); PH_END
            PH_BEGIN
                pg8::Gemm g{(const bf16*)(ws + WS_C), (const bf16*)(ws + WS_CW2), 1024}; pg8::StaticOrder S; S.init(NTOK, D, F.G, (int)blockIdx.x);
                EpiBf16 E{(bf16*)(ws + WS_Y1), D, INP(I_CB2)};
                pg8::gemm_phase<EpiBf16, pg8::StaticOrder, false>(F.lds + RING_OFF, g, S, E, F.tid, STAG_PL);
            PH_END
        }
        PH_BEGIN rows_router(F, layer, layer ? (const float*)F.out : INP(I_X), (const bf16*)(ws + (layer ? WS_Y1 : WS_Y)), (bf16*)(ws + WS_U), INP(I_NORMS), INP(I_MBIAS), F.out); PH_END
        PH_BEGIN moe_gemm1(F, layer, 0); PH_END
        PH_BEGIN moe_gemm2(F, layer, 0); PH_END
        PH_BEGIN moe_combine(F, layer, 0, layer == 1, INP(I_NORMS));
                 if (layer == 0) conv_moe_weights(F, 1, INP(I_MW1), INP(I_MW3), INP(I_MW2), INP(I_SW1), INP(I_SW3), INP(I_SW2)); PH_END
    }
#ifdef PROBE_A
    if (blockIdx.x == 0 && F.tid == 0) {
        const unsigned long long tend = __builtin_amdgcn_s_memrealtime();
        unsigned long long sa = 0, sb = 0;
        for (int k = 0; k < N_PHASES; ++k) { const unsigned long long d = stampv[k + 1] - stampv[k]; if ((PROBE_A >> k) & 1u) sa += d; if ((PROBE_B >> k) & 1u) sb += d; }
        if (sb) { VM_WAIT(); F.out[0] += (float)sb * 0.001f; }
        while (__builtin_amdgcn_s_memrealtime() - tend < 8ull * sa) __builtin_amdgcn_s_sleep(8);
    }
#endif
#undef PH_BEGIN
#undef PH_END
}

extern "C" void kernel_launch(void* const* d_in, const int* in_sizes, int n_in, void* d_out, int out_size, void* d_ws, size_t ws_size, hipStream_t stream) {
    static int grid = 0;
    if (grid == 0) {
        if (n_in != 26 || in_sizes[0] != NTOK * D || out_size != NTOK * D || ws_size < WS_END) {
            fprintf(stderr, "kernel_launch: unexpected shapes / workspace (n_in %d, ws %zu, need %zu); nothing launched\n", n_in, ws_size, (size_t)WS_END); grid = -1; return; }
        int dev = 0, cus = 0, per_cu = 0;
        if (hipGetDevice(&dev) != hipSuccess || hipDeviceGetAttribute(&cus, hipDeviceAttributeMultiprocessorCount, dev) != hipSuccess) { grid = -1; return; }
        if (hipFuncSetAttribute((const void*)fwd_kernel, hipFuncAttributeMaxDynamicSharedMemorySize, LDS_BYTES) != hipSuccess) { fprintf(stderr, "kernel_launch: hipFuncSetAttribute failed\n"); grid = -1; return; }
        if (hipOccupancyMaxActiveBlocksPerMultiprocessor(&per_cu, (const void*)fwd_kernel, 512, LDS_BYTES) != hipSuccess || per_cu < 1) { fprintf(stderr, "kernel_launch: occupancy query says %d\n", per_cu); }
        (void)hipGetLastError();
        if (cus < 160) { fprintf(stderr, "kernel_launch: %d CUs: this kernel's per-workgroup tables are sized for >= 160 workgroups; nothing launched\n", cus); grid = -1; return; }
        grid = cus;
    }
    if (grid < 0) return;
    (void)hipMemsetAsync((char*)d_ws + WS_CTL, 0, CTL_ZERO_BYTES, stream);
    Args a{};
    for (int i = 0; i < 26; ++i) a.in[i] = (const float*)d_in[i];
    a.out = (float*)d_out; a.ws = (unsigned char*)d_ws;
#if MK_ONE_LAUNCH
    a.ph_lo = 0; a.ph_hi = N_PHASES;
    hipLaunchKernelGGL(fwd_kernel, dim3(grid), dim3(512), LDS_BYTES, stream, a);
#else
    for (int p = 0; p < N_PHASES; ++p) { a.ph_lo = p; a.ph_hi = p + 1; hipLaunchKernelGGL(fwd_kernel, dim3(grid), dim3(512), LDS_BYTES, stream, a); }
#endif
}
```

```cpp
#include <hip/hip_runtime.h>
#include <cstdio>
#include <cstdint>

#define STAG_G1 0
#define STAG_G2 0
#define STAG_IN 0
#define STAG_PL 0
#ifndef MK_ONE_LAUNCH
#define MK_ONE_LAUNCH 1
#endif

#define GAS __attribute__((address_space(1)))
#define LAS __attribute__((address_space(3)))
typedef unsigned short bf16;
typedef unsigned v4u __attribute__((ext_vector_type(4)));
typedef unsigned v2u __attribute__((ext_vector_type(2)));
typedef float f32x4 __attribute__((ext_vector_type(4)));
typedef float f32x2 __attribute__((ext_vector_type(2)));
typedef float f32x16 __attribute__((ext_vector_type(16)));
typedef short bf16x8 __attribute__((ext_vector_type(8)));
typedef short s16x4 __attribute__((ext_vector_type(4)));
typedef GAS unsigned gu32;
#define RLX_AGENT __ATOMIC_RELAXED, __HIP_MEMORY_SCOPE_AGENT
#define LDS_WAIT() asm volatile("s_waitcnt lgkmcnt(0)" ::: "memory")
#define VM_WAIT() asm volatile("s_waitcnt vmcnt(0)" ::: "memory")
#define DI __device__ __forceinline__

constexpr int D = 1024, NB = 8, T = 4096, NTOK = NB * T, LCTX = 256, NCTX = NB * LCTX;
constexpr int NH = 4, DK = 256, DV = 512, VTOT = 2048, RIN = 6144;
constexpr int NE = 64, TOPK = 8, EH = 256;
constexpr int CH = 128, NCHUNK = T / CH;
constexpr int NSLICE = 1, SLTOK = NTOK / NSLICE;
constexpr int ECAP = SLTOK;
constexpr int NEX = NE + 1;
constexpr int ACT_ROUTED = SLTOK * TOPK + NE * 256;
constexpr float NORM_EPS = 1e-6f, LN_EPS = 1e-5f;

typedef __bf16 bf16x2_hw __attribute__((ext_vector_type(2)));
typedef float f32x2_hw __attribute__((ext_vector_type(2)));
DI unsigned cvt_pk_bf16(float lo, float hi) { const f32x2_hw v = {lo, hi}; const bf16x2_hw r = __builtin_convertvector(v, bf16x2_hw); return __builtin_bit_cast(unsigned, r); }
DI float bf_lo(unsigned u) { return __uint_as_float(u << 16); }
DI float bf_hi(unsigned u) { return __uint_as_float(u & 0xffff0000u); }
DI float bf2f(bf16 b) { return __uint_as_float(((unsigned)b) << 16); }
DI bf16 f2bf(float f) { return (bf16)(cvt_pk_bf16(f, 0.f) & 0xffffu); }
DI float wave_sum(float v) {
    int x = __builtin_bit_cast(int, v);
#define WS_STEP(ctrl, rmask) x = __builtin_bit_cast(int, __builtin_bit_cast(float, x) + __builtin_bit_cast(float, __builtin_amdgcn_update_dpp(0, x, ctrl, rmask, 0xf, false)))
    WS_STEP(0x111, 0xf); WS_STEP(0x112, 0xf); WS_STEP(0x114, 0xf); WS_STEP(0x118, 0xf); WS_STEP(0x142, 0xa); WS_STEP(0x143, 0xc);
#undef WS_STEP
    return __builtin_bit_cast(float, __builtin_amdgcn_readlane(x, 63));
}
DI float wave_max(float v) {
    int x = __builtin_bit_cast(int, v);
#define WM_STEP(ctrl, rmask) x = __builtin_bit_cast(int, fmaxf(__builtin_bit_cast(float, x), __builtin_bit_cast(float, __builtin_amdgcn_update_dpp((int)0xff800000, x, ctrl, rmask, 0xf, false))))
    WM_STEP(0x111, 0xf); WM_STEP(0x112, 0xf); WM_STEP(0x114, 0xf); WM_STEP(0x118, 0xf); WM_STEP(0x142, 0xa); WM_STEP(0x143, 0xc);
#undef WM_STEP
    return __builtin_bit_cast(float, __builtin_amdgcn_readlane(x, 63));
}
#define G8_DPP(x, ctrl) __builtin_bit_cast(float, __builtin_amdgcn_update_dpp(0, __builtin_bit_cast(int, x), ctrl, 0xf, 0xf, false))
DI float grp8_max(float x) { x = fmaxf(x, G8_DPP(x, 0xB1)); x = fmaxf(x, G8_DPP(x, 0x4E)); x = fmaxf(x, G8_DPP(x, 0x141)); return x; }
DI float grp8_sum(float x) { x += G8_DPP(x, 0xB1); x += G8_DPP(x, 0x4E); x += G8_DPP(x, 0x141); return x; }
DI float lane_xor(float v, int lane, int d) { return __builtin_bit_cast(float, __builtin_amdgcn_ds_bpermute((lane ^ d) << 2, __builtin_bit_cast(int, v))); }
DI float sigmoidf_(float x) { return __builtin_amdgcn_rcpf(1.f + __expf(-x)); }
DI float siluf_(float x) { return x * __builtin_amdgcn_rcpf(1.f + __expf(-x)); }

namespace pg8 {
constexpr int BM = 256, BK = 64, HALF = 128, HTB = HALF * BK * 2, STAGE_BYTES = 8 * HTB, NXCD = 8, WGM = 8;
DI int lds_byte(int r, int c) { const int st = (r >> 4) * 2 + (c >> 5), rr = r & 15, cc = c & 31, ob = rr * 64 + cc * 2; return st * 1024 + (ob ^ (((ob >> 9) & 1) << 5)); }
DI void stage_rc(int b, int& R, int& C) { const int st = b / 1024, sb = b % 1024, swz = sb ^ (((sb >> 9) & 1) << 5); R = (st >> 1) * 16 + swz / 64; C = (st & 1) * 32 + (swz % 64) / 2; }
DI int perm32(int rho) { const int n = rho >> 4, i = rho & 15; return 8 * (i >> 2) + 4 * n + (i & 3); }

struct Unit { int pm, pn, e0, e1; };
struct Gemm { const bf16* A; const bf16* Bt; int K; };

struct StaticOrder {
    int nM, nN, nwg, G, c;
    DI void init(int M, int N, int G_, int c_) { nM = M / BM; nN = N / BM; nwg = nM * nN; G = G_; c = c_; }
    DI bool next(int i, Unit& u) const {
        const long L = (long)i * G + c; if (L >= nwg) return false;
        int wgid = (int)L; { const int q = nwg / NXCD, r = nwg % NXCD, xcd = wgid % NXCD, off = wgid / NXCD; wgid = (xcd < r ? xcd * (q + 1) : r * (q + 1) + (xcd - r) * q) + off; }
        const int nig = WGM * nN, gid = wgid / nig, fm = gid * WGM, gsz = (nM - fm) < WGM ? (nM - fm) : WGM;
        u.pm = fm + ((wgid % nig) % gsz); u.pn = (wgid % nig) / gsz; u.e0 = 0; u.e1 = 0; return true;
    }
    DI int a_row(const Unit&, int) const { return 0; }
};

template <class Epi, class Sched, bool GATHER>
DI void gemm_phase(LAS unsigned char* lds, const Gemm g, const Sched& S, const Epi& E, const int tid, const int stagger_us = 0) {
    if (stagger_us > 0 && (S.c & 1)) {
#pragma unroll 1
        for (int i_ = 0; i_ < stagger_us / 2; ++i_) __builtin_amdgcn_s_sleep(64); }
    const int wid = __builtin_amdgcn_readfirstlane(tid >> 6), lane = tid & 63, wr = wid >> 2, wc = wid & 3, fr = lane & 15, fq = lane >> 4;
    const int K = g.K, nt = K / BK;
    unsigned voffB[2], vA[2][2], nvA[2][2]; int Rr[2], Cc[2];
#pragma unroll
    for (int i = 0; i < 2; ++i) { int R, C; stage_rc(tid * 16 + i * 8192, R, C); const int Rb = Epi::PERM ? ((R & ~31) + perm32(R & 31)) : R;
        voffB[i] = (unsigned)(Rb * K + C) * 2u; Rr[i] = R; Cc[i] = C; }
    const size_t kstep = (size_t)(BK * 2);
    const size_t hstep = (size_t)HALF * K * 2;
    const size_t tstep = 2 * hstep;
    const unsigned ldsw = (unsigned)wid * 1024u;
    const int aoff = lds_byte(wr * 64 + fr, fq * 8), boff = lds_byte(wc * 32 + fr, fq * 8);
#define PG8_SETV(u, v) do { _Pragma("unroll") for (int _h = 0; _h < 2; ++_h) _Pragma("unroll") for (int _i = 0; _i < 2; ++_i) \
        (v)[_h][_i] = GATHER ? (unsigned)(S.a_row((u), _h * 128 + Rr[_i]) * K + Cc[_i]) * 2u : (unsigned)((_h * 128 + Rr[_i]) * K + Cc[_i]) * 2u; } while (0)
#define PG8_SA(b, h) (((b) * 2 + (h)) * HTB)
#define PG8_SB(b, h) ((4 + (b) * 2 + (h)) * HTB)
#define PG8_STAGE(bufoff, gbase, voff) do { _Pragma("unroll") for (int _i = 0; _i < 2; ++_i) \
        __builtin_amdgcn_global_load_lds((const unsigned*)((const char*)(gbase) + (voff)[_i]), (LAS unsigned*)(lds + (bufoff) + ldsw + _i * 8192), 16, 0, 0); } while (0)
#define PG8_LDA(dst, b, h) do { _Pragma("unroll") for (int m = 0; m < 4; ++m) _Pragma("unroll") for (int k = 0; k < 2; ++k) dst[m][k] = *(const LAS bf16x8*)(lds + PG8_SA(b, h) + aoff + m * 2048 + k * 1024); } while (0)
#define PG8_LDB(dst, b, h) do { _Pragma("unroll") for (int n = 0; n < 2; ++n) _Pragma("unroll") for (int k = 0; k < 2; ++k) dst[n][k] = *(const LAS bf16x8*)(lds + PG8_SB(b, h) + boff + n * 2048 + k * 1024); } while (0)
#define PG8_MMA(ai, bj, At, Bt) do { __builtin_amdgcn_s_setprio(1); _Pragma("unroll") for (int m = 0; m < 4; ++m) _Pragma("unroll") for (int n = 0; n < 2; ++n) _Pragma("unroll") for (int k = 0; k < 2; ++k) \
        acc[ai][bj][m][n] = __builtin_amdgcn_mfma_f32_16x16x32_bf16(Bt[n][k], At[m][k], acc[ai][bj][m][n], 0, 0, 0); __builtin_amdgcn_s_setprio(0); } while (0)
#define PG8_WAIT_V(n) asm volatile("s_waitcnt vmcnt(" #n ")" ::: "memory")
#define PG8_WAIT_L(n) asm volatile("s_waitcnt lgkmcnt(" #n ")" ::: "memory")
#define PG8_BAR __builtin_amdgcn_s_barrier()
#define PG8_SCHED __builtin_amdgcn_sched_barrier(0)
    Unit cur, nxt; int ui = 0;
    if (!S.next(0, cur)) return;
    f32x4 acc[2][2][4][2];
#pragma unroll
    for (int a = 0; a < 2; ++a)
#pragma unroll
        for (int b = 0; b < 2; ++b)
#pragma unroll
            for (int m = 0; m < 4; ++m)
#pragma unroll
                for (int n = 0; n < 2; ++n) acc[a][b][m][n] = (f32x4){0.f, 0.f, 0.f, 0.f};
    bf16x8 At[4][2], B0[2][2], B1[2][2];
    PG8_SETV(cur, vA);
    const char* cA = GATHER ? (const char*)g.A : (const char*)g.A + (size_t)cur.pm * tstep; const char* cB = (const char*)g.Bt + (size_t)cur.pn * tstep;
    PG8_STAGE(PG8_SB(0, 0), cB, voffB); PG8_STAGE(PG8_SB(0, 1), cB + hstep, voffB); PG8_STAGE(PG8_SA(0, 0), cA, vA[0]); PG8_STAGE(PG8_SA(0, 1), cA, vA[1]);
    if (wr == 1) PG8_BAR;
    PG8_WAIT_V(2); PG8_BAR;
    PG8_STAGE(PG8_SB(1, 0), cB + kstep, voffB); PG8_STAGE(PG8_SA(1, 0), cA + kstep, vA[0]); PG8_STAGE(PG8_SB(1, 1), cB + hstep + kstep, voffB);
    PG8_WAIT_V(6); PG8_BAR;
    for (;;) {
        const bool has_next = S.next(ui + 1, nxt);
        const char* nA = has_next ? (GATHER ? (const char*)g.A : (const char*)g.A + (size_t)nxt.pm * tstep) : cA; const char* nB = has_next ? (const char*)g.Bt + (size_t)nxt.pn * tstep : cB;
        if (GATHER) { if (has_next) { PG8_SETV(nxt, nvA); } else {
#pragma unroll
            for (int h = 0; h < 2; ++h)
#pragma unroll
                for (int i = 0; i < 2; ++i) nvA[h][i] = vA[h][i]; } }
#pragma unroll 1
        for (int t = 0; t < nt; t += 2) {
            const bool last = (t == nt - 2);
            const char* a1 = cA + (size_t)(t + 1) * kstep;
            const char* a2 = last ? nA : cA + (size_t)(t + 2) * kstep; const char* b2 = last ? nB : cB + (size_t)(t + 2) * kstep;
            const char* a3 = a2 + kstep; const char* b3 = b2 + kstep;
            unsigned s2[2][2];
#pragma unroll
            for (int h = 0; h < 2; ++h)
#pragma unroll
                for (int i = 0; i < 2; ++i) s2[h][i] = (GATHER && last) ? nvA[h][i] : vA[h][i];
            PG8_LDB(B0, 0, 0); PG8_LDB(B1, 0, 1); PG8_SCHED; PG8_LDA(At, 0, 0); PG8_STAGE(PG8_SA(1, 1), a1, vA[1]);
            PG8_WAIT_V(8); PG8_WAIT_L(0); PG8_BAR; PG8_MMA(0, 0, At, B0); PG8_MMA(0, 1, At, B1); PG8_BAR; PG8_SCHED;
            PG8_LDA(At, 0, 1); PG8_STAGE(PG8_SB(0, 0), b2, voffB); PG8_STAGE(PG8_SB(0, 1), b2 + hstep, voffB); PG8_STAGE(PG8_SA(0, 0), a2, s2[0]);
            PG8_WAIT_V(8); PG8_WAIT_L(0); PG8_BAR; PG8_MMA(1, 0, At, B0); PG8_MMA(1, 1, At, B1); PG8_BAR; PG8_SCHED;
            PG8_LDB(B0, 1, 0); PG8_LDB(B1, 1, 1); PG8_SCHED; PG8_LDA(At, 1, 0); PG8_STAGE(PG8_SA(0, 1), a2, s2[1]);
            PG8_WAIT_V(8); PG8_WAIT_L(0); PG8_BAR; PG8_MMA(0, 0, At, B0); PG8_MMA(0, 1, At, B1); PG8_BAR; PG8_SCHED;
            PG8_LDA(At, 1, 1); PG8_STAGE(PG8_SB(1, 0), b3, voffB); PG8_STAGE(PG8_SB(1, 1), b3 + hstep, voffB); PG8_STAGE(PG8_SA(1, 0), a3, s2[0]);
            PG8_WAIT_V(8); PG8_WAIT_L(0); PG8_BAR; PG8_MMA(1, 0, At, B0); PG8_MMA(1, 1, At, B1); PG8_BAR; PG8_SCHED;
        }
        if (wr == 0) PG8_BAR;
        { int tz = tid; asm volatile("" : "+v"(tz));
          const int wid2 = __builtin_amdgcn_readfirstlane(tz >> 6), lane2 = tz & 63;
          E(acc, cur, wid2 >> 2, wid2 & 3, lane2 & 15, lane2 >> 4); }
        if (!has_next) break;
#pragma unroll
        for (int a = 0; a < 2; ++a)
#pragma unroll
            for (int b = 0; b < 2; ++b)
#pragma unroll
                for (int m = 0; m < 4; ++m)
#pragma unroll
                    for (int n = 0; n < 2; ++n) acc[a][b][m][n] = (f32x4){0.f, 0.f, 0.f, 0.f};
        cur = nxt; cA = nA; cB = nB; ++ui;
        if (GATHER) {
#pragma unroll
            for (int h = 0; h < 2; ++h)
#pragma unroll
                for (int i = 0; i < 2; ++i) vA[h][i] = nvA[h][i]; }
        if (wr == 1) PG8_BAR;
    }
    PG8_WAIT_V(0);
    PG8_BAR;
#undef PG8_SETV
#undef PG8_SA
#undef PG8_SB
#undef PG8_STAGE
#undef PG8_LDA
#undef PG8_LDB
#undef PG8_MMA
#undef PG8_WAIT_V
#undef PG8_WAIT_L
#undef PG8_BAR
#undef PG8_SCHED
}
}
using pg8::Unit;

constexpr size_t MiB = 1u << 20;
constexpr size_t WS_CTL = 0, CTL_ZERO_BYTES = 2 * MiB;
constexpr size_t WS_MOD = 2 * MiB;
constexpr size_t WS_ROPE = 4 * MiB;
constexpr size_t WS_WIN = 10 * MiB, WS_WOUT = 22 * MiB, WS_CW1 = 26 * MiB, WS_CW2 = 30 * MiB;
constexpr size_t WS_W13 = 32 * MiB, WS_W2 = 97 * MiB;
constexpr size_t WS_LIST = 130 * MiB;
constexpr size_t LIST_ARR = (size_t)NEX * ECAP * 4, LIST_SLICE = 3 * LIST_ARR;
constexpr size_t WS_BIG = 160 * MiB;
constexpr size_t WS_Q = WS_BIG, WS_K = WS_Q + 64 * MiB, WS_V = WS_K + 64 * MiB, WS_G = WS_V + 128 * MiB;
constexpr size_t WS_KC = 544 * MiB, WS_VC = 548 * MiB, WS_P = 560 * MiB;
constexpr size_t WS_Y = WS_BIG;
constexpr size_t WS_ACT = WS_BIG;
constexpr size_t WS_Y2 = WS_BIG + 152 * MiB;
constexpr size_t WS_U = WS_Y2;
constexpr size_t WS_UC = WS_BIG;
constexpr size_t WS_Z = WS_BIG + 64 * MiB, WS_C = WS_BIG + 128 * MiB, WS_Y1 = WS_BIG + 216 * MiB;
constexpr size_t WS_END = 600 * MiB;
static_assert(WS_LIST + NSLICE * LIST_SLICE <= WS_BIG, "lists");
static_assert(WS_ACT + (size_t)(ACT_ROUTED + SLTOK) * 512 <= WS_Y2, "act");
static_assert(WS_Y2 + (size_t)SLTOK * 9 * 1024 <= WS_END, "y2");
static_assert(WS_W13 + (size_t)NEX * 512 * 1024 * 2 <= WS_W2 && WS_W2 + (size_t)NEX * 1024 * 256 * 2 <= WS_LIST, "moe w");
constexpr int CW_TMO = 0, CW_CODE = 1;
constexpr int CW_BAR = 4096;
constexpr int CW_CNT = 16384;
DI int cnt_word(int layer, int slice, int e) { return CW_CNT + ((layer * NSLICE + slice) * NE + e) * 16; }

constexpr int RING_OFF = 0, RING_BYTES = 131072;
constexpr int LDSCTL_OFF = 148480, MISC_OFF = LDSCTL_OFF + 1024;
constexpr int LDS_BYTES = 152576;

#define XB_TMO      128
#define XB_XCNT(j)  (256  + 64 * (j))
#define XB_XSUB(j)  (1280 + 64 * (j))
#define XB_XGEN(j)  (2304 + 64 * (j))
#define XB_TOP      3328
#define XB_TOPGEN   3392
#define XCD_BAR_WORDS 3456
#define XB_SPIN_CAP (1u << 18)
DI unsigned xb_ld(unsigned* p)              { return __hip_atomic_load(p, __ATOMIC_RELAXED, __HIP_MEMORY_SCOPE_AGENT); }
DI unsigned xb_add(unsigned* p, unsigned v) { return __hip_atomic_fetch_add(p, v, __ATOMIC_RELAXED, __HIP_MEMORY_SCOPE_AGENT); }
DI unsigned xb_xcc_id() { return (unsigned)__builtin_amdgcn_s_getreg((3 << 11) | 20) & 0xFu; }
#define XB_SPIN(cond, bar) do { unsigned _sp = 0; while (cond) { __builtin_amdgcn_s_sleep(1); \
    if ((++_sp & 255u) == 0u) { if (xb_ld(&(bar)[XB_TMO])) break; if (_sp > XB_SPIN_CAP) { atomicAdd(&(bar)[XB_TMO], 1u); break; } } } } while (0)
struct XcdBarrier { unsigned* bar; unsigned x; volatile LAS unsigned* st; };
DI XcdBarrier xcd_barrier_post(unsigned* bar, volatile LAS unsigned* st) {
    XcdBarrier b; b.bar = bar; b.x = xb_xcc_id(); b.st = st;
    if (threadIdx.x == 0) (void)xb_add(&bar[XB_XCNT(b.x)], 1u);
    return b;
}
DI void xcd_barrier_complete(unsigned* bar, unsigned x, unsigned& nloc, unsigned& nx) {
    const unsigned G = gridDim.x * gridDim.y * gridDim.z;
    unsigned sum, cnt, mine, sp = 0u;
    for (;;) {
        sum = 0u; cnt = 0u; mine = 0u;
#pragma unroll
        for (unsigned j = 0; j < 16; ++j) { const unsigned c = xb_ld(&bar[XB_XCNT(j)]); sum += c; cnt += (c > 0u) ? 1u : 0u; mine = (j == x) ? c : mine; }
        if (sum == G) break;
        __builtin_amdgcn_s_sleep(1);
        if ((++sp & 255u) == 0u) { if (xb_ld(&bar[XB_TMO])) break; if (sp > XB_SPIN_CAP) { atomicAdd(&bar[XB_TMO], 1u); break; } }
    }
    nloc = mine > 0u ? mine : 1u; nx = cnt > 0u ? cnt : 1u;
}
DI void xcd_barrier(const XcdBarrier& b, const bool leader) {
    asm volatile("s_waitcnt vmcnt(0)" ::: "memory");
    __syncthreads();
    if (leader) {
        unsigned* bar = b.bar;
        __builtin_amdgcn_s_waitcnt(0);
        unsigned nloc = b.st[0], nx = b.st[1];
        if (nloc == 0u) { xcd_barrier_complete(bar, b.x, nloc, nx); b.st[0] = nloc; b.st[1] = nx; }
        const unsigned old = xb_add(&bar[XB_XSUB(b.x)], 1u);
        const unsigned gen = old / nloc;
        if (old + 1u == (gen + 1u) * nloc) {
            __builtin_amdgcn_fence(__ATOMIC_RELEASE, "agent");
            asm volatile("s_waitcnt vmcnt(0)" ::: "memory");
            const unsigned og = xb_add(&bar[XB_TOP], 1u);
            const unsigned tg = og / nx;
            if (og + 1u == (tg + 1u) * nx) xb_add(&bar[XB_TOPGEN], 1u);
            else XB_SPIN(xb_ld(&bar[XB_TOPGEN]) == tg, bar);
            __builtin_amdgcn_fence(__ATOMIC_ACQUIRE, "agent");
            xb_add(&bar[XB_XGEN(b.x)], 1u);
            asm volatile("s_waitcnt vmcnt(0)" ::: "memory");
        } else {
            XB_SPIN(xb_ld(&bar[XB_XGEN(b.x)]) == gen, bar);
            __builtin_amdgcn_fence(__ATOMIC_ACQUIRE, "agent");
            asm volatile("s_waitcnt vmcnt(0)" ::: "memory");
        }
    }
    __syncthreads();
}

struct Frame {
    LAS unsigned char* lds;
    volatile LAS unsigned* MISC;
    unsigned* ctl;
    unsigned char* ws;
    int tid, lane, wave, vcu, G;
    float* out;
};
enum { I_X = 0, I_C, I_CTX, I_CCTX, I_MODW, I_MODB, I_NORMS, I_RWIN, I_RWOUT, I_RDECAY, I_CW1, I_CB1, I_CDW, I_CBDW, I_CLNG, I_CLNB, I_CW2, I_CB2,
       I_ROUTER, I_MBIAS, I_MW1, I_MW3, I_MW2, I_SW1, I_SW3, I_SW2 };

typedef const f32x4 (&AccRef)[2][2][4][2];
DI void st16(bf16* p, unsigned a, unsigned b, unsigned c, unsigned d) { v4u o; o.x = a; o.y = b; o.z = c; o.w = d; *(GAS v4u*)p = o; }

struct EpiQKVG {
    static constexpr bool PERM = true;
    unsigned char* ws;
    DI void operator()(AccRef acc, const Unit& u, int wr, int wc, int fr, int fq) const {
        const bool ctx = u.pm >= 128;
        const int rbase = u.pm * 256 + wr * 64 + fr, cw = wc * 32 + 8 * fq, pn = u.pn;
        if (pn < 8) {
            const bool isq = pn < 4; const int head = pn & 3;
            const size_t doff = ctx ? WS_KC : (isq ? WS_Q : WS_K);
            bf16* dst = (bf16*)(ws + doff);
            const int bb = ctx ? u.pm - 128 : u.pm >> 4, nch = ctx ? 2 : NCHUNK;
            const float* cs = (const float*)(ws + WS_ROPE) + (ctx ? 2 * T * 128 : 0);
            const int snoff = ctx ? LCTX * 128 : T * 128;
            const float sc = isq ? 0.0625f : 1.f;
#pragma unroll
            for (int ai = 0; ai < 2; ++ai)
#pragma unroll
                for (int m = 0; m < 4; ++m) {
                    const int row = rbase + ai * 128 + m * 16, rr = ctx ? row - NTOK : row, t = ctx ? (rr & (LCTX - 1)) : (row & (T - 1));
#pragma unroll
                    for (int bj = 0; bj < 2; ++bj) {
                        const int p0 = bj * 64 + wc * 16 + 4 * fq;
                        const f32x4 c = *(const GAS f32x4*)(cs + (size_t)t * 128 + p0), s = *(const GAS f32x4*)(cs + snoff + (size_t)t * 128 + p0);
                        const f32x4 v0 = acc[ai][bj][m][0], v1 = acc[ai][bj][m][1];
                        const float o0 = (v0[0] * c[0] - v0[1] * s[0]) * sc, o1 = (v0[0] * s[0] + v0[1] * c[0]) * sc;
                        const float o2 = (v0[2] * c[1] - v0[3] * s[1]) * sc, o3 = (v0[2] * s[1] + v0[3] * c[1]) * sc;
                        const float o4 = (v1[0] * c[2] - v1[1] * s[2]) * sc, o5 = (v1[0] * s[2] + v1[1] * c[2]) * sc;
                        const float o6 = (v1[2] * c[3] - v1[3] * s[3]) * sc, o7 = (v1[2] * s[3] + v1[3] * c[3]) * sc;
                        const int chunk = ctx ? ai : ((2 * u.pm + ai) & (NCHUNK - 1)), itq = wr * 2 + (m >> 1), rq = (m & 1) * 16 + fr, ksq = bj * 8 + wc * 2 + (fq >> 1);
                        const size_t fo = isq ? ((((size_t)(bb * nch + chunk) * NH + head) * 8 + (4 * wr + m)) * 8 + (4 * bj + wc)) * 512 + (fr + 16 * fq) * 8
                                              : ((((size_t)(bb * nch + chunk) * NH + head) * 4 + itq) * 16 + ksq) * 512 + (rq + 32 * (fq & 1)) * 8;
                        st16(dst + fo, cvt_pk_bf16(o0, o1), cvt_pk_bf16(o2, o3), cvt_pk_bf16(o4, o5), cvt_pk_bf16(o6, o7));
                    }
                }
        } else {
            const bool isg = pn >= 16; const int ct = (pn - (isg ? 16 : 8)) * 256;
            const size_t doff = isg ? WS_G : (ctx ? WS_VC : WS_V);
            bf16* dst = (bf16*)(ws + doff);
#pragma unroll
            for (int ai = 0; ai < 2; ++ai)
#pragma unroll
                for (int m = 0; m < 4; ++m) {
                    const int row = rbase + ai * 128 + m * 16, rr = ctx ? row - NTOK : row;
#pragma unroll
                    for (int bj = 0; bj < 2; ++bj) {
                        f32x4 v0 = acc[ai][bj][m][0], v1 = acc[ai][bj][m][1];
                        if (isg) {
#pragma unroll
                            for (int e = 0; e < 4; ++e) { v0[e] = siluf_(v0[e]); v1[e] = siluf_(v1[e]); }
                        }
                        st16(dst + (size_t)rr * 2048 + ct + bj * 128 + cw, cvt_pk_bf16(v0[0], v0[1]), cvt_pk_bf16(v0[2], v0[3]), cvt_pk_bf16(v1[0], v1[1]), cvt_pk_bf16(v1[2], v1[3]));
                    }
                }
        }
    }
};
struct InprojOrder {
    pg8::StaticOrder so; int G, c;
    DI void init(int G_, int c_) { so.init(NTOK, RIN, G_, c_); G = G_; c = c_; }
    DI bool next(int i, Unit& u) const {
        const int L = i * G + c;
        if (L < 3072) return so.next(i, u);
        const int l2 = L - 3072; if (l2 >= 96) return false;
        u.pm = 128 + l2 / 12; u.pn = 4 + l2 % 12; u.e0 = 0; u.e1 = 0; return true;
    }
    DI int a_row(const Unit&, int) const { return 0; }
};
struct EpiBf16 {
    static constexpr bool PERM = true;
    bf16* O; int ldc; const float* bias;
    DI void operator()(AccRef acc, const Unit& u, int wr, int wc, int fr, int fq) const {
        const int rbase = u.pm * 256 + wr * 64 + fr, cbase = u.pn * 256 + wc * 32 + 8 * fq;
#pragma unroll
        for (int bj = 0; bj < 2; ++bj) {
            f32x4 b0 = (f32x4){0.f, 0.f, 0.f, 0.f}, b1 = b0;
            if (bias) { b0 = *(const GAS f32x4*)(bias + cbase + bj * 128); b1 = *(const GAS f32x4*)(bias + cbase + bj * 128 + 4); }
#pragma unroll
            for (int ai = 0; ai < 2; ++ai)
#pragma unroll
                for (int m = 0; m < 4; ++m) {
                    const f32x4 v0 = acc[ai][bj][m][0] + b0, v1 = acc[ai][bj][m][1] + b1;
                    st16(O + (size_t)(rbase + ai * 128 + m * 16) * ldc + cbase + bj * 128, cvt_pk_bf16(v0[0], v0[1]), cvt_pk_bf16(v0[2], v0[3]), cvt_pk_bf16(v1[0], v1[1]), cvt_pk_bf16(v1[2], v1[3]));
                }
        }
    }
};
struct EpiGLU {
    static constexpr bool PERM = true;
    bf16* Z; const float* b1;
    DI void operator()(AccRef acc, const Unit& u, int wr, int wc, int fr, int fq) const {
        const int rbase = u.pm * 256 + wr * 64 + fr, cc = u.pn * 128 + wc * 32 + 8 * fq;
        const f32x4 ba0 = *(const GAS f32x4*)(b1 + cc), ba1 = *(const GAS f32x4*)(b1 + cc + 4), bg0 = *(const GAS f32x4*)(b1 + 1024 + cc), bg1 = *(const GAS f32x4*)(b1 + 1024 + cc + 4);
#pragma unroll
        for (int ai = 0; ai < 2; ++ai)
#pragma unroll
            for (int m = 0; m < 4; ++m) {
                const f32x4 a0 = acc[ai][0][m][0] + ba0, a1 = acc[ai][0][m][1] + ba1, g0 = acc[ai][1][m][0] + bg0, g1 = acc[ai][1][m][1] + bg1;
                f32x4 o0, o1;
#pragma unroll
                for (int e = 0; e < 4; ++e) { o0[e] = a0[e] * sigmoidf_(g0[e]); o1[e] = a1[e] * sigmoidf_(g1[e]); }
                st16(Z + (size_t)(rbase + ai * 128 + m * 16) * 1024 + cc, cvt_pk_bf16(o0[0], o0[1]), cvt_pk_bf16(o0[2], o0[3]), cvt_pk_bf16(o1[0], o1[1]), cvt_pk_bf16(o1[2], o1[3]));
            }
    }
};
struct MoeOrder {
    const LAS int* cum; const LAS int* cnt; const LAS int* rb; const LAS unsigned char* eob; const int* ltok; int npn, G, c, total;
    DI bool next(int i, Unit& u) const {
        const int L = i * G + c; if (L >= total) return false;
        const int blk = L / npn, sub = L - blk * npn;
        const int e = eob[blk];
        const int bi = blk - cum[e];
        u.pm = blk; u.pn = e * npn + sub; const int left = cnt[e] - bi * 256; u.e1 = left < 256 ? left : 256;
        u.e0 = ltok ? e * ECAP + bi * 256 : rb[e] + bi * 256;
        return true;
    }
    DI int a_row(const Unit& u, int r) const { return r < u.e1 ? ltok[u.e0 + r] : 0; }
};
struct EpiSwiGLU {
    static constexpr bool PERM = true;
    bf16* ACT;
    DI void operator()(AccRef acc, const Unit& u, int wr, int wc, int fr, int fq) const {
        const int rbase = u.pm * 256 + wr * 64 + fr, cc = (u.pn & 1) * 128 + wc * 32 + 8 * fq;
#pragma unroll
        for (int ai = 0; ai < 2; ++ai)
#pragma unroll
            for (int m = 0; m < 4; ++m) {
                const f32x4 a0 = acc[ai][0][m][0], a1 = acc[ai][0][m][1], g0 = acc[ai][1][m][0], g1 = acc[ai][1][m][1];
                f32x4 o0, o1;
#pragma unroll
                for (int e = 0; e < 4; ++e) { o0[e] = siluf_(a0[e]) * g0[e]; o1[e] = siluf_(a1[e]) * g1[e]; }
                st16(ACT + (size_t)(rbase + ai * 128 + m * 16) * 256 + cc, cvt_pk_bf16(o0[0], o0[1]), cvt_pk_bf16(o0[2], o0[3]), cvt_pk_bf16(o1[0], o1[1]), cvt_pk_bf16(o1[2], o1[3]));
            }
    }
};
struct EpiMoeOut {
    static constexpr bool PERM = true;
    unsigned char* Y2; int nostore;
    DI void operator()(AccRef acc, const Unit& u, int wr, int wc, int fr, int fq) const {
        const int ch = ((u.pn & 3) * 16 + wc * 4 + fq) * 16;
        if (nostore) { if (acc[0][0][0][0][0] != 12345.678f || acc[1][1][3][1][3] != 321.f) return; }
#pragma unroll
        for (int ai = 0; ai < 2; ++ai)
#pragma unroll
            for (int m = 0; m < 4; ++m) {
                const int r = ai * 128 + wr * 64 + m * 16 + fr;
                if (r < u.e1) {
                    unsigned pk[4];
#pragma unroll
                    for (int bj = 0; bj < 2; ++bj) {
                        const f32x4 v0 = acc[ai][bj][m][0], v1 = acc[ai][bj][m][1];
                        int p0 = __builtin_amdgcn_cvt_pk_fp8_f32(v0[0], v0[1], 0, false); p0 = __builtin_amdgcn_cvt_pk_fp8_f32(v0[2], v0[3], p0, true);
                        int p1 = __builtin_amdgcn_cvt_pk_fp8_f32(v1[0], v1[1], 0, false); p1 = __builtin_amdgcn_cvt_pk_fp8_f32(v1[2], v1[3], p1, true);
                        pk[2 * bj] = (unsigned)p0; pk[2 * bj + 1] = (unsigned)p1;
                    }
                    *(GAS v4u*)(Y2 + (size_t)(u.e0 + r) * 1024 + ch) = (v4u){pk[0], pk[1], pk[2], pk[3]};
                }
            }
    }
};

struct TrItem { const float* src; bf16* dst; int ldsrc, Kd; };
DI void tr_load(const TrItem& t, float (&tv)[32], int lane) {
#pragma unroll
    for (int i = 0; i < 32; ++i) { const int kk = 2 * i + (lane >> 5); tv[i] = t.src[(size_t)kk * t.ldsrc + (lane & 31)]; }
}
DI void tr_store(const TrItem& t, const float (&tv)[32], LAS float* scr, int lane) {
#pragma unroll
    for (int i = 0; i < 32; ++i) { const int kk = 2 * i + (lane >> 5); scr[kk * 33 + (lane & 31)] = tv[i]; }
    LDS_WAIT(); asm volatile("" ::: "memory");
    const int c = lane & 7;
#pragma unroll
    for (int j = 0; j < 4; ++j) { const int n = (lane >> 3) + 8 * j; const LAS float* s = scr + (8 * c) * 33 + n;
        v4u o; o.x = cvt_pk_bf16(s[0 * 33], s[1 * 33]); o.y = cvt_pk_bf16(s[2 * 33], s[3 * 33]); o.z = cvt_pk_bf16(s[4 * 33], s[5 * 33]); o.w = cvt_pk_bf16(s[6 * 33], s[7 * 33]);
        *(GAS v4u*)(t.dst + (size_t)n * t.Kd + 8 * c) = o; }
    LDS_WAIT(); asm volatile("" ::: "memory");
}
DI TrItem tr_mk(const float* src, int ldsrc, int k0, int scol0, bf16* dst, int Kd, int drow0) { TrItem t; t.src = src + (size_t)k0 * ldsrc + scol0; t.dst = dst + (size_t)drow0 * Kd + k0; t.ldsrc = ldsrc; t.Kd = Kd; return t; }
template <class MK> DI void tr_run(int it0, int step, int n, LAS float* scr, int lane, MK mk) {
    float ta[32], tb[32];
    TrItem ia, ib;
    if (it0 < n) { ia = mk(it0); tr_load(ia, ta, lane); }
    for (int it = it0; it < n; it += 2 * step) {
        const bool hb = it + step < n;
        if (hb) { ib = mk(it + step); tr_load(ib, tb, lane); }
        tr_store(ia, ta, scr, lane);
        if (hb) {
            if (it + 2 * step < n) { ia = mk(it + 2 * step); tr_load(ia, ta, lane); }
            tr_store(ib, tb, scr, lane);
        }
    }
}
DI void conv_moe_weights(Frame& F, int layer, const float* mw1, const float* mw3, const float* mw2, const float* sw1, const float* sw3, const float* sw2) {
    LAS float* scr = (LAS float*)(F.lds + RING_OFF + F.wave * 16384);
    const int gw = F.vcu * 8 + F.wave, NGW = F.G * 8;
    bf16* W13 = (bf16*)(F.ws + WS_W13); bf16* W2 = (bf16*)(F.ws + WS_W2);
    constexpr int I13 = 16 * 16, I2 = 4 * 32, PER = I13 + I2;
    tr_run(gw, NGW, NEX * PER, scr, F.lane, [&](int it) -> TrItem {
        const int e = it / PER, r = it - e * PER;
        if (r < I13) {
            const int kb = r >> 4, nb = r & 15;
            const float* s1 = e < NE ? mw1 + ((size_t)(layer * NE + e) << 18) : sw1 + ((size_t)layer << 18);
            const float* s3 = e < NE ? mw3 + ((size_t)(layer * NE + e) << 18) : sw3 + ((size_t)layer << 18);
            const float* src = (nb & 7) < 4 ? s1 : s3;
            return tr_mk(src, 256, kb * 64, 128 * (nb >> 3) + 32 * (nb & 3), W13, 1024, e * 512 + nb * 32);
        } else {
            const int r2 = r - I13, kb = r2 >> 5, nb = r2 & 31;
            const float* src = e < NE ? mw2 + ((size_t)(layer * NE + e) << 18) : sw2 + ((size_t)layer << 18);
            return tr_mk(src, 1024, kb * 64, nb * 32, W2, 256, e * 1024 + nb * 32);
        }
    });
}
DI void conv_small_weights(Frame& F, const float* rwin, const float* rwout, const float* cw1, const float* cw2) {
    LAS float* scr = (LAS float*)(F.lds + RING_OFF + F.wave * 16384);
    const int gw = F.vcu * 8 + F.wave, NGW = F.G * 8;
    constexpr int I_IN = 16 * 192, I_OUT = 32 * 32, I_C1 = 16 * 64, I_C2 = 16 * 32, TOT = I_IN + I_OUT + I_C1 + I_C2;
    unsigned char* ws = F.ws;
    tr_run(gw, NGW, TOT, scr, F.lane, [&](int it) -> TrItem {
        int r = it;
        if (r < I_IN) { const int kb = r / 192, nb = r % 192; return tr_mk(rwin, RIN, kb * 64, nb * 32, (bf16*)(ws + WS_WIN), 1024, nb * 32); } r -= I_IN;
        if (r < I_OUT) { const int kb = r >> 5, nb = r & 31; return tr_mk(rwout, 1024, kb * 64, nb * 32, (bf16*)(ws + WS_WOUT), 2048, nb * 32); } r -= I_OUT;
        if (r < I_C1) { const int kb = r >> 6, nb = r & 63; const int sc0 = ((nb & 7) < 4 ? 0 : 1024) + 128 * (nb >> 3) + 32 * (nb & 3);
            return tr_mk(cw1, 2048, kb * 64, sc0, (bf16*)(ws + WS_CW1), 1024, nb * 32); } r -= I_C1;
        { const int kb = r >> 5, nb = r & 31; return tr_mk(cw2, 1024, kb * 64, nb * 32, (bf16*)(ws + WS_CW2), 1024, nb * 32); }
    });
}
DI void rope_tables(Frame& F) {
    float* csL = (float*)(F.ws + WS_ROPE); float* snL = csL + T * 128; float* csC = snL + T * 128; float* snC = csC + LCTX * 128;
    const int gt = F.vcu * 512 + F.tid, NT = F.G * 512;
    for (int i = gt; i < (T + LCTX) * 128; i += NT) {
        const int t = i >> 7, p = i & 127;
        int ax, ii, dd; if (p < 32) { ax = 0; ii = p; dd = 64; } else if (p < 80) { ax = 1; ii = p - 32; dd = 96; } else { ax = 2; ii = p - 80; dd = 96; }
        const float inv = exp2f(-13.287712379549449f * (float)(2 * ii) / (float)dd);
        int pos;
        if (t < T) pos = ax == 0 ? LCTX : (ax == 1 ? (t >> 6) : (t & 63)); else pos = ax == 0 ? (t - T) : 0;
        const float ang = (float)pos * inv;
        const float rev = ang * 0.15915494309189535f;
        const float fr = rev - floorf(rev);
        const float s = __builtin_amdgcn_sinf(fr), c = __builtin_amdgcn_cosf(fr);
        if (t < T) { csL[i] = c; snL[i] = s; } else { csC[i - T * 128] = c; snC[i - T * 128] = s; }
    }
}
DI void mod_vectors(Frame& F, const float* cin, const float* cctx, const float* modw, const float* modb) {
    LAS float* sl = (LAS float*)(F.lds + RING_OFF);
    LAS float* red = sl + 9 * 1024;
    if (F.vcu >= 192) return;
    for (int i = F.tid; i < 9 * 1024; i += 512) { const float v = i < 8192 ? cin[i] : cctx[i - 8192]; sl[i] = siluf_(v); }
    __syncthreads();
    float* MOD = (float*)(F.ws + WS_MOD);
    for (int it = F.vcu; it < 192; it += F.G) {
        const int l = it / 96, cb = (it % 96) * 64;
        const float* w = modw + (size_t)l * 1024 * 6144 + cb + F.lane;
        float a[9];
#pragma unroll
        for (int b = 0; b < 9; ++b) a[b] = 0.f;
        const int k0 = F.wave * 128;
#pragma unroll 8
        for (int k = 0; k < 128; ++k) { const float wv = w[(size_t)(k0 + k) * 6144];
#pragma unroll
            for (int b = 0; b < 9; ++b) a[b] += sl[b * 1024 + k0 + k] * wv; }
#pragma unroll
        for (int b = 0; b < 9; ++b) red[(F.wave * 9 + b) * 64 + F.lane] = a[b];
        __syncthreads();
        for (int o = F.tid; o < 9 * 64; o += 512) { const int b = o >> 6, c = o & 63; float s = modb[l * 6144 + cb + c];
#pragma unroll
            for (int w8 = 0; w8 < 8; ++w8) s += red[(w8 * 9 + b) * 64 + c];
            MOD[(size_t)(l * 9 + b) * 6144 + cb + c] = s; }
        __syncthreads();
    }
}

DI void ld_row_f32(const float* p, int lane, float (&v)[16]) {
#pragma unroll
    for (int j = 0; j < 2; ++j) { const f32x4 a = *(const GAS f32x4*)(p + 512 * j + 8 * lane), b = *(const GAS f32x4*)(p + 512 * j + 8 * lane + 4);
#pragma unroll
        for (int e = 0; e < 4; ++e) { v[8 * j + e] = a[e]; v[8 * j + 4 + e] = b[e]; } }
}
DI void st_row_f32(float* p, int lane, const float (&v)[16]) {
#pragma unroll
    for (int j = 0; j < 2; ++j) { *(GAS f32x4*)(p + 512 * j + 8 * lane) = (f32x4){v[8 * j], v[8 * j + 1], v[8 * j + 2], v[8 * j + 3]}; *(GAS f32x4*)(p + 512 * j + 8 * lane + 4) = (f32x4){v[8 * j + 4], v[8 * j + 5], v[8 * j + 6], v[8 * j + 7]}; }
}
DI void ld_row_bf16(const bf16* p, int lane, float (&v)[16]) {
#pragma unroll
    for (int j = 0; j < 2; ++j) { const v4u a = *(const GAS v4u*)(p + 512 * j + 8 * lane);
        v[8 * j + 0] = bf_lo(a.x); v[8 * j + 1] = bf_hi(a.x); v[8 * j + 2] = bf_lo(a.y); v[8 * j + 3] = bf_hi(a.y); v[8 * j + 4] = bf_lo(a.z); v[8 * j + 5] = bf_hi(a.z); v[8 * j + 6] = bf_lo(a.w); v[8 * j + 7] = bf_hi(a.w); }
}
DI void ld_row_fp8(const unsigned char* p, int lane, float (&v)[16]) {
#pragma unroll
    for (int j = 0; j < 2; ++j) { const v2u a = *(const GAS v2u*)(p + 512 * j + 8 * lane);
        const f32x2 d0 = __builtin_amdgcn_cvt_pk_f32_fp8((int)a.x, false), d1 = __builtin_amdgcn_cvt_pk_f32_fp8((int)a.x, true), d2 = __builtin_amdgcn_cvt_pk_f32_fp8((int)a.y, false), d3 = __builtin_amdgcn_cvt_pk_f32_fp8((int)a.y, true);
        v[8 * j + 0] = d0[0]; v[8 * j + 1] = d0[1]; v[8 * j + 2] = d1[0]; v[8 * j + 3] = d1[1]; v[8 * j + 4] = d2[0]; v[8 * j + 5] = d2[1]; v[8 * j + 6] = d3[0]; v[8 * j + 7] = d3[1]; }
}
DI void st_row_bf16(bf16* p, int lane, const float (&v)[16]) {
#pragma unroll
    for (int j = 0; j < 2; ++j) st16(p + 512 * j + 8 * lane, cvt_pk_bf16(v[8 * j], v[8 * j + 1]), cvt_pk_bf16(v[8 * j + 2], v[8 * j + 3]), cvt_pk_bf16(v[8 * j + 4], v[8 * j + 5]), cvt_pk_bf16(v[8 * j + 6], v[8 * j + 7]));
}
DI int colx(int lane, int j) { return (lane >> 4) * 256 + (lane & 15) * 8 + 128 * j; }
DI void ld_rowx_f32(const float* p, int lane, float (&v)[16]) {
#pragma unroll
    for (int j = 0; j < 2; ++j) { const f32x4 a = *(const GAS f32x4*)(p + colx(lane, j)), b = *(const GAS f32x4*)(p + colx(lane, j) + 4);
#pragma unroll
        for (int e = 0; e < 4; ++e) { v[8 * j + e] = a[e]; v[8 * j + 4 + e] = b[e]; } }
}
DI void st_rowx_f32(float* p, int lane, const float (&v)[16]) {
#pragma unroll
    for (int j = 0; j < 2; ++j) { *(GAS f32x4*)(p + colx(lane, j)) = (f32x4){v[8 * j], v[8 * j + 1], v[8 * j + 2], v[8 * j + 3]}; *(GAS f32x4*)(p + colx(lane, j) + 4) = (f32x4){v[8 * j + 4], v[8 * j + 5], v[8 * j + 6], v[8 * j + 7]}; }
}
DI void st_rowx_bf16(bf16* p, int lane, const float (&v)[16]) {
#pragma unroll
    for (int j = 0; j < 2; ++j) st16(p + colx(lane, j), cvt_pk_bf16(v[8 * j], v[8 * j + 1]), cvt_pk_bf16(v[8 * j + 2], v[8 * j + 3]), cvt_pk_bf16(v[8 * j + 4], v[8 * j + 5]), cvt_pk_bf16(v[8 * j + 6], v[8 * j + 7]));
}
DI float row_sumsq(const float (&v)[16]) { float s = 0.f;
#pragma unroll
    for (int i = 0; i < 16; ++i) s += v[i] * v[i];
    return wave_sum(s); }
DI void norm_mod(const float (&x)[16], float rstd, const float* nw, const float* sh, const float* sc, int lane, float (&u)[16]) {
    float g[16], a[16], b[16]; ld_row_f32(nw, lane, g); ld_row_f32(sh, lane, a); ld_row_f32(sc, lane, b);
#pragma unroll
    for (int i = 0; i < 16; ++i) u[i] = x[i] * rstd * g[i] * (1.f + b[i]) + a[i];
}
DI void u_rows_layer0(Frame& F, bf16* U, const float* xin, const float* ctxin, const float* norms) {
    const int gw = F.vcu * 8 + F.wave, NGW = F.G * 8;
    const float* MOD = (const float*)(F.ws + WS_MOD);
    float av[16], bv[16]; int bcur = -1;
    float xn[16];
    if (gw < NTOK + NCTX) ld_row_f32(gw < NTOK ? xin + (size_t)gw * D : ctxin + (size_t)(gw - NTOK) * D, F.lane, xn);
    for (int m = gw; m < NTOK + NCTX; m += NGW) {
        const bool lat = m < NTOK; const int b = lat ? m / T : 8;
        float x[16], u[16];
#pragma unroll
        for (int i = 0; i < 16; ++i) x[i] = xn[i];
        const int mn = m + NGW;
        if (mn < NTOK + NCTX) ld_row_f32(mn < NTOK ? xin + (size_t)mn * D : ctxin + (size_t)(mn - NTOK) * D, F.lane, xn);
        if (b != bcur) {
            bcur = b; const float* mb = MOD + (size_t)b * 6144; float t1[16], t2[16];
            ld_row_f32(norms, F.lane, t1); ld_row_f32(mb + 1024, F.lane, t2); ld_row_f32(mb, F.lane, bv);
#pragma unroll
            for (int i = 0; i < 16; ++i) av[i] = t1[i] * (1.f + t2[i]);
        }
        const float rstd = rsqrtf(row_sumsq(x) * (1.f / D) + NORM_EPS);
#pragma unroll
        for (int i = 0; i < 16; ++i) u[i] = x[i] * rstd * av[i] + bv[i];
        st_row_bf16(U + (size_t)m * D, F.lane, u);
    }
}

#define MFMA32(a, b, c) __builtin_amdgcn_mfma_f32_32x32x16_bf16((a), (b), (c), 0, 0, 0)
#define MFMA16(a, b, c) __builtin_amdgcn_mfma_f32_16x16x32_bf16((a), (b), (c), 0, 0, 0)
DI int crow(int reg, int h5) { return (reg & 3) + 8 * (reg >> 2) + 4 * h5; }
DI float log2_gamma(const float* decay, int dir, int head) { const float x = decay[dir * NH + head]; return -log2f(1.f + expf(-x)); }

DI void retention_scores(Frame& F, const float* decay) {
    const bf16* Q = (const bf16*)(F.ws + WS_Q); const bf16* K = (const bf16*)(F.ws + WS_K); bf16* P = (bf16*)(F.ws + WS_P);
    const int lane = F.lane, r = lane & 31, h5 = lane >> 5;
    for (int unit = F.vcu; unit < NB * NH * NCHUNK; unit += F.G) {
        const int bh = unit >> 5, c = unit & 31, b = bh >> 2, head = bh & 3;
        const float lf = log2_gamma(decay, 0, head), lb = log2_gamma(decay, 1, head);
        bf16* Pt = P + (size_t)unit * CH * CH;
        {
            const bf16* kb = K + ((size_t)(b * NCHUNK + c) * NH + head) * 32768 + lane * 8;
            const bf16* qb = Q + ((size_t)(b * NCHUNK + c) * NH + head) * 32768;
            __syncthreads();
#pragma unroll
            for (int i = 0; i < 8; ++i) { const int pc = F.wave + 8 * i;
                __builtin_amdgcn_global_load_lds((const unsigned*)(kb + (size_t)pc * 512), (LAS unsigned*)(F.lds + RING_OFF + pc * 1024), 16, 0, 0);
                { const int qit = pc >> 4, qks = pc & 15;
                  __builtin_amdgcn_global_load_lds((const unsigned*)(qb + (size_t)(((2 * qit + (r >> 4)) * 8 + (qks >> 1)) * 64 + (r & 15) + 16 * (2 * (qks & 1) + h5)) * 8), (LAS unsigned*)(F.lds + RING_OFF + 65536 + pc * 1024), 16, 0, 0); } }
            VM_WAIT(); __syncthreads();
        }
#pragma unroll
        for (int tt = 0; tt < 2; ++tt) {
            const int tile = F.wave * 2 + tt, jt = tile >> 2, it = tile & 3;
            const LAS unsigned char* kp = F.lds + RING_OFF + (jt * 16) * 1024 + lane * 16;
            const LAS unsigned char* qp = F.lds + RING_OFF + 65536 + (it * 16) * 1024 + lane * 16;
            f32x16 acc;
#pragma unroll
            for (int i = 0; i < 16; ++i) acc[i] = 0.f;
#pragma unroll
            for (int s = 0; s < 16; ++s) { const bf16x8 a = *(const LAS bf16x8*)(kp + 1024 * s), bq = *(const LAS bf16x8*)(qp + 1024 * s); acc = MFMA32(a, bq, acc); }
            const int i = 32 * it + r;
#pragma unroll
            for (int g = 0; g < 4; ++g) {
                float o[4];
#pragma unroll
                for (int e = 0; e < 4; ++e) { const int j = 32 * jt + 8 * g + 4 * h5 + e; const int dd = i - j;
                    const float w = dd > 0 ? exp2f(lf * (float)dd) : (dd < 0 ? exp2f(lb * (float)(-dd)) : 2.f);
                    o[e] = acc[4 * g + e] * w; }
                v2u pk; pk.x = cvt_pk_bf16(o[0], o[1]); pk.y = cvt_pk_bf16(o[2], o[3]);
                *(GAS v2u*)(Pt + ((size_t)((2 * it + (r >> 4)) * 4 + jt) * 64 + (r & 15) + 16 * g) * 8 + 4 * h5) = pk;
            }
        }
    }
}

DI void dma16_untracked(const void* g, const LAS unsigned char* l) {
    const unsigned la = __builtin_amdgcn_readfirstlane((unsigned)(__UINTPTR_TYPE__)l);
    asm volatile("s_mov_b32 m0, %1\n\ts_nop 0\n\tglobal_load_lds_dwordx4 %0, off" :: "v"(g), "s"(la) : "memory", "m0");
}
constexpr size_t WS_SCANDUMP = 130 * MiB;
constexpr int KSLAB = 0, VPITCH = 192, SPITCH = 528;
constexpr int VIMG = 65536, VSIMG = VIMG + 128 * VPITCH, SIMG = VSIMG + 128 * VPITCH, SCAN_LDS_END = SIMG + 64 * SPITCH;
static_assert(SCAN_LDS_END <= LDSCTL_OFF, "scan LDS");
typedef LAS s16x4 lds_s16x4;
DI const LAS unsigned char* tr_lane_base(const LAS unsigned char* img, int pitch, int lane) {
    const int h5 = lane >> 5, blk = (lane >> 4) & 1, q = (lane & 15) >> 2, p = lane & 3;
    return img + (8 * h5 + q) * pitch + (16 * blk + 4 * p) * 2;
}
DI bf16x8 tr_frag(const LAS unsigned char* lane_base, int off, int pitch) {
    const s16x4 lo = __builtin_amdgcn_ds_read_tr16_b64_v4i16((lds_s16x4*)(lane_base + off));
    const s16x4 hi = __builtin_amdgcn_ds_read_tr16_b64_v4i16((lds_s16x4*)(lane_base + off + 4 * pitch));
    return __builtin_shufflevector(lo, hi, 0, 1, 2, 3, 4, 5, 6, 7);
}
#define WG_BAR() do { asm volatile("s_waitcnt lgkmcnt(0)" ::: "memory"); __builtin_amdgcn_s_barrier(); asm volatile("" ::: "memory"); } while (0)
DI void retention_scan(Frame& F, bf16* Opart, bf16* O, const float* decay, const int variant = 0) {
    const bf16* Qg = (const bf16*)(F.ws + WS_Q); const bf16* Kg = (const bf16*)(F.ws + WS_K); const bf16* Vg = (const bf16*)(F.ws + WS_V);
    const bf16* KCg = (const bf16*)(F.ws + WS_KC); const bf16* VCg = (const bf16*)(F.ws + WS_VC); const bf16* Pg = (const bf16*)(F.ws + WS_P);
    const int lane = F.lane, w = F.wave, tid = F.tid;
    const int it = w >> 1, et = w & 1;
    const LAS unsigned char* trK = tr_lane_base(F.lds + KSLAB + w * 8192, 64, lane);
    const LAS unsigned char* trV = tr_lane_base(F.lds + VIMG, VPITCH, lane);
    const LAS unsigned char* trVS = tr_lane_base(F.lds + VSIMG, VPITCH, lane);
    for (int unit = F.vcu; unit < NB * NH * 8; unit += F.G) {
        const int bh = unit >> 3, eb = unit & 7, b = bh >> 2, head = bh & 3;
        const int vcol = head * DV + eb * 64;
#pragma unroll
        for (int pass = 0; pass < 2; ++pass) {
            const bool fwd = pass == 1;
            const float l2g = log2_gamma(decay, fwd ? 0 : 1, head);
            const float gC = exp2f(l2g * (float)CH);
            f32x16 accS[2];
#pragma unroll
            for (int i = 0; i < 16; ++i) { accS[0][i] = 0.f; accS[1][i] = 0.f; }
            v4u vreg[2];
#define SCAN_SRC(s, kp, vp) do { if ((s) < 2) { const int cc = fwd ? (s) : 1 - (s); kp = KCg + ((size_t)(b * 2 + cc) * NH + head) * 32768; vp = VCg + ((size_t)b * LCTX + cc * CH) * 2048 + vcol; } \
                else { const int cc = fwd ? (s) - 2 : 33 - (s); kp = Kg + ((size_t)(b * NCHUNK + cc) * NH + head) * 32768; vp = Vg + ((size_t)b * T + cc * CH) * 2048 + vcol; } } while (0)
#define SCAN_LOADV(s) do { const bf16* kp_; const bf16* vp_; SCAN_SRC(s, kp_, vp_); (void)kp_; \
                _Pragma("unroll") for (int i = 0; i < 2; ++i) vreg[i] = *(const GAS v4u*)(vp_ + (size_t)((tid >> 3) + 64 * i) * 2048 + (tid & 7) * 8); } while (0)
#define SCAN_LOADK(s) do { const bf16* kp_; const bf16* vp_; SCAN_SRC(s, kp_, vp_); (void)vp_; \
                _Pragma("unroll") for (int i = 0; i < 8; ++i) kreg[i] = *(const GAS v4u*)(kp_ + (unsigned)((((i >> 1) * 16 + 2 * w + ((lane & 3) >> 1)) * 64 + ((16 * i + (lane >> 2)) & 31) + 32 * (lane & 1)) * 8)); } while (0)
#define SCAN_WRITEK() do { _Pragma("unroll") for (int i = 0; i < 8; ++i) *(LAS v4u*)(F.lds + KSLAB + w * 8192 + i * 1024 + lane * 16) = kreg[i]; } while (0)
            v4u kreg[8];
            bf16x8 qf[8], pf[4];
            { int lane_ = lane, tid_ = tid; asm volatile("" : "+v"(lane_), "+v"(tid_));
              const int lane = lane_, tid = tid_; (void)lane; (void)tid;
              SCAN_LOADV(0); asm volatile("" : "+v"(vreg[0]), "+v"(vreg[1]));
              SCAN_LOADK(0); SCAN_WRITEK(); asm volatile("s_waitcnt lgkmcnt(0)" ::: "memory"); }
#pragma unroll 1
            for (int s = 0; s < 34; ++s) {
                int lz = lane, tz = tid; asm volatile("" : "+v"(lz), "+v"(tz));
                const int r = lz & 31, h5 = lz >> 5;
                const unsigned ooff = (unsigned)(4 * h5) * 2048u + (unsigned)r;
#pragma unroll
                for (int i = 0; i < 2; ++i) {
                    const int row = (tz >> 3) + 64 * i;
                    const float dec = exp2f(l2g * (float)(fwd ? (CH - 1 - row) : row));
                    const v4u x = vreg[i]; v4u o;
                    o.x = cvt_pk_bf16(bf_lo(x.x) * dec, bf_hi(x.x) * dec); o.y = cvt_pk_bf16(bf_lo(x.y) * dec, bf_hi(x.y) * dec);
                    o.z = cvt_pk_bf16(bf_lo(x.z) * dec, bf_hi(x.z) * dec); o.w = cvt_pk_bf16(bf_lo(x.w) * dec, bf_hi(x.w) * dec);
                    *(LAS v4u*)(F.lds + VIMG + row * VPITCH + (tz & 7) * 16) = x;
                    *(LAS v4u*)(F.lds + VSIMG + row * VPITCH + (tz & 7) * 16) = o;
                }
#pragma unroll
                for (int e2 = 0; e2 < 2; ++e2)
#pragma unroll
                    for (int g = 0; g < 4; ++g) { v2u pk; pk.x = cvt_pk_bf16(accS[e2][4 * g], accS[e2][4 * g + 1]); pk.y = cvt_pk_bf16(accS[e2][4 * g + 2], accS[e2][4 * g + 3]);
                        *(LAS v2u*)(F.lds + SIMG + (32 * e2 + r) * SPITCH + (32 * w + 8 * g + 4 * h5) * 2) = pk; }
                { const int lane = lz; const int sk = s + 1 < 34 ? s + 1 : 33; SCAN_LOADK(sk); }
                WG_BAR();
                unsigned opk[8];
#pragma unroll
                for (int i = 0; i < 8; ++i) opk[i] = 0u;
                if (s >= 2 && !(variant & 1)) {
                    f32x4 accO[4];
#pragma unroll
                    for (int mt = 0; mt < 4; ++mt) accO[mt] = (f32x4){0.f, 0.f, 0.f, 0.f};
                    {
                        const LAS unsigned char* sp_ = F.lds + SIMG + (lz & 15) * SPITCH + 16 * (lz >> 4);
                        bf16x8 sb[2][4];
#pragma unroll
                        for (int mt = 0; mt < 4; ++mt) sb[0][mt] = *(const LAS bf16x8*)(sp_ + 16 * mt * SPITCH);
#pragma unroll
                        for (int ks = 0; ks < 8; ++ks) {
                            if (ks < 7) {
#pragma unroll
                                for (int mt = 0; mt < 4; ++mt) sb[(ks + 1) & 1][mt] = *(const LAS bf16x8*)(sp_ + 16 * mt * SPITCH + 64 * (ks + 1)); }
                            __builtin_amdgcn_sched_barrier(0);
#pragma unroll
                            for (int mt = 0; mt < 4; ++mt) accO[mt] = MFMA16(sb[ks & 1][mt], qf[ks], accO[mt]);
                            __builtin_amdgcn_sched_barrier(0);
                        }
                    }
                    {
                        const int il = 16 * w + (lz & 15);
                        const float qd = exp2f(l2g * (float)(fwd ? il + 1 : CH - il));
#pragma unroll
                        for (int mt = 0; mt < 4; ++mt) accO[mt] *= qd;
                    }
                    if (fwd) {
                        const LAS unsigned char* vp_ = F.lds + VIMG + (8 * (lz >> 4) + ((lz & 15) >> 2)) * VPITCH + 8 * (lz & 3);
                        bf16x8 vb[2][4];
#pragma unroll
                        for (int mt = 0; mt < 4; ++mt) vb[0][mt] = tr_frag(vp_, 32 * mt, VPITCH);
#pragma unroll
                        for (int ks = 0; ks < 4; ++ks) {
                            if (ks < 3) {
#pragma unroll
                                for (int mt = 0; mt < 4; ++mt) vb[(ks + 1) & 1][mt] = tr_frag(vp_, 32 * (ks + 1) * VPITCH + 32 * mt, VPITCH); }
                            __builtin_amdgcn_sched_barrier(0);
#pragma unroll
                            for (int mt = 0; mt < 4; ++mt) accO[mt] = MFMA16(vb[ks & 1][mt], pf[ks], accO[mt]);
                            __builtin_amdgcn_sched_barrier(0);
                        }
                    }
#pragma unroll
                    for (int mt = 0; mt < 4; ++mt) { opk[2 * mt] = cvt_pk_bf16(accO[mt][0], accO[mt][1]); opk[2 * mt + 1] = cvt_pk_bf16(accO[mt][2], accO[mt][3]); }
                }
                {
                    const int sn = s + 1 < 34 ? s + 1 : 33;
                    const bf16* kp_; const bf16* vp_; SCAN_SRC(sn, kp_, vp_); (void)kp_;
#pragma unroll
                    for (int i = 0; i < 2; ++i) vreg[i] = *(const GAS v4u*)(vp_ + (unsigned)(((tz >> 3) + 64 * i) * 2048 + (tz & 7) * 8));
                    const int cq = sn >= 2 ? (fwd ? sn - 2 : 33 - sn) : (fwd ? 0 : 31);
                    const bf16* qn = Qg + ((((size_t)(b * NCHUNK + cq) * NH + head) * 8 + w) * 8) * 512;
                    const unsigned qoff = (unsigned)lz * 8u;
#pragma unroll
                    for (int ks = 0; ks < 8; ++ks) qf[ks] = *(const GAS bf16x8*)(qn + qoff + 512 * ks);
                    if (fwd) {
                        const bf16* pn = Pg + ((size_t)(bh * NCHUNK + cq) * CH * CH) + (size_t)(w * 4) * 512;
#pragma unroll
                        for (int ks = 0; ks < 4; ++ks) pf[ks] = *(const GAS bf16x8*)(pn + qoff + 512 * ks);
                    }
                }
#pragma unroll
                for (int i = 0; i < 16; ++i) { accS[0][i] *= gC; accS[1][i] *= gC; }
                if (!(variant & 2))
                {
                    bf16x8 ua[2], ub0[2], ub1[2];
                    ua[0] = tr_frag(trK, 0, 64); ub0[0] = tr_frag(trVS, 0, VPITCH); ub1[0] = tr_frag(trVS, 64, VPITCH);
#pragma unroll
                    for (int ks = 0; ks < 8; ++ks) {
                        if (ks < 7) { ua[(ks + 1) & 1] = tr_frag(trK, 16 * (ks + 1) * 64, 64); ub0[(ks + 1) & 1] = tr_frag(trVS, 16 * (ks + 1) * VPITCH, VPITCH); ub1[(ks + 1) & 1] = tr_frag(trVS, 16 * (ks + 1) * VPITCH + 64, VPITCH); }
                        __builtin_amdgcn_sched_barrier(0);
                        accS[0] = MFMA32(ua[ks & 1], ub0[ks & 1], accS[0]); accS[1] = MFMA32(ua[ks & 1], ub1[ks & 1], accS[1]);
                        __builtin_amdgcn_sched_barrier(0);
                    }
                }
                asm volatile("s_waitcnt lgkmcnt(0)" ::: "memory");
                { const int lane = lz; SCAN_WRITEK(); }
                {
                    const int cc = fwd ? s - 2 : 33 - s;
                    const size_t obase = ((size_t)b * T + cc * CH + 16 * w) * 2048 + vcol;
                    GAS unsigned char* dstp = s >= 2 ? (GAS unsigned char*)((fwd ? O : Opart) + obase) : (GAS unsigned char*)(F.ws + WS_SCANDUMP) + (size_t)(16 * w) * 4096;
                    const unsigned so = (unsigned)(lz & 15) * 4096u + (unsigned)(lz >> 4) * 8u;
#pragma unroll
                    for (int mt = 0; mt < 4; ++mt) *(GAS v2u*)(dstp + so + 32 * mt) = (v2u){opk[2 * mt], opk[2 * mt + 1]};
                }
                WG_BAR();
            }
#undef SCAN_SRC
#undef SCAN_LOADV
#undef SCAN_LOADK
#undef SCAN_WRITEK
            VM_WAIT(); __syncthreads();
        }
    }
}
DI void gn_gate_rows(Frame& F, bf16* O, const bf16* G, const bf16* OP) {
    const int gw = F.vcu * 8 + F.wave, NGW = F.G * 8;
    v4u an[4], gn[4], pn[4];
    if (gw < NTOK) {
#pragma unroll
        for (int j = 0; j < 4; ++j) { an[j] = *(const GAS v4u*)(O + (size_t)gw * VTOT + 512 * j + 8 * F.lane); pn[j] = *(const GAS v4u*)(OP + (size_t)gw * VTOT + 512 * j + 8 * F.lane); gn[j] = *(const GAS v4u*)(G + (size_t)gw * VTOT + 512 * j + 8 * F.lane); } }
    for (int m = gw; m < NTOK; m += NGW) {
        bf16* op = O + (size_t)m * VTOT;
        v4u ac[4], gc[4], pc[4];
#pragma unroll
        for (int j = 0; j < 4; ++j) { ac[j] = an[j]; gc[j] = gn[j]; pc[j] = pn[j]; }
        const int mn = m + NGW;
        if (mn < NTOK) {
#pragma unroll
            for (int j = 0; j < 4; ++j) { an[j] = *(const GAS v4u*)(O + (size_t)mn * VTOT + 512 * j + 8 * F.lane); pn[j] = *(const GAS v4u*)(OP + (size_t)mn * VTOT + 512 * j + 8 * F.lane); gn[j] = *(const GAS v4u*)(G + (size_t)mn * VTOT + 512 * j + 8 * F.lane); } }
#pragma unroll
        for (int j = 0; j < 4; ++j) {
            const v4u a = ac[j], g = gc[j], q = pc[j];
            float v[8] = {bf_lo(a.x) + bf_lo(q.x), bf_hi(a.x) + bf_hi(q.x), bf_lo(a.y) + bf_lo(q.y), bf_hi(a.y) + bf_hi(q.y), bf_lo(a.z) + bf_lo(q.z), bf_hi(a.z) + bf_hi(q.z), bf_lo(a.w) + bf_lo(q.w), bf_hi(a.w) + bf_hi(q.w)};
            const float gg[8] = {bf_lo(g.x), bf_hi(g.x), bf_lo(g.y), bf_hi(g.y), bf_lo(g.z), bf_hi(g.z), bf_lo(g.w), bf_hi(g.w)};
            float ss = 0.f;
#pragma unroll
            for (int e = 0; e < 8; ++e) ss += v[e] * v[e];
            const float rstd = rsqrtf(wave_sum(ss) * (1.f / DV) + NORM_EPS);
#pragma unroll
            for (int e = 0; e < 8; ++e) v[e] = v[e] * rstd * gg[e];
            st16(op + 512 * j + 8 * F.lane, cvt_pk_bf16(v[0], v[1]), cvt_pk_bf16(v[2], v[3]), cvt_pk_bf16(v[4], v[5]), cvt_pk_bf16(v[6], v[7]));
        }
    }
}
constexpr size_t WS_WPRIME = 156 * MiB, WS_CPART = WS_MOD + 1 * MiB;
DI void router_prescale(Frame& F, const float* norms, const float* router) {
    const float* MOD = (const float*)(F.ws + WS_MOD);
    bf16* WP = (bf16*)(F.ws + WS_WPRIME); float* CP = (float*)(F.ws + WS_CPART);
    const int gt = F.vcu * 512 + F.tid, NT = F.G * 512;
    for (int i = gt; i < 2 * NB * D * NE; i += NT) {
        const int e = i & 63, k = (i >> 6) & 1023, b = (i >> 16) & 7, l = i >> 19;
        const float v = norms[(l * 4 + 2) * D + k] * (1.f + MOD[(size_t)(l * 9 + b) * 6144 + 4 * D + k]) * router[((size_t)l * D + k) * NE + e];
        const bf16 hi = f2bf(v), lo = f2bf(v - bf2f(hi));
        const size_t o = (size_t)(l * NB + b) * 131072 + ((size_t)((e >> 5) * 64 + (k >> 4)) * 64 + (e & 31) + 32 * ((k >> 3) & 1)) * 8 + (k & 7);
        WP[o] = hi; WP[o + 65536] = lo;
    }
    const int gw = F.vcu * 8 + F.wave, NGW = F.G * 8;
    for (int t = gw; t < 2 * NB * 16; t += NGW) {
        const int ch = t & 15, b = (t >> 4) & 7, l = t >> 7;
        float a = 0.f;
#pragma unroll 8
        for (int kk = 0; kk < 64; ++kk) { const int k = ch * 64 + kk; a += MOD[(size_t)(l * 9 + b) * 6144 + 3 * D + k] * router[((size_t)l * D + k) * NE + F.lane]; }
        CP[(size_t)t * 64 + F.lane] = a;
    }
}
DI void rows_router(Frame& F, int layer, const float* hin, const bf16* Y, bf16* U, const float* norms, const float* mbias, float* hout, const int variant = 0, const int cl = 0) {
    const float* MOD = (const float*)(F.ws + WS_MOD) + (size_t)layer * 9 * 6144;
    const float* nrm = norms + (size_t)layer * 4 * D;
    constexpr int UP = 2064;
    LAS unsigned char* uhi = F.lds + RING_OFF; LAS unsigned char* ulo = uhi + 32 * UP;
    LAS float* plg = (LAS float*)uhi;
    LAS float* rstdl = (LAS float*)(ulo + 32 * UP);
    LAS int* bcnt = (LAS int*)(rstdl + 32); LAS int* bbase = bcnt + 64;
    LAS int* park = bbase + 64;
    const int lane = F.lane, w = F.wave;
    const float mybias = mbias[layer * NE + lane];
    unsigned char* lb = F.ws + WS_LIST;
    if (F.tid < 64) bcnt[F.tid] = 0;
    int nblk = 0;
    float yA[16], hA[16], yB[16], hB[16];
    if (F.vcu < NTOK / 32 && !(variant & 1)) { const int mf = F.vcu * 32 + w * 4;
        ld_row_bf16(Y + (size_t)mf * D, lane, yA); ld_row_f32(hin + (size_t)mf * D, lane, hA); ld_row_bf16(Y + (size_t)(mf + 1) * D, lane, yB); ld_row_f32(hin + (size_t)(mf + 1) * D, lane, hB); }
    for (int blk = F.vcu; blk < NTOK / 32; blk += F.G, ++nblk) {
        const int m0 = blk * 32, b = m0 / T;
        const float* mb = MOD + (size_t)b * 6144;
        float csum = 0.f;
        { const float* cp = (const float*)(F.ws + WS_CPART) + (size_t)((layer * NB + b) * 16) * 64 + lane;
#pragma unroll
          for (int ch = 0; ch < 16; ++ch) csum += cp[ch * 64]; }
        if (!(variant & 1)) {
            float gg[16], av[16], bv[16];
            { float t1[16], t2[16]; ld_row_f32(nrm + D, lane, t1); ld_row_f32(mb + 2 * D, lane, t2);
#pragma unroll
              for (int i = 0; i < 16; ++i) gg[i] = t1[i] * t2[i];
              ld_row_f32(nrm + 2 * D, lane, t1); ld_row_f32(mb + 4 * D, lane, t2); ld_row_f32(mb + 3 * D, lane, bv);
#pragma unroll
              for (int i = 0; i < 16; ++i) av[i] = t1[i] * (1.f + t2[i]); }
            const int mnext = (blk + F.G) * 32;
            const bool hasnext = blk + F.G < NTOK / 32;
#pragma unroll
            for (int rr = 0; rr < 4; ++rr) {
                const int rl = w * 4 + rr, m = m0 + rl;
                float y[16], h[16], u[16];
#pragma unroll
                for (int i = 0; i < 16; ++i) { y[i] = (rr & 1) ? yB[i] : yA[i]; h[i] = (rr & 1) ? hB[i] : hA[i]; }
                {
                    const int mr = rr < 2 ? m + 2 : mnext + w * 4 + (rr - 2);
                    if (rr < 2 || hasnext) {
                        if (rr & 1) { ld_row_bf16(Y + (size_t)mr * D, lane, yB); ld_row_f32(hin + (size_t)mr * D, lane, hB); }
                        else        { ld_row_bf16(Y + (size_t)mr * D, lane, yA); ld_row_f32(hin + (size_t)mr * D, lane, hA); }
                    }
                }
                const float rs1 = rsqrtf(row_sumsq(y) * (1.f / D) + NORM_EPS);
#pragma unroll
                for (int i = 0; i < 16; ++i) h[i] += gg[i] * (y[i] * rs1);
                st_row_f32(hout + (size_t)m * D, lane, h);
                const float rs2 = rsqrtf(row_sumsq(h) * (1.f / D) + NORM_EPS);
#pragma unroll
                for (int i = 0; i < 16; ++i) u[i] = h[i] * rs2 * av[i] + bv[i];
                st_row_bf16(U + (size_t)m * D, lane, u);
#pragma unroll
                for (int j = 0; j < 2; ++j) {
                    unsigned hh[4], ll[4];
#pragma unroll
                    for (int e = 0; e < 4; ++e) { const float x0 = h[8 * j + 2 * e], x1 = h[8 * j + 2 * e + 1]; const unsigned ph = cvt_pk_bf16(x0, x1); hh[e] = ph; ll[e] = cvt_pk_bf16(x0 - bf_lo(ph), x1 - bf_hi(ph)); }
                    *(LAS v4u*)(uhi + rl * UP + (512 * j + 8 * lane) * 2) = (v4u){hh[0], hh[1], hh[2], hh[3]};
                    *(LAS v4u*)(ulo + rl * UP + (512 * j + 8 * lane) * 2) = (v4u){ll[0], ll[1], ll[2], ll[3]};
                }
                if (lane == 0) rstdl[rl] = rs2;
            }
        }
        __syncthreads();
        if (!(variant & 2)) {
            const int kq = w >> 1, et = w & 1, r = lane & 31, h5 = lane >> 5;
            const bf16* wph = (const bf16*)(F.ws + WS_WPRIME) + (size_t)(layer * NB + b) * 131072 + ((size_t)(et * 64 + 16 * kq) * 64 + lane) * 8;
            f32x16 acc;
#pragma unroll
            for (int i = 0; i < 16; ++i) acc[i] = 0.f;
            bf16x8 bh[16], bl[16];
#pragma unroll
            for (int ks = 0; ks < 16; ++ks) { bh[ks] = *(const GAS bf16x8*)(wph + 512 * ks); bl[ks] = *(const GAS bf16x8*)(wph + 65536 + 512 * ks); }
            __builtin_amdgcn_sched_barrier(0);
#pragma unroll
            for (int ks = 0; ks < 16; ++ks) {
                const bf16x8 ah = *(const LAS bf16x8*)(uhi + r * UP + (256 * kq + 16 * ks + 8 * h5) * 2), al = *(const LAS bf16x8*)(ulo + r * UP + (256 * kq + 16 * ks + 8 * h5) * 2);
                acc = MFMA32(ah, bh[ks], acc); acc = MFMA32(ah, bl[ks], acc); acc = MFMA32(al, bh[ks], acc);
            }
            __syncthreads();
#pragma unroll
            for (int i = 0; i < 16; ++i) plg[(kq * 32 + crow(i, h5)) * 65 + 32 * et + r] = acc[i];
        }
        __syncthreads();
        int lc = lane; asm volatile("" : "+v"(lc));
        float wgt[4]; int ksl[4], ipos[4];
#pragma unroll
        for (int rr = 0; rr < 4; ++rr) { ksl[rr] = -1; wgt[rr] = 0.f; ipos[rr] = 0; }
        if (!(variant & 4))
#pragma unroll
        for (int rr = 0; rr < 4; ++rr) {
            const int rl = w * 4 + rr;
            const float lg = rstdl[rl] * (plg[rl * 65 + lc] + plg[(32 + rl) * 65 + lc] + plg[(64 + rl) * 65 + lc] + plg[(96 + rl) * 65 + lc]) + csum;
            const float sc = sigmoidf_(lg), bs = sc + mybias;
            const float NINF = -__builtin_inff();
            const float m1 = grp8_max(bs);
            const bool ism = bs == m1;
            const float nm = grp8_sum(ism ? 1.f : 0.f);
            const float rest = grp8_max(ism ? NINF : bs);
            const float gs = m1 + (nm >= 2.f ? m1 : rest);
            int grk = 0; const int grp = lc >> 3;
#pragma unroll
            for (int g = 0; g < 8; ++g) { const float o = __builtin_bit_cast(float, __builtin_amdgcn_readlane(__builtin_bit_cast(int, gs), 8 * g)); grk += (o > gs || (o == gs && g < grp)) ? 1 : 0; }
            const bool gsel = grk < 4;
            float cur = gsel ? bs : NINF;
            bool sel = false;
#pragma unroll
            for (int t8 = 0; t8 < TOPK; ++t8) {
                const float mx = wave_max(cur);
                const unsigned long long eq = __builtin_amdgcn_ballot_w64(cur == mx);
                const int first = __builtin_ctzll(eq);
                const bool isf = lc == first;
                sel = sel || isf; cur = isf ? NINF : cur;
            }
            const float ssum = wave_sum(sel ? sc : 0.f);
            const unsigned long long bal = __ballot(sel);
            ksl[rr] = sel ? __popcll(bal & ((1ull << lc) - 1ull)) : -1;
            wgt[rr] = sc / ssum * 2.5f;
            ipos[rr] = sel ? __hip_atomic_fetch_add(bcnt + lc, 1, __ATOMIC_RELAXED, __HIP_MEMORY_SCOPE_WORKGROUP) : 0;
        }
#pragma unroll
        for (int rr = 0; rr < 4; ++rr) if (ksl[rr] >= 0) { const int pi = ((nblk * 32 + w * 4 + rr) * 8 + ksl[rr]) * 2; park[pi] = lc | (ipos[rr] << 8); park[pi + 1] = __builtin_bit_cast(int, wgt[rr]); }
        __syncthreads();
    }
    if (w == 0) { const int n = bcnt[lane]; bbase[lane] = n ? (int)atomicAdd(F.ctl + cnt_word(layer + cl, 0, lane), (unsigned)n) : 0; }
    __syncthreads();
    for (int k = 0; k < nblk; ++k) {
        const int m0 = (F.vcu + k * F.G) * 32;
#pragma unroll 1
        for (int rr = 0; rr < 4; ++rr) {
            const int m = m0 + w * 4 + rr;
            if (lane < 8) {
                const int pi = ((k * 32 + w * 4 + rr) * 8 + lane) * 2; const int pe = park[pi]; const float wv = __builtin_bit_cast(float, park[pi + 1]);
                const int e = pe & 0xff, pos = bbase[e] + (pe >> 8);
                ((int*)lb)[(size_t)e * ECAP + pos] = m;
                ((int*)(lb + LIST_ARR))[m * 8 + lane] = (e << 16) | pos; ((float*)(lb + 2 * LIST_ARR))[m * 8 + lane] = wv;
            }
            if (lane == 0) ((int*)lb)[(size_t)NE * ECAP + m] = m;
        }
    }
    __syncthreads();
}

DI void moe_tables(Frame& F, int layer, int slice) {
    LAS int* cum = (LAS int*)(F.lds + LDSCTL_OFF); LAS int* cnt = (LAS int*)(F.lds + LDSCTL_OFF + 272); LAS int* rb = (LAS int*)(F.lds + LDSCTL_OFF + 544);
    __syncthreads();
    if (F.wave == 0) {
        const int lane = F.lane;
        const int n = (int)__hip_atomic_load(F.ctl + cnt_word(layer, slice, lane), RLX_AGENT);
        int pb = (n + 255) >> 8, pr = n;
#pragma unroll
        for (int d = 1; d < 64; d <<= 1) {
            const int ob = __builtin_amdgcn_ds_bpermute((lane - d) << 2, pb), orr = __builtin_amdgcn_ds_bpermute((lane - d) << 2, pr);
            if (lane >= d) { pb += ob; pr += orr; }
        }
        cnt[lane] = n; cum[lane] = pb - ((n + 255) >> 8); rb[lane] = pr - n;
        if (lane == 63) { cnt[NE] = SLTOK; cum[NE] = pb; rb[NE] = pr; cum[NEX] = pb + ((SLTOK + 255) >> 8); rb[NEX] = pr + SLTOK; }
    }
    __syncthreads();
    {
        LAS unsigned char* eob = (LAS unsigned char*)(F.lds + LDSCTL_OFF + 1536); const int nb = cum[NEX];
        for (int blk = F.tid; blk < nb; blk += 512) { int e = 0, hi_ = NEX;
#pragma unroll
            for (int it = 0; it < 7; ++it) { const int mid = (e + hi_) >> 1; if (cum[mid] <= blk) e = mid; else hi_ = mid; }
            eob[blk] = (unsigned char)e; }
    }
    __syncthreads();
}
DI void moe_gemm1(Frame& F, int layer, int slice) {
    moe_tables(F, layer, slice);
    const LAS int* cum = (const LAS int*)(F.lds + LDSCTL_OFF); const LAS int* cnt = (const LAS int*)(F.lds + LDSCTL_OFF + 272); const LAS int* rb = (const LAS int*)(F.lds + LDSCTL_OFF + 544);
    unsigned char* lb = F.ws + WS_LIST + (size_t)slice * LIST_SLICE;
    pg8::Gemm g{(const bf16*)(F.ws + WS_U), (const bf16*)(F.ws + WS_W13), 1024};
    MoeOrder S{cum, cnt, rb, (const LAS unsigned char*)(F.lds + LDSCTL_OFF + 1536), (const int*)lb, 2, F.G, F.vcu, cum[NEX] * 2};
    EpiSwiGLU E{(bf16*)(F.ws + WS_ACT)};
    pg8::gemm_phase<EpiSwiGLU, MoeOrder, true>(F.lds + RING_OFF, g, S, E, F.tid, STAG_G1);
}
DI void moe_gemm2(Frame& F, int layer, int slice, int nostore = 0) {
    moe_tables(F, layer, slice);
    const LAS int* cum = (const LAS int*)(F.lds + LDSCTL_OFF); const LAS int* cnt = (const LAS int*)(F.lds + LDSCTL_OFF + 272); const LAS int* rb = (const LAS int*)(F.lds + LDSCTL_OFF + 544);
    pg8::Gemm g{(const bf16*)(F.ws + WS_ACT), (const bf16*)(F.ws + WS_W2), 256};
    MoeOrder S{cum, cnt, rb, (const LAS unsigned char*)(F.lds + LDSCTL_OFF + 1536), nullptr, 4, F.G, F.vcu, cum[NEX] * 4};
    EpiMoeOut E{F.ws + WS_Y2, nostore};
    pg8::gemm_phase<EpiMoeOut, MoeOrder, false>(F.lds + RING_OFF, g, S, E, F.tid, STAG_G2);
}
DI void moe_combine(Frame& F, int layer, int slice, bool last_layer, const float* norms) {
    moe_tables(F, layer, slice);
    const LAS int* rb = (const LAS int*)(F.lds + LDSCTL_OFF + 544);
    const int gw = F.vcu * 8 + F.wave, NGW = F.G * 8, lane = F.lane;
    const float* MOD = (const float*)(F.ws + WS_MOD);
    const unsigned char* Y2 = F.ws + WS_Y2; bf16* U = (bf16*)(F.ws + WS_UC);
    const unsigned char* lb = F.ws + WS_LIST + (size_t)slice * LIST_SLICE;
    const int* slot = (const int*)(lb + LIST_ARR); const float* wts = (const float*)(lb + 2 * LIST_ARR);
    float g3[16]; ld_rowx_f32(norms + (size_t)(layer * 4 + 3) * D, lane, g3);
    for (int ml0 = gw; ml0 < SLTOK; ml0 += 2 * NGW) {
        int lz = F.lane; asm volatile("" : "+v"(lz));
        int mm[2]; v4u rw[2][9]; float wk[2][8];
#pragma unroll
        for (int t = 0; t < 2; ++t) {
            const int ml = ml0 + t * NGW; mm[t] = ml < SLTOK ? ml : ml0;
            const int sv = slot[mm[t] * 8 + (lz & 7)]; const float wv = wts[mm[t] * 8 + (lz & 7)];
            const int myrow = rb[sv >> 16] + (sv & 0xffff);
#pragma unroll
            for (int k = 0; k < 8; ++k) { const int row = __builtin_amdgcn_readlane(myrow, k); wk[t][k] = __builtin_bit_cast(float, __builtin_amdgcn_readlane(__builtin_bit_cast(int, wv), k));
                rw[t][k] = *(const GAS v4u*)(Y2 + (size_t)row * D + (unsigned)(16 * lz)); }
            rw[t][8] = *(const GAS v4u*)(Y2 + ((size_t)SLTOK * 8 + mm[t]) * D + 16 * lz);
        }
        float o[2][16];
#pragma unroll
        for (int t = 0; t < 2; ++t) {
#pragma unroll
            for (int i = 0; i < 16; ++i) o[t][i] = 0.f;
#pragma unroll
            for (int k = 0; k < 9; ++k) { const float w = k < 8 ? wk[t][k < 8 ? k : 0] : 1.f;
#pragma unroll
                for (int j = 0; j < 2; ++j) { v2u a; a.x = j ? rw[t][k].z : rw[t][k].x; a.y = j ? rw[t][k].w : rw[t][k].y;
                    const f32x2 d0 = __builtin_amdgcn_cvt_pk_f32_fp8((int)a.x, false), d1 = __builtin_amdgcn_cvt_pk_f32_fp8((int)a.x, true), d2 = __builtin_amdgcn_cvt_pk_f32_fp8((int)a.y, false), d3 = __builtin_amdgcn_cvt_pk_f32_fp8((int)a.y, true);
                    o[t][8 * j + 0] += w * d0[0]; o[t][8 * j + 1] += w * d0[1]; o[t][8 * j + 2] += w * d1[0]; o[t][8 * j + 3] += w * d1[1]; o[t][8 * j + 4] += w * d2[0]; o[t][8 * j + 5] += w * d2[1]; o[t][8 * j + 6] += w * d3[0]; o[t][8 * j + 7] += w * d3[1]; } }
        }
        float h[2][16], gf[2][16];
#pragma unroll
        for (int t = 0; t < 2; ++t) { const int m = slice * SLTOK + mm[t]; ld_rowx_f32(F.out + (size_t)m * D, lz, h[t]); ld_rowx_f32(MOD + ((size_t)(layer * 9 + m / T)) * 6144 + 5 * D, lz, gf[t]); }
#pragma unroll
        for (int t = 0; t < 2; ++t) {
            if (ml0 + t * NGW >= SLTOK) break;
            const int m = slice * SLTOK + mm[t], b = m / T;
            const float rs = rsqrtf(row_sumsq(o[t]) * (1.f / D) + NORM_EPS);
#pragma unroll
            for (int i = 0; i < 16; ++i) h[t][i] += gf[t][i] * (o[t][i] * rs * g3[i]);
            st_rowx_f32(F.out + (size_t)m * D, lz, h[t]);
            if (!last_layer) {
                const float rs2 = rsqrtf(row_sumsq(h[t]) * (1.f / D) + NORM_EPS);
                const float* mb = MOD + ((size_t)((layer + 1) * 9 + b)) * 6144;
                float u[16], ng[16], na[16], nb[16]; ld_rowx_f32(norms + (size_t)((layer + 1) * 4) * D, lz, ng); ld_rowx_f32(mb, lz, na); ld_rowx_f32(mb + D, lz, nb);
#pragma unroll
                for (int i = 0; i < 16; ++i) u[i] = h[t][i] * rs2 * ng[i] * (1.f + nb[i]) + na[i];
                st_rowx_bf16(U + (size_t)m * D, lz, u);
            }
        }
    }
}

DI void dwconv_ln(Frame& F, const bf16* Z, bf16* C, const float* dw, const float* bdwp, const float* lngp, const float* lnbp) {
    LAS float* red = (LAS float*)(F.lds + RING_OFF);
    LAS float* tot = red + 32 * 528;
    const int tid = F.tid, c0 = 2 * tid;
    const f32x2 bdw = *(const GAS f32x2*)(bdwp + c0), lg = *(const GAS f32x2*)(lngp + c0), lb = *(const GAS f32x2*)(lnbp + c0);
    f32x2 kk[31];
#pragma unroll
    for (int w = 0; w < 31; ++w) kk[w] = *(const GAS f32x2*)(dw + w * D + c0);
    for (int run = F.vcu; run < NTOK / 128; run += F.G) {
        const int mrun = run * 128, trun = mrun & (T - 1);
        f32x2 zz[46]; unsigned zn[16];
        { unsigned z[46];
#pragma unroll
          for (int i = 0; i < 46; ++i) { const int t = trun - 15 + i; z[i] = (t >= 0 && t < T) ? *(const GAS unsigned*)(Z + (size_t)(mrun - 15 + i) * D + c0) : 0u; }
#pragma unroll
          for (int i = 0; i < 46; ++i) zz[i] = (f32x2){bf_lo(z[i]), bf_hi(z[i])}; }
#pragma unroll 1
        for (int j = 0; j < 8; ++j) {
            const int m0 = mrun + 16 * j, t0 = trun + 16 * j;
            if (j + 1 < 8) {
#pragma unroll
                for (int i = 0; i < 16; ++i) { const int t = t0 + 31 + i; zn[i] = (t < T) ? *(const GAS unsigned*)(Z + (size_t)(m0 + 31 + i) * D + c0) : 0u; }
            }
            f32x2 acc2[16];
#pragma unroll
            for (int i = 0; i < 16; ++i) acc2[i] = bdw;
#pragma unroll
            for (int w = 0; w < 31; ++w)
#pragma unroll
                for (int i = 0; i < 16; ++i) acc2[i] = __builtin_elementwise_fma(zz[i + w], kk[w], acc2[i]);
            __syncthreads();
#pragma unroll
            for (int i = 0; i < 16; ++i) { red[i * 528 + tid] = acc2[i][0] + acc2[i][1]; red[(16 + i) * 528 + tid] = acc2[i][0] * acc2[i][0] + acc2[i][1] * acc2[i][1]; }
            __syncthreads();
            { const int tk = tid >> 5, which = (tid >> 4) & 1, pp = tid & 15; float acc_ = 0.f;
              const LAS float* rp = red + (which * 16 + tk) * 528 + pp;
#pragma unroll
              for (int k = 0; k < 32; ++k) acc_ += rp[16 * k];
              acc_ += lane_xor(acc_, tid & 63, 1); acc_ += lane_xor(acc_, tid & 63, 2); acc_ += lane_xor(acc_, tid & 63, 4); acc_ += lane_xor(acc_, tid & 63, 8);
              const float oth = lane_xor(acc_, tid & 63, 16);
              if ((tid & 31) == 0) { const float mu = acc_ * (1.f / D), var = oth * (1.f / D) - mu * mu; tot[2 * tk] = mu; tot[2 * tk + 1] = rsqrtf(fmaxf(var, 0.f) + LN_EPS); } }
            __syncthreads();
#pragma unroll
            for (int i = 0; i < 16; ++i) {
                const float mu = tot[2 * i], rstd = tot[2 * i + 1];
                const float v0 = (acc2[i][0] - mu) * rstd * lg[0] + lb[0], v1 = (acc2[i][1] - mu) * rstd * lg[1] + lb[1];
                *(GAS unsigned*)(C + (size_t)(m0 + i) * D + c0) = cvt_pk_bf16(siluf_(v0), siluf_(v1));
            }
#pragma unroll
            for (int i = 0; i < 30; ++i) zz[i] = zz[i + 16];
#pragma unroll
            for (int i = 0; i < 16; ++i) zz[30 + i] = (f32x2){bf_lo(zn[i]), bf_hi(zn[i])};
        }
    }
}

constexpr int N_PHASES = 18;
struct Args { const float* in[26]; float* out; unsigned char* ws; int ph_lo, ph_hi; };
#define INP(i) ([&]() -> const float* { int j_ = (i); asm volatile("" : "+s"(j_)); return args.in[j_]; }())
__global__ void __launch_bounds__(512, 2) fwd_kernel(Args args) {
    extern __shared__ __attribute__((aligned(16))) unsigned char lds[];
    Frame F;
    F.lds = (LAS unsigned char*)lds;
    F.MISC = (volatile LAS unsigned*)(F.lds + MISC_OFF);
    F.tid = threadIdx.x; F.lane = F.tid & 63; F.wave = __builtin_amdgcn_readfirstlane(F.tid >> 6);
    F.G = gridDim.x; { const int bx = blockIdx.x; F.vcu = (F.G % 8 == 0) ? (bx % 8) * (F.G / 8) + bx / 8 : bx; }
    F.ws = args.ws; F.ctl = (unsigned*)(args.ws + WS_CTL); F.out = args.out;
    for (int u = F.tid; u < (LDS_BYTES - LDSCTL_OFF) / 4; u += 512) ((LAS unsigned*)(F.lds + LDSCTL_OFF))[u] = 0u;
    __syncthreads();
    const int wave_s = __builtin_amdgcn_readfirstlane(threadIdx.x >> 6);
    const int lo = args.ph_lo, hi = args.ph_hi;
    XcdBarrier bar; bar.bar = F.ctl + CW_BAR; bar.x = 0; bar.st = nullptr;
    if (hi - lo > 1) bar = xcd_barrier_post(F.ctl + CW_BAR, F.MISC + 8);
    int ph = 0;
#ifdef PROBE_A
    volatile LAS unsigned long long* stampv = (volatile LAS unsigned long long*)(F.lds + LDSCTL_OFF + 1280);
    if (blockIdx.x == 0 && F.tid == 0) stampv[0] = __builtin_amdgcn_s_memrealtime();
#define STAMP() do { if (blockIdx.x == 0 && F.tid == 0) stampv[ph + 1] = __builtin_amdgcn_s_memrealtime(); } while (0)
#else
#define STAMP() do { } while (0)
#endif
#define FRESH() do { int lz_; asm volatile("v_mbcnt_lo_u32_b32 %0, -1, 0\n\tv_mbcnt_hi_u32_b32 %0, -1, %0" : "=&v"(lz_)); F.lane = lz_; F.wave = wave_s; F.tid = wave_s * 64 + lz_;     \
        unsigned char* w_ = args.ws; float* o_ = args.out; asm volatile("" : "+s"(w_), "+s"(o_)); F.ws = w_; F.ctl = (unsigned*)(w_ + WS_CTL); F.out = o_; ws = w_; U0 = (bf16*)o_; OPART = (bf16*)o_; Ob = (bf16*)(w_ + WS_V); } while (0)
#define PH_BEGIN if (lo <= ph && ph < hi) { FRESH();
#define PH_END } if (lo <= ph && ph + 1 < hi) xcd_barrier(bar, F.tid == 0); STAMP(); ++ph;
    unsigned char* ws; bf16 *U0, *OPART, *Ob;

    PH_BEGIN mod_vectors(F, INP(I_C), INP(I_CCTX), INP(I_MODW), INP(I_MODB)); rope_tables(F); conv_small_weights(F, INP(I_RWIN), INP(I_RWOUT), INP(I_CW1), INP(I_CW2));
             conv_moe_weights(F, 0, INP(I_MW1), INP(I_MW3), INP(I_MW2), INP(I_SW1), INP(I_SW3), INP(I_SW2)); PH_END
    PH_BEGIN u_rows_layer0(F, U0, INP(I_X), INP(I_CTX), INP(I_NORMS)); router_prescale(F, INP(I_NORMS), INP(I_ROUTER)); PH_END
    PH_BEGIN
        pg8::Gemm g{U0, (const bf16*)(ws + WS_WIN), 1024}; InprojOrder S; S.init(F.G, (int)blockIdx.x);
        EpiQKVG E{ws};
        pg8::gemm_phase<EpiQKVG, InprojOrder, false>(F.lds + RING_OFF, g, S, E, F.tid, STAG_IN);
    PH_END
    PH_BEGIN retention_scores(F, INP(I_RDECAY)); PH_END
    PH_BEGIN retention_scan(F, OPART, Ob, INP(I_RDECAY)); PH_END
    PH_BEGIN gn_gate_rows(F, Ob, (const bf16*)(ws + WS_G), OPART); PH_END
    PH_BEGIN
        pg8::Gemm g{Ob, (const bf16*)(ws + WS_WOUT), 2048}; pg8::StaticOrder S; S.init(NTOK, D, F.G, (int)blockIdx.x);
        EpiBf16 E{(bf16*)(ws + WS_Y), D, nullptr};
        pg8::gemm_phase<EpiBf16, pg8::StaticOrder, false>(F.lds + RING_OFF, g, S, E, F.tid, STAG_PL);
    PH_END
#pragma unroll 1
    for (int layer = 0; layer < 2; ++layer) {
        if (layer == 1) {
            PH_BEGIN
                pg8::Gemm g{(const bf16*)(ws + WS_UC), (const bf16*)(ws + WS_CW1), 1024}; pg8::StaticOrder S; S.init(NTOK, 2048, F.G, (int)blockIdx.x);
                EpiGLU E{(bf16*)(ws + WS_Z), INP(I_CB1)};
                pg8::gemm_phase<EpiGLU, pg8::StaticOrder, false>(F.lds + RING_OFF, g, S, E, F.tid, STAG_PL);
            PH_END
            PH_BEGIN dwconv_ln(F, (const bf16*)(ws + WS_Z), (bf16*)(ws + WS_C), INP(I_CDW), INP(I_CBDW), INP(I_CLNG), INP(I_CLNB)); PH_END
            PH_BEGIN
                pg8::Gemm g{(const bf16*)(ws + WS_C), (const bf16*)(ws + WS_CW2), 1024}; pg8::StaticOrder S; S.init(NTOK, D, F.G, (int)blockIdx.x);
                EpiBf16 E{(bf16*)(ws + WS_Y1), D, INP(I_CB2)};
                pg8::gemm_phase<EpiBf16, pg8::StaticOrder, false>(F.lds + RING_OFF, g, S, E, F.tid, STAG_PL);
            PH_END
        }
        PH_BEGIN rows_router(F, layer, layer ? (const float*)F.out : INP(I_X), (const bf16*)(ws + (layer ? WS_Y1 : WS_Y)), (bf16*)(ws + WS_U), INP(I_NORMS), INP(I_MBIAS), F.out); PH_END
        PH_BEGIN moe_gemm1(F, layer, 0); PH_END
        PH_BEGIN moe_gemm2(F, layer, 0); PH_END
        PH_BEGIN moe_combine(F, layer, 0, layer == 1, INP(I_NORMS));
                 if (layer == 0) conv_moe_weights(F, 1, INP(I_MW1), INP(I_MW3), INP(I_MW2), INP(I_SW1), INP(I_SW3), INP(I_SW2)); PH_END
    }
#ifdef PROBE_A
    if (blockIdx.x == 0 && F.tid == 0) {
        const unsigned long long tend = __builtin_amdgcn_s_memrealtime();
        unsigned long long sa = 0, sb = 0;
        for (int k = 0; k < N_PHASES; ++k) { const unsigned long long d = stampv[k + 1] - stampv[k]; if ((PROBE_A >> k) & 1u) sa += d; if ((PROBE_B >> k) & 1u) sb += d; }
        if (sb) { VM_WAIT(); F.out[0] += (float)sb * 0.001f; }
        while (__builtin_amdgcn_s_memrealtime() - tend < 8ull * sa) __builtin_amdgcn_s_sleep(8);
    }
#endif
#undef PH_BEGIN
#undef PH_END
}

extern "C" void kernel_launch(void* const* d_in, const int* in_sizes, int n_in, void* d_out, int out_size, void* d_ws, size_t ws_size, hipStream_t stream) {
    static int grid = 0;
    if (grid == 0) {
        if (n_in != 26 || in_sizes[0] != NTOK * D || out_size != NTOK * D || ws_size < WS_END) {
            fprintf(stderr, "kernel_launch: unexpected shapes / workspace (n_in %d, ws %zu, need %zu); nothing launched\n", n_in, ws_size, (size_t)WS_END); grid = -1; return; }
        int dev = 0, cus = 0, per_cu = 0;
        if (hipGetDevice(&dev) != hipSuccess || hipDeviceGetAttribute(&cus, hipDeviceAttributeMultiprocessorCount, dev) != hipSuccess) { grid = -1; return; }
        if (hipFuncSetAttribute((const void*)fwd_kernel, hipFuncAttributeMaxDynamicSharedMemorySize, LDS_BYTES) != hipSuccess) { fprintf(stderr, "kernel_launch: hipFuncSetAttribute failed\n"); grid = -1; return; }
        if (hipOccupancyMaxActiveBlocksPerMultiprocessor(&per_cu, (const void*)fwd_kernel, 512, LDS_BYTES) != hipSuccess || per_cu < 1) { fprintf(stderr, "kernel_launch: occupancy query says %d\n", per_cu); }
        (void)hipGetLastError();
        if (cus < 160) { fprintf(stderr, "kernel_launch: %d CUs: this kernel's per-workgroup tables are sized for >= 160 workgroups; nothing launched\n", cus); grid = -1; return; }
        grid = cus;
    }
    if (grid < 0) return;
    (void)hipMemsetAsync((char*)d_ws + WS_CTL, 0, CTL_ZERO_BYTES, stream);
    Args a{};
    for (int i = 0; i < 26; ++i) a.in[i] = (const float*)d_in[i];
    a.out = (float*)d_out; a.ws = (unsigned char*)d_ws;
#if MK_ONE_LAUNCH
    a.ph_lo = 0; a.ph_hi = N_PHASES;
    hipLaunchKernelGGL(fwd_kernel, dim3(grid), dim3(512), LDS_BYTES, stream, a);
#else
    for (int p = 0; p < N_PHASES; ++p) { a.ph_lo = p; a.ph_hi = p + 1; hipLaunchKernelGGL(fwd_kernel, dim3(grid), dim3(512), LDS_BYTES, stream, a); }
#endif
}
```

```cpp
#include <hip/hip_runtime.h>
#include <cstdio>
#include <cstdint>

#define STAG_G1 0
#define STAG_G2 0
#define STAG_IN 5
#define STAG_PL 0
#ifndef MK_ONE_LAUNCH
#define MK_ONE_LAUNCH 1
#endif

#define GAS __attribute__((address_space(1)))
#define LAS __attribute__((address_space(3)))
typedef unsigned short bf16;
typedef unsigned v4u __attribute__((ext_vector_type(4)));
typedef unsigned v2u __attribute__((ext_vector_type(2)));
typedef float f32x4 __attribute__((ext_vector_type(4)));
typedef float f32x2 __attribute__((ext_vector_type(2)));
typedef float f32x16 __attribute__((ext_vector_type(16)));
typedef short bf16x8 __attribute__((ext_vector_type(8)));
typedef short s16x4 __attribute__((ext_vector_type(4)));
typedef GAS unsigned gu32;
#define RLX_AGENT __ATOMIC_RELAXED, __HIP_MEMORY_SCOPE_AGENT
#define LDS_WAIT() asm volatile("s_waitcnt lgkmcnt(0)" ::: "memory")
#define VM_WAIT() asm volatile("s_waitcnt vmcnt(0)" ::: "memory")
#define DI __device__ __forceinline__

constexpr int D = 1024, NB = 8, T = 4096, NTOK = NB * T, LCTX = 256, NCTX = NB * LCTX;
constexpr int NH = 4, DK = 256, DV = 512, VTOT = 2048, RIN = 6144;
constexpr int NE = 64, TOPK = 8, EH = 256;
constexpr int CH = 128, NCHUNK = T / CH;
constexpr int NSLICE = 1, SLTOK = NTOK / NSLICE;
constexpr int ECAP = SLTOK;
constexpr int NEX = NE + 1;
constexpr int ACT_ROUTED = SLTOK * TOPK + NE * 256;
constexpr float NORM_EPS = 1e-6f, LN_EPS = 1e-5f;

typedef __bf16 bf16x2_hw __attribute__((ext_vector_type(2)));
typedef float f32x2_hw __attribute__((ext_vector_type(2)));
DI unsigned cvt_pk_bf16(float lo, float hi) { const f32x2_hw v = {lo, hi}; const bf16x2_hw r = __builtin_convertvector(v, bf16x2_hw); return __builtin_bit_cast(unsigned, r); }
DI float bf_lo(unsigned u) { return __uint_as_float(u << 16); }
DI float bf_hi(unsigned u) { return __uint_as_float(u & 0xffff0000u); }
DI float bf2f(bf16 b) { return __uint_as_float(((unsigned)b) << 16); }
DI bf16 f2bf(float f) { return (bf16)(cvt_pk_bf16(f, 0.f) & 0xffffu); }
DI float wave_sum(float v) {
    int x = __builtin_bit_cast(int, v);
#define WS_STEP(ctrl, rmask) x = __builtin_bit_cast(int, __builtin_bit_cast(float, x) + __builtin_bit_cast(float, __builtin_amdgcn_update_dpp(0, x, ctrl, rmask, 0xf, false)))
    WS_STEP(0x111, 0xf); WS_STEP(0x112, 0xf); WS_STEP(0x114, 0xf); WS_STEP(0x118, 0xf); WS_STEP(0x142, 0xa); WS_STEP(0x143, 0xc);
#undef WS_STEP
    return __builtin_bit_cast(float, __builtin_amdgcn_readlane(x, 63));
}
DI float wave_max(float v) {
    int x = __builtin_bit_cast(int, v);
#define WM_STEP(ctrl, rmask) x = __builtin_bit_cast(int, fmaxf(__builtin_bit_cast(float, x), __builtin_bit_cast(float, __builtin_amdgcn_update_dpp((int)0xff800000, x, ctrl, rmask, 0xf, false))))
    WM_STEP(0x111, 0xf); WM_STEP(0x112, 0xf); WM_STEP(0x114, 0xf); WM_STEP(0x118, 0xf); WM_STEP(0x142, 0xa); WM_STEP(0x143, 0xc);
#undef WM_STEP
    return __builtin_bit_cast(float, __builtin_amdgcn_readlane(x, 63));
}
#define G8_DPP(x, ctrl) __builtin_bit_cast(float, __builtin_amdgcn_update_dpp(0, __builtin_bit_cast(int, x), ctrl, 0xf, 0xf, false))
DI float grp8_max(float x) { x = fmaxf(x, G8_DPP(x, 0xB1)); x = fmaxf(x, G8_DPP(x, 0x4E)); x = fmaxf(x, G8_DPP(x, 0x141)); return x; }
DI float grp8_sum(float x) { x += G8_DPP(x, 0xB1); x += G8_DPP(x, 0x4E); x += G8_DPP(x, 0x141); return x; }
DI float lane_xor(float v, int lane, int d) { return __builtin_bit_cast(float, __builtin_amdgcn_ds_bpermute((lane ^ d) << 2, __builtin_bit_cast(int, v))); }
DI float sigmoidf_(float x) { return __builtin_amdgcn_rcpf(1.f + __expf(-x)); }
DI float siluf_(float x) { return x * __builtin_amdgcn_rcpf(1.f + __expf(-x)); }

namespace pg8 {
constexpr int BM = 256, BK = 64, HALF = 128, HTB = HALF * BK * 2, STAGE_BYTES = 8 * HTB, NXCD = 8, WGM = 8;
DI int lds_byte(int r, int c) { const int st = (r >> 4) * 2 + (c >> 5), rr = r & 15, cc = c & 31, ob = rr * 64 + cc * 2; return st * 1024 + (ob ^ (((ob >> 9) & 1) << 5)); }
DI void stage_rc(int b, int& R, int& C) { const int st = b / 1024, sb = b % 1024, swz = sb ^ (((sb >> 9) & 1) << 5); R = (st >> 1) * 16 + swz / 64; C = (st & 1) * 32 + (swz % 64) / 2; }
DI int perm32(int rho) { const int n = rho >> 4, i = rho & 15; return 8 * (i >> 2) + 4 * n + (i & 3); }

struct Unit { int pm, pn, e0, e1; };
struct Gemm { const bf16* A; const bf16* Bt; int K; };

struct StaticOrder {
    int nM, nN, nwg, G, c;
    DI void init(int M, int N, int G_, int c_) { nM = M / BM; nN = N / BM; nwg = nM * nN; G = G_; c = c_; }
    DI bool next(int i, Unit& u) const {
        const long L = (long)i * G + c; if (L >= nwg) return false;
        int wgid = (int)L; { const int q = nwg / NXCD, r = nwg % NXCD, xcd = wgid % NXCD, off = wgid / NXCD; wgid = (xcd < r ? xcd * (q + 1) : r * (q + 1) + (xcd - r) * q) + off; }
        const int nig = WGM * nN, gid = wgid / nig, fm = gid * WGM, gsz = (nM - fm) < WGM ? (nM - fm) : WGM;
        u.pm = fm + ((wgid % nig) % gsz); u.pn = (wgid % nig) / gsz; u.e0 = 0; u.e1 = 0; return true;
    }
    DI int a_row(const Unit&, int) const { return 0; }
};

template <class Epi, class Sched, bool GATHER>
DI void gemm_phase(LAS unsigned char* lds, const Gemm g, const Sched& S, const Epi& E, const int tid, const int stagger_us = 0) {
    if (stagger_us > 0 && (S.c & 1)) {
#pragma unroll 1
        for (int i_ = 0; i_ < stagger_us / 2; ++i_) __builtin_amdgcn_s_sleep(64); }
    const int wid = __builtin_amdgcn_readfirstlane(tid >> 6), lane = tid & 63, wr = wid >> 2, wc = wid & 3, fr = lane & 15, fq = lane >> 4;
    const int K = g.K, nt = K / BK;
    unsigned voffB[2], vA[2][2], nvA[2][2]; int Rr[2], Cc[2];
#pragma unroll
    for (int i = 0; i < 2; ++i) { int R, C; stage_rc(tid * 16 + i * 8192, R, C); const int Rb = Epi::PERM ? ((R & ~31) + perm32(R & 31)) : R;
        voffB[i] = (unsigned)(Rb * K + C) * 2u; Rr[i] = R; Cc[i] = C; }
    const size_t kstep = (size_t)(BK * 2);
    const size_t hstep = (size_t)HALF * K * 2;
    const size_t tstep = 2 * hstep;
    const unsigned ldsw = (unsigned)wid * 1024u;
    const int aoff = lds_byte(wr * 64 + fr, fq * 8), boff = lds_byte(wc * 32 + fr, fq * 8);
#define PG8_SETV(u, v) do { _Pragma("unroll") for (int _h = 0; _h < 2; ++_h) _Pragma("unroll") for (int _i = 0; _i < 2; ++_i) \
        (v)[_h][_i] = GATHER ? (unsigned)(S.a_row((u), _h * 128 + Rr[_i]) * K + Cc[_i]) * 2u : (unsigned)((_h * 128 + Rr[_i]) * K + Cc[_i]) * 2u; } while (0)
#define PG8_SA(b, h) (((b) * 2 + (h)) * HTB)
#define PG8_SB(b, h) ((4 + (b) * 2 + (h)) * HTB)
#define PG8_STAGE(bufoff, gbase, voff) do { _Pragma("unroll") for (int _i = 0; _i < 2; ++_i) \
        __builtin_amdgcn_global_load_lds((const unsigned*)((const char*)(gbase) + (voff)[_i]), (LAS unsigned*)(lds + (bufoff) + ldsw + _i * 8192), 16, 0, 0); } while (0)
#define PG8_LDA(dst, b, h) do { _Pragma("unroll") for (int m = 0; m < 4; ++m) _Pragma("unroll") for (int k = 0; k < 2; ++k) dst[m][k] = *(const LAS bf16x8*)(lds + PG8_SA(b, h) + aoff + m * 2048 + k * 1024); } while (0)
#define PG8_LDB(dst, b, h) do { _Pragma("unroll") for (int n = 0; n < 2; ++n) _Pragma("unroll") for (int k = 0; k < 2; ++k) dst[n][k] = *(const LAS bf16x8*)(lds + PG8_SB(b, h) + boff + n * 2048 + k * 1024); } while (0)
#define PG8_MMA(ai, bj, At, Bt) do { __builtin_amdgcn_s_setprio(1); _Pragma("unroll") for (int m = 0; m < 4; ++m) _Pragma("unroll") for (int n = 0; n < 2; ++n) _Pragma("unroll") for (int k = 0; k < 2; ++k) \
        acc[ai][bj][m][n] = __builtin_amdgcn_mfma_f32_16x16x32_bf16(Bt[n][k], At[m][k], acc[ai][bj][m][n], 0, 0, 0); __builtin_amdgcn_s_setprio(0); } while (0)
#define PG8_WAIT_V(n) asm volatile("s_waitcnt vmcnt(" #n ")" ::: "memory")
#define PG8_WAIT_L(n) asm volatile("s_waitcnt lgkmcnt(" #n ")" ::: "memory")
#define PG8_BAR __builtin_amdgcn_s_barrier()
#define PG8_SCHED __builtin_amdgcn_sched_barrier(0)
    Unit cur, nxt; int ui = 0;
    if (!S.next(0, cur)) return;
    f32x4 acc[2][2][4][2];
#pragma unroll
    for (int a = 0; a < 2; ++a)
#pragma unroll
        for (int b = 0; b < 2; ++b)
#pragma unroll
            for (int m = 0; m < 4; ++m)
#pragma unroll
                for (int n = 0; n < 2; ++n) acc[a][b][m][n] = (f32x4){0.f, 0.f, 0.f, 0.f};
    bf16x8 At[4][2], B0[2][2], B1[2][2];
    PG8_SETV(cur, vA);
    const char* cA = GATHER ? (const char*)g.A : (const char*)g.A + (size_t)cur.pm * tstep; const char* cB = (const char*)g.Bt + (size_t)cur.pn * tstep;
    PG8_STAGE(PG8_SB(0, 0), cB, voffB); PG8_STAGE(PG8_SB(0, 1), cB + hstep, voffB); PG8_STAGE(PG8_SA(0, 0), cA, vA[0]); PG8_STAGE(PG8_SA(0, 1), cA, vA[1]);
    if (wr == 1) PG8_BAR;
    PG8_WAIT_V(2); PG8_BAR;
    PG8_STAGE(PG8_SB(1, 0), cB + kstep, voffB); PG8_STAGE(PG8_SA(1, 0), cA + kstep, vA[0]); PG8_STAGE(PG8_SB(1, 1), cB + hstep + kstep, voffB);
    PG8_WAIT_V(6); PG8_BAR;
    for (;;) {
        const bool has_next = S.next(ui + 1, nxt);
        const char* nA = has_next ? (GATHER ? (const char*)g.A : (const char*)g.A + (size_t)nxt.pm * tstep) : cA; const char* nB = has_next ? (const char*)g.Bt + (size_t)nxt.pn * tstep : cB;
        if (GATHER) { if (has_next) { PG8_SETV(nxt, nvA); } else {
#pragma unroll
            for (int h = 0; h < 2; ++h)
#pragma unroll
                for (int i = 0; i < 2; ++i) nvA[h][i] = vA[h][i]; } }
#pragma unroll 1
        for (int t = 0; t < nt; t += 2) {
            const bool last = (t == nt - 2);
            const char* a1 = cA + (size_t)(t + 1) * kstep;
            const char* a2 = last ? nA : cA + (size_t)(t + 2) * kstep; const char* b2 = last ? nB : cB + (size_t)(t + 2) * kstep;
            const char* a3 = a2 + kstep; const char* b3 = b2 + kstep;
            unsigned s2[2][2];
#pragma unroll
            for (int h = 0; h < 2; ++h)
#pragma unroll
                for (int i = 0; i < 2; ++i) s2[h][i] = (GATHER && last) ? nvA[h][i] : vA[h][i];
            PG8_LDB(B0, 0, 0); PG8_LDB(B1, 0, 1); PG8_SCHED; PG8_LDA(At, 0, 0); PG8_STAGE(PG8_SA(1, 1), a1, vA[1]);
            PG8_WAIT_V(8); PG8_WAIT_L(0); PG8_BAR; PG8_MMA(0, 0, At, B0); PG8_MMA(0, 1, At, B1); PG8_BAR; PG8_SCHED;
            PG8_LDA(At, 0, 1); PG8_STAGE(PG8_SB(0, 0), b2, voffB); PG8_STAGE(PG8_SB(0, 1), b2 + hstep, voffB); PG8_STAGE(PG8_SA(0, 0), a2, s2[0]);
            PG8_WAIT_V(8); PG8_WAIT_L(0); PG8_BAR; PG8_MMA(1, 0, At, B0); PG8_MMA(1, 1, At, B1); PG8_BAR; PG8_SCHED;
            PG8_LDB(B0, 1, 0); PG8_LDB(B1, 1, 1); PG8_SCHED; PG8_LDA(At, 1, 0); PG8_STAGE(PG8_SA(0, 1), a2, s2[1]);
            PG8_WAIT_V(8); PG8_WAIT_L(0); PG8_BAR; PG8_MMA(0, 0, At, B0); PG8_MMA(0, 1, At, B1); PG8_BAR; PG8_SCHED;
            PG8_LDA(At, 1, 1); PG8_STAGE(PG8_SB(1, 0), b3, voffB); PG8_STAGE(PG8_SB(1, 1), b3 + hstep, voffB); PG8_STAGE(PG8_SA(1, 0), a3, s2[0]);
            PG8_WAIT_V(8); PG8_WAIT_L(0); PG8_BAR; PG8_MMA(1, 0, At, B0); PG8_MMA(1, 1, At, B1); PG8_BAR; PG8_SCHED;
        }
        if (wr == 0) PG8_BAR;
        { int tz = tid; asm volatile("" : "+v"(tz));
          const int wid2 = __builtin_amdgcn_readfirstlane(tz >> 6), lane2 = tz & 63;
          E(acc, cur, wid2 >> 2, wid2 & 3, lane2 & 15, lane2 >> 4); }
        if (!has_next) break;
#pragma unroll
        for (int a = 0; a < 2; ++a)
#pragma unroll
            for (int b = 0; b < 2; ++b)
#pragma unroll
                for (int m = 0; m < 4; ++m)
#pragma unroll
                    for (int n = 0; n < 2; ++n) acc[a][b][m][n] = (f32x4){0.f, 0.f, 0.f, 0.f};
        cur = nxt; cA = nA; cB = nB; ++ui;
        if (GATHER) {
#pragma unroll
            for (int h = 0; h < 2; ++h)
#pragma unroll
                for (int i = 0; i < 2; ++i) vA[h][i] = nvA[h][i]; }
        if (wr == 1) PG8_BAR;
    }
    PG8_WAIT_V(0);
    PG8_BAR;
#undef PG8_SETV
#undef PG8_SA
#undef PG8_SB
#undef PG8_STAGE
#undef PG8_LDA
#undef PG8_LDB
#undef PG8_MMA
#undef PG8_WAIT_V
#undef PG8_WAIT_L
#undef PG8_BAR
#undef PG8_SCHED
}
}
using pg8::Unit;

constexpr size_t MiB = 1u << 20;
constexpr size_t WS_CTL = 0, CTL_ZERO_BYTES = 128 * 1024;
constexpr size_t WS_MOD = 2 * MiB;
constexpr size_t WS_ROPE = 4 * MiB;
constexpr size_t WS_WIN = 10 * MiB, WS_WOUT = 22 * MiB, WS_CW1 = 26 * MiB, WS_CW2 = 30 * MiB;
constexpr size_t WS_W13 = 32 * MiB, WS_W2 = 97 * MiB;
constexpr size_t WS_LIST = 130 * MiB;
constexpr size_t LIST_ARR = (size_t)NEX * ECAP * 4, LIST_SLICE = 3 * LIST_ARR;
constexpr size_t WS_BIG = 160 * MiB;
constexpr size_t WS_Q = WS_BIG, WS_K = WS_Q + 64 * MiB, WS_V = WS_K + 64 * MiB, WS_G = WS_V + 128 * MiB;
constexpr size_t WS_KC = 544 * MiB, WS_VC = 548 * MiB, WS_P = 560 * MiB;
constexpr size_t WS_Y = WS_BIG;
constexpr size_t WS_ACT = WS_BIG;
constexpr size_t WS_Y2 = WS_BIG + 152 * MiB;
constexpr size_t WS_U = WS_Y2;
constexpr size_t WS_UC = WS_BIG;
constexpr size_t WS_Z = WS_BIG + 64 * MiB, WS_C = WS_BIG + 128 * MiB, WS_Y1 = WS_BIG + 216 * MiB;
constexpr size_t WS_END = 600 * MiB;
static_assert(WS_LIST + NSLICE * LIST_SLICE <= WS_BIG, "lists");
static_assert(WS_ACT + (size_t)(ACT_ROUTED + SLTOK) * 512 <= WS_Y2, "act");
static_assert(WS_Y2 + (size_t)SLTOK * 9 * 1024 <= WS_END, "y2");
static_assert(WS_W13 + (size_t)NEX * 512 * 1024 * 2 <= WS_W2 && WS_W2 + (size_t)NEX * 1024 * 256 * 2 <= WS_LIST, "moe w");
constexpr int CW_TMO = 0, CW_CODE = 1;
constexpr int CW_BAR = 4096, XCD_BAR_WORDS_C = 3456;
constexpr int CW_CNT = 16384;
DI int cnt_word(int layer, int slice, int e) { return CW_CNT + ((layer * NSLICE + slice) * NE + e) * 16; }
static_assert((size_t)(CW_CNT + 2 * NSLICE * NE * 16) * 4 <= CTL_ZERO_BYTES && (size_t)(CW_BAR + XCD_BAR_WORDS_C) * 4 <= CTL_ZERO_BYTES, "control words inside the zeroed block");

constexpr int RING_OFF = 0, RING_BYTES = 131072;
constexpr int LDSCTL_OFF = 148480, MISC_OFF = LDSCTL_OFF + 1024;
constexpr int LDS_BYTES = 152576;

#define XB_TMO      128
#define XB_XCNT(j)  (256  + 64 * (j))
#define XB_XSUB(j)  (1280 + 64 * (j))
#define XB_XGEN(j)  (2304 + 64 * (j))
#define XB_TOP      3328
#define XB_TOPGEN   3392
#define XCD_BAR_WORDS 3456
#define XB_SPIN_CAP (1u << 18)
DI unsigned xb_ld(unsigned* p)              { return __hip_atomic_load(p, __ATOMIC_RELAXED, __HIP_MEMORY_SCOPE_AGENT); }
DI unsigned xb_add(unsigned* p, unsigned v) { return __hip_atomic_fetch_add(p, v, __ATOMIC_RELAXED, __HIP_MEMORY_SCOPE_AGENT); }
DI unsigned xb_xcc_id() { return (unsigned)__builtin_amdgcn_s_getreg((3 << 11) | 20) & 0xFu; }
#define XB_SPIN(cond, bar) do { unsigned _sp = 0; while (cond) { __builtin_amdgcn_s_sleep(1); \
    if ((++_sp & 255u) == 0u) { if (xb_ld(&(bar)[XB_TMO])) break; if (_sp > XB_SPIN_CAP) { atomicAdd(&(bar)[XB_TMO], 1u); break; } } } } while (0)
struct XcdBarrier { unsigned* bar; unsigned x; volatile LAS unsigned* st; };
DI XcdBarrier xcd_barrier_post(unsigned* bar, volatile LAS unsigned* st) {
    XcdBarrier b; b.bar = bar; b.x = xb_xcc_id(); b.st = st;
    if (threadIdx.x == 0) (void)xb_add(&bar[XB_XCNT(b.x)], 1u);
    return b;
}
DI void xcd_barrier_complete(unsigned* bar, unsigned x, unsigned& nloc, unsigned& nx) {
    const unsigned G = gridDim.x * gridDim.y * gridDim.z;
    unsigned sum, cnt, mine, sp = 0u;
    for (;;) {
        sum = 0u; cnt = 0u; mine = 0u;
#pragma unroll
        for (unsigned j = 0; j < 16; ++j) { const unsigned c = xb_ld(&bar[XB_XCNT(j)]); sum += c; cnt += (c > 0u) ? 1u : 0u; mine = (j == x) ? c : mine; }
        if (sum == G) break;
        __builtin_amdgcn_s_sleep(1);
        if ((++sp & 255u) == 0u) { if (xb_ld(&bar[XB_TMO])) break; if (sp > XB_SPIN_CAP) { atomicAdd(&bar[XB_TMO], 1u); break; } }
    }
    nloc = mine > 0u ? mine : 1u; nx = cnt > 0u ? cnt : 1u;
}
DI void xcd_barrier(const XcdBarrier& b, const bool leader) {
    asm volatile("s_waitcnt vmcnt(0)" ::: "memory");
    __syncthreads();
    if (leader) {
        unsigned* bar = b.bar;
        __builtin_amdgcn_s_waitcnt(0);
        unsigned nloc = b.st[0], nx = b.st[1];
        if (nloc == 0u) { xcd_barrier_complete(bar, b.x, nloc, nx); b.st[0] = nloc; b.st[1] = nx; }
        const unsigned old = xb_add(&bar[XB_XSUB(b.x)], 1u);
        const unsigned gen = old / nloc;
        if (old + 1u == (gen + 1u) * nloc) {
            __builtin_amdgcn_fence(__ATOMIC_RELEASE, "agent");
            asm volatile("s_waitcnt vmcnt(0)" ::: "memory");
            const unsigned og = xb_add(&bar[XB_TOP], 1u);
            const unsigned tg = og / nx;
            if (og + 1u == (tg + 1u) * nx) xb_add(&bar[XB_TOPGEN], 1u);
            else XB_SPIN(xb_ld(&bar[XB_TOPGEN]) == tg, bar);
            __builtin_amdgcn_fence(__ATOMIC_ACQUIRE, "agent");
            xb_add(&bar[XB_XGEN(b.x)], 1u);
            asm volatile("s_waitcnt vmcnt(0)" ::: "memory");
        } else {
            XB_SPIN(xb_ld(&bar[XB_XGEN(b.x)]) == gen, bar);
            __builtin_amdgcn_fence(__ATOMIC_ACQUIRE, "agent");
            asm volatile("s_waitcnt vmcnt(0)" ::: "memory");
        }
    }
    __syncthreads();
}

struct Frame {
    LAS unsigned char* lds;
    volatile LAS unsigned* MISC;
    unsigned* ctl;
    unsigned char* ws;
    int tid, lane, wave, vcu, G;
    float* out;
};
enum { I_X = 0, I_C, I_CTX, I_CCTX, I_MODW, I_MODB, I_NORMS, I_RWIN, I_RWOUT, I_RDECAY, I_CW1, I_CB1, I_CDW, I_CBDW, I_CLNG, I_CLNB, I_CW2, I_CB2,
       I_ROUTER, I_MBIAS, I_MW1, I_MW3, I_MW2, I_SW1, I_SW3, I_SW2 };

typedef const f32x4 (&AccRef)[2][2][4][2];
DI void st16(bf16* p, unsigned a, unsigned b, unsigned c, unsigned d) { v4u o; o.x = a; o.y = b; o.z = c; o.w = d; *(GAS v4u*)p = o; }

struct EpiQKVG {
    static constexpr bool PERM = true;
    unsigned char* ws;
    DI void operator()(AccRef acc, const Unit& u, int wr, int wc, int fr, int fq) const {
        const bool ctx = u.pm >= 128;
        const int rbase = u.pm * 256 + wr * 64 + fr, cw = wc * 32 + 8 * fq, pn = u.pn;
        if (pn < 8) {
            const bool isq = pn < 4; const int head = pn & 3;
            const size_t doff = ctx ? WS_KC : (isq ? WS_Q : WS_K);
            bf16* dst = (bf16*)(ws + doff);
            const int bb = ctx ? u.pm - 128 : u.pm >> 4, nch = ctx ? 2 : NCHUNK;
            const float* cs = (const float*)(ws + WS_ROPE) + (ctx ? 2 * T * 128 : 0);
            const int snoff = ctx ? LCTX * 128 : T * 128;
            const float sc = isq ? 0.0625f : 1.f;
#pragma unroll
            for (int ai = 0; ai < 2; ++ai)
#pragma unroll
                for (int m = 0; m < 4; ++m) {
                    const int row = rbase + ai * 128 + m * 16, rr = ctx ? row - NTOK : row, t = ctx ? (rr & (LCTX - 1)) : (row & (T - 1));
#pragma unroll
                    for (int bj = 0; bj < 2; ++bj) {
                        const int p0 = bj * 64 + wc * 16 + 4 * fq;
                        const f32x4 c = *(const GAS f32x4*)(cs + (size_t)t * 128 + p0), s = *(const GAS f32x4*)(cs + snoff + (size_t)t * 128 + p0);
                        const f32x4 v0 = acc[ai][bj][m][0], v1 = acc[ai][bj][m][1];
                        const float o0 = (v0[0] * c[0] - v0[1] * s[0]) * sc, o1 = (v0[0] * s[0] + v0[1] * c[0]) * sc;
                        const float o2 = (v0[2] * c[1] - v0[3] * s[1]) * sc, o3 = (v0[2] * s[1] + v0[3] * c[1]) * sc;
                        const float o4 = (v1[0] * c[2] - v1[1] * s[2]) * sc, o5 = (v1[0] * s[2] + v1[1] * c[2]) * sc;
                        const float o6 = (v1[2] * c[3] - v1[3] * s[3]) * sc, o7 = (v1[2] * s[3] + v1[3] * c[3]) * sc;
                        const int chunk = ctx ? ai : ((2 * u.pm + ai) & (NCHUNK - 1)), itq = wr * 2 + (m >> 1), rq = (m & 1) * 16 + fr, ksq = bj * 8 + wc * 2 + (fq >> 1);
                        const size_t fo = isq ? ((((size_t)(bb * nch + chunk) * NH + head) * 8 + (4 * wr + m)) * 8 + (4 * bj + wc)) * 512 + (fr + 16 * fq) * 8
                                              : ((((size_t)(bb * nch + chunk) * NH + head) * 4 + itq) * 16 + ksq) * 512 + (rq + 32 * (fq & 1)) * 8;
                        st16(dst + fo, cvt_pk_bf16(o0, o1), cvt_pk_bf16(o2, o3), cvt_pk_bf16(o4, o5), cvt_pk_bf16(o6, o7));
                    }
                }
        } else {
            const bool isg = pn >= 16; const int ct = (pn - (isg ? 16 : 8)) * 256;
            const size_t doff = isg ? WS_G : (ctx ? WS_VC : WS_V);
            bf16* dst = (bf16*)(ws + doff);
#pragma unroll
            for (int ai = 0; ai < 2; ++ai)
#pragma unroll
                for (int m = 0; m < 4; ++m) {
                    const int row = rbase + ai * 128 + m * 16, rr = ctx ? row - NTOK : row;
#pragma unroll
                    for (int bj = 0; bj < 2; ++bj) {
                        f32x4 v0 = acc[ai][bj][m][0], v1 = acc[ai][bj][m][1];
                        if (isg) {
#pragma unroll
                            for (int e = 0; e < 4; ++e) { v0[e] = siluf_(v0[e]); v1[e] = siluf_(v1[e]); }
                        }
                        st16(dst + (size_t)rr * 2048 + ct + bj * 128 + cw, cvt_pk_bf16(v0[0], v0[1]), cvt_pk_bf16(v0[2], v0[3]), cvt_pk_bf16(v1[0], v1[1]), cvt_pk_bf16(v1[2], v1[3]));
                    }
                }
        }
    }
};
struct InprojOrder {
    pg8::StaticOrder so; int G, c;
    DI void init(int G_, int c_) { so.init(NTOK, RIN, G_, c_); G = G_; c = c_; }
    DI bool next(int i, Unit& u) const {
        const int L = i * G + c;
        if (L < 3072) return so.next(i, u);
        const int l2 = L - 3072; if (l2 >= 96) return false;
        u.pm = 128 + l2 / 12; u.pn = 4 + l2 % 12; u.e0 = 0; u.e1 = 0; return true;
    }
    DI int a_row(const Unit&, int) const { return 0; }
};
struct EpiBf16 {
    static constexpr bool PERM = true;
    bf16* O; int ldc; const float* bias;
    DI void operator()(AccRef acc, const Unit& u, int wr, int wc, int fr, int fq) const {
        const int rbase = u.pm * 256 + wr * 64 + fr, cbase = u.pn * 256 + wc * 32 + 8 * fq;
#pragma unroll
        for (int bj = 0; bj < 2; ++bj) {
            f32x4 b0 = (f32x4){0.f, 0.f, 0.f, 0.f}, b1 = b0;
            if (bias) { b0 = *(const GAS f32x4*)(bias + cbase + bj * 128); b1 = *(const GAS f32x4*)(bias + cbase + bj * 128 + 4); }
#pragma unroll
            for (int ai = 0; ai < 2; ++ai)
#pragma unroll
                for (int m = 0; m < 4; ++m) {
                    const f32x4 v0 = acc[ai][bj][m][0] + b0, v1 = acc[ai][bj][m][1] + b1;
                    st16(O + (size_t)(rbase + ai * 128 + m * 16) * ldc + cbase + bj * 128, cvt_pk_bf16(v0[0], v0[1]), cvt_pk_bf16(v0[2], v0[3]), cvt_pk_bf16(v1[0], v1[1]), cvt_pk_bf16(v1[2], v1[3]));
                }
        }
    }
};
struct EpiGLU {
    static constexpr bool PERM = true;
    bf16* Z; const float* b1;
    DI void operator()(AccRef acc, const Unit& u, int wr, int wc, int fr, int fq) const {
        const int rbase = u.pm * 256 + wr * 64 + fr, cc = u.pn * 128 + wc * 32 + 8 * fq;
        const f32x4 ba0 = *(const GAS f32x4*)(b1 + cc), ba1 = *(const GAS f32x4*)(b1 + cc + 4), bg0 = *(const GAS f32x4*)(b1 + 1024 + cc), bg1 = *(const GAS f32x4*)(b1 + 1024 + cc + 4);
#pragma unroll
        for (int ai = 0; ai < 2; ++ai)
#pragma unroll
            for (int m = 0; m < 4; ++m) {
                const f32x4 a0 = acc[ai][0][m][0] + ba0, a1 = acc[ai][0][m][1] + ba1, g0 = acc[ai][1][m][0] + bg0, g1 = acc[ai][1][m][1] + bg1;
                f32x4 o0, o1;
#pragma unroll
                for (int e = 0; e < 4; ++e) { o0[e] = a0[e] * sigmoidf_(g0[e]); o1[e] = a1[e] * sigmoidf_(g1[e]); }
                st16(Z + (size_t)(rbase + ai * 128 + m * 16) * 1024 + cc, cvt_pk_bf16(o0[0], o0[1]), cvt_pk_bf16(o0[2], o0[3]), cvt_pk_bf16(o1[0], o1[1]), cvt_pk_bf16(o1[2], o1[3]));
            }
    }
};
struct MoeOrder {
    const LAS int* cum; const LAS int* cnt; const LAS int* rb; const LAS unsigned char* eob; const int* ltok; int npn, G, c, total;
    DI bool next(int i, Unit& u) const {
        const int L = i * G + c; if (L >= total) return false;
        const int blk = L / npn, sub = L - blk * npn;
        const int e = eob[blk];
        const int bi = blk - cum[e];
        u.pm = blk; u.pn = e * npn + sub; const int left = cnt[e] - bi * 256; u.e1 = left < 256 ? left : 256;
        u.e0 = ltok ? e * ECAP + bi * 256 : rb[e] + bi * 256;
        return true;
    }
    DI int a_row(const Unit& u, int r) const { return r < u.e1 ? ltok[u.e0 + r] : 0; }
};
struct EpiSwiGLU {
    static constexpr bool PERM = true;
    bf16* ACT;
    DI void operator()(AccRef acc, const Unit& u, int wr, int wc, int fr, int fq) const {
        const int rbase = u.pm * 256 + wr * 64 + fr, cc = (u.pn & 1) * 128 + wc * 32 + 8 * fq;
#pragma unroll
        for (int ai = 0; ai < 2; ++ai)
#pragma unroll
            for (int m = 0; m < 4; ++m) {
                const f32x4 a0 = acc[ai][0][m][0], a1 = acc[ai][0][m][1], g0 = acc[ai][1][m][0], g1 = acc[ai][1][m][1];
                f32x4 o0, o1;
#pragma unroll
                for (int e = 0; e < 4; ++e) { o0[e] = siluf_(a0[e]) * g0[e]; o1[e] = siluf_(a1[e]) * g1[e]; }
                st16(ACT + (size_t)(rbase + ai * 128 + m * 16) * 256 + cc, cvt_pk_bf16(o0[0], o0[1]), cvt_pk_bf16(o0[2], o0[3]), cvt_pk_bf16(o1[0], o1[1]), cvt_pk_bf16(o1[2], o1[3]));
            }
    }
};
struct EpiMoeOut {
    static constexpr bool PERM = true;
    unsigned char* Y2; int nostore;
    DI void operator()(AccRef acc, const Unit& u, int wr, int wc, int fr, int fq) const {
        const int ch = ((u.pn & 3) * 16 + wc * 4 + fq) * 16;
        if (nostore) { if (acc[0][0][0][0][0] != 12345.678f || acc[1][1][3][1][3] != 321.f) return; }
#pragma unroll
        for (int ai = 0; ai < 2; ++ai)
#pragma unroll
            for (int m = 0; m < 4; ++m) {
                const int r = ai * 128 + wr * 64 + m * 16 + fr;
                if (r < u.e1) {
                    unsigned pk[4];
#pragma unroll
                    for (int bj = 0; bj < 2; ++bj) {
                        const f32x4 v0 = acc[ai][bj][m][0], v1 = acc[ai][bj][m][1];
                        int p0 = __builtin_amdgcn_cvt_pk_fp8_f32(v0[0], v0[1], 0, false); p0 = __builtin_amdgcn_cvt_pk_fp8_f32(v0[2], v0[3], p0, true);
                        int p1 = __builtin_amdgcn_cvt_pk_fp8_f32(v1[0], v1[1], 0, false); p1 = __builtin_amdgcn_cvt_pk_fp8_f32(v1[2], v1[3], p1, true);
                        pk[2 * bj] = (unsigned)p0; pk[2 * bj + 1] = (unsigned)p1;
                    }
                    *(GAS v4u*)(Y2 + (size_t)(u.e0 + r) * 1024 + ch) = (v4u){pk[0], pk[1], pk[2], pk[3]};
                }
            }
    }
};

struct TrItem { const float* src; bf16* dst; int ldsrc, Kd; };
DI void tr_load(const TrItem& t, float (&tv)[32], int lane) {
#pragma unroll
    for (int i = 0; i < 32; ++i) { const int kk = 2 * i + (lane >> 5); tv[i] = t.src[(size_t)kk * t.ldsrc + (lane & 31)]; }
}
DI void tr_store(const TrItem& t, const float (&tv)[32], LAS float* scr, int lane) {
#pragma unroll
    for (int i = 0; i < 32; ++i) { const int kk = 2 * i + (lane >> 5); scr[kk * 33 + (lane & 31)] = tv[i]; }
    LDS_WAIT(); asm volatile("" ::: "memory");
    const int c = lane & 7;
#pragma unroll
    for (int j = 0; j < 4; ++j) { const int n = (lane >> 3) + 8 * j; const LAS float* s = scr + (8 * c) * 33 + n;
        v4u o; o.x = cvt_pk_bf16(s[0 * 33], s[1 * 33]); o.y = cvt_pk_bf16(s[2 * 33], s[3 * 33]); o.z = cvt_pk_bf16(s[4 * 33], s[5 * 33]); o.w = cvt_pk_bf16(s[6 * 33], s[7 * 33]);
        *(GAS v4u*)(t.dst + (size_t)n * t.Kd + 8 * c) = o; }
    LDS_WAIT(); asm volatile("" ::: "memory");
}
DI TrItem tr_mk(const float* src, int ldsrc, int k0, int scol0, bf16* dst, int Kd, int drow0) { TrItem t; t.src = src + (size_t)k0 * ldsrc + scol0; t.dst = dst + (size_t)drow0 * Kd + k0; t.ldsrc = ldsrc; t.Kd = Kd; return t; }
template <class MK> DI void tr_run(int it0, int step, int n, LAS float* scr, int lane, MK mk) {
    float ta[32], tb[32];
    TrItem ia, ib;
    if (it0 < n) { ia = mk(it0); tr_load(ia, ta, lane); }
    for (int it = it0; it < n; it += 2 * step) {
        const bool hb = it + step < n;
        if (hb) { ib = mk(it + step); tr_load(ib, tb, lane); }
        tr_store(ia, ta, scr, lane);
        if (hb) {
            if (it + 2 * step < n) { ia = mk(it + 2 * step); tr_load(ia, ta, lane); }
            tr_store(ib, tb, scr, lane);
        }
    }
}
DI void conv_moe_weights(Frame& F, int layer, const float* mw1, const float* mw3, const float* mw2, const float* sw1, const float* sw3, const float* sw2) {
    LAS float* scr = (LAS float*)(F.lds + RING_OFF + F.wave * 16384);
    const int gw = F.vcu * 8 + F.wave, NGW = F.G * 8;
    bf16* W13 = (bf16*)(F.ws + WS_W13); bf16* W2 = (bf16*)(F.ws + WS_W2);
    constexpr int I13 = 16 * 16, I2 = 4 * 32, PER = I13 + I2;
    tr_run(gw, NGW, NEX * PER, scr, F.lane, [&](int it) -> TrItem {
        const int e = it / PER, r = it - e * PER;
        if (r < I13) {
            const int kb = r >> 4, nb = r & 15;
            const float* s1 = e < NE ? mw1 + ((size_t)(layer * NE + e) << 18) : sw1 + ((size_t)layer << 18);
            const float* s3 = e < NE ? mw3 + ((size_t)(layer * NE + e) << 18) : sw3 + ((size_t)layer << 18);
            const float* src = (nb & 7) < 4 ? s1 : s3;
            return tr_mk(src, 256, kb * 64, 128 * (nb >> 3) + 32 * (nb & 3), W13, 1024, e * 512 + nb * 32);
        } else {
            const int r2 = r - I13, kb = r2 >> 5, nb = r2 & 31;
            const float* src = e < NE ? mw2 + ((size_t)(layer * NE + e) << 18) : sw2 + ((size_t)layer << 18);
            return tr_mk(src, 1024, kb * 64, nb * 32, W2, 256, e * 1024 + nb * 32);
        }
    });
}
DI void conv_small_weights(Frame& F, const float* rwin, const float* rwout, const float* cw1, const float* cw2) {
    LAS float* scr = (LAS float*)(F.lds + RING_OFF + F.wave * 16384);
    const int gw = F.vcu * 8 + F.wave, NGW = F.G * 8;
    constexpr int I_IN = 16 * 192, I_OUT = 32 * 32, I_C1 = 16 * 64, I_C2 = 16 * 32, TOT = I_IN + I_OUT + I_C1 + I_C2;
    unsigned char* ws = F.ws;
    tr_run(gw, NGW, TOT, scr, F.lane, [&](int it) -> TrItem {
        int r = it;
        if (r < I_IN) { const int kb = r / 192, nb = r % 192; return tr_mk(rwin, RIN, kb * 64, nb * 32, (bf16*)(ws + WS_WIN), 1024, nb * 32); } r -= I_IN;
        if (r < I_OUT) { const int kb = r >> 5, nb = r & 31; return tr_mk(rwout, 1024, kb * 64, nb * 32, (bf16*)(ws + WS_WOUT), 2048, nb * 32); } r -= I_OUT;
        if (r < I_C1) { const int kb = r >> 6, nb = r & 63; const int sc0 = ((nb & 7) < 4 ? 0 : 1024) + 128 * (nb >> 3) + 32 * (nb & 3);
            return tr_mk(cw1, 2048, kb * 64, sc0, (bf16*)(ws + WS_CW1), 1024, nb * 32); } r -= I_C1;
        { const int kb = r >> 5, nb = r & 31; return tr_mk(cw2, 1024, kb * 64, nb * 32, (bf16*)(ws + WS_CW2), 1024, nb * 32); }
    });
}
DI void rope_tables(Frame& F) {
    float* csL = (float*)(F.ws + WS_ROPE); float* snL = csL + T * 128; float* csC = snL + T * 128; float* snC = csC + LCTX * 128;
    const int gt = F.vcu * 512 + F.tid, NT = F.G * 512;
    for (int i = gt; i < (T + LCTX) * 128; i += NT) {
        const int t = i >> 7, p = i & 127;
        int ax, ii, dd; if (p < 32) { ax = 0; ii = p; dd = 64; } else if (p < 80) { ax = 1; ii = p - 32; dd = 96; } else { ax = 2; ii = p - 80; dd = 96; }
        const float inv = exp2f(-13.287712379549449f * (float)(2 * ii) / (float)dd);
        int pos;
        if (t < T) pos = ax == 0 ? LCTX : (ax == 1 ? (t >> 6) : (t & 63)); else pos = ax == 0 ? (t - T) : 0;
        const float ang = (float)pos * inv;
        const float rev = ang * 0.15915494309189535f;
        const float fr = rev - floorf(rev);
        const float s = __builtin_amdgcn_sinf(fr), c = __builtin_amdgcn_cosf(fr);
        if (t < T) { csL[i] = c; snL[i] = s; } else { csC[i - T * 128] = c; snC[i - T * 128] = s; }
    }
}
DI void mod_vectors(Frame& F, const float* cin, const float* cctx, const float* modw, const float* modb) {
    LAS float* sl = (LAS float*)(F.lds + RING_OFF);
    LAS float* red = sl + 9 * 1024;
    if (F.vcu >= 192) return;
    for (int i = F.tid; i < 9 * 1024; i += 512) { const float v = i < 8192 ? cin[i] : cctx[i - 8192]; sl[i] = siluf_(v); }
    __syncthreads();
    float* MOD = (float*)(F.ws + WS_MOD);
    for (int it = F.vcu; it < 192; it += F.G) {
        const int l = it / 96, cb = (it % 96) * 64;
        const float* w = modw + (size_t)l * 1024 * 6144 + cb + F.lane;
        float a[9];
#pragma unroll
        for (int b = 0; b < 9; ++b) a[b] = 0.f;
        const int k0 = F.wave * 128;
#pragma unroll 8
        for (int k = 0; k < 128; ++k) { const float wv = w[(size_t)(k0 + k) * 6144];
#pragma unroll
            for (int b = 0; b < 9; ++b) a[b] += sl[b * 1024 + k0 + k] * wv; }
#pragma unroll
        for (int b = 0; b < 9; ++b) red[(F.wave * 9 + b) * 64 + F.lane] = a[b];
        __syncthreads();
        for (int o = F.tid; o < 9 * 64; o += 512) { const int b = o >> 6, c = o & 63; float s = modb[l * 6144 + cb + c];
#pragma unroll
            for (int w8 = 0; w8 < 8; ++w8) s += red[(w8 * 9 + b) * 64 + c];
            MOD[(size_t)(l * 9 + b) * 6144 + cb + c] = s; }
        __syncthreads();
    }
}

DI void ld_row_f32(const float* p, int lane, float (&v)[16]) {
#pragma unroll
    for (int j = 0; j < 2; ++j) { const f32x4 a = *(const GAS f32x4*)(p + 512 * j + 8 * lane), b = *(const GAS f32x4*)(p + 512 * j + 8 * lane + 4);
#pragma unroll
        for (int e = 0; e < 4; ++e) { v[8 * j + e] = a[e]; v[8 * j + 4 + e] = b[e]; } }
}
DI void st_row_f32(float* p, int lane, const float (&v)[16]) {
#pragma unroll
    for (int j = 0; j < 2; ++j) { *(GAS f32x4*)(p + 512 * j + 8 * lane) = (f32x4){v[8 * j], v[8 * j + 1], v[8 * j + 2], v[8 * j + 3]}; *(GAS f32x4*)(p + 512 * j + 8 * lane + 4) = (f32x4){v[8 * j + 4], v[8 * j + 5], v[8 * j + 6], v[8 * j + 7]}; }
}
DI void ld_row_bf16(const bf16* p, int lane, float (&v)[16]) {
#pragma unroll
    for (int j = 0; j < 2; ++j) { const v4u a = *(const GAS v4u*)(p + 512 * j + 8 * lane);
        v[8 * j + 0] = bf_lo(a.x); v[8 * j + 1] = bf_hi(a.x); v[8 * j + 2] = bf_lo(a.y); v[8 * j + 3] = bf_hi(a.y); v[8 * j + 4] = bf_lo(a.z); v[8 * j + 5] = bf_hi(a.z); v[8 * j + 6] = bf_lo(a.w); v[8 * j + 7] = bf_hi(a.w); }
}
DI void ld_row_fp8(const unsigned char* p, int lane, float (&v)[16]) {
#pragma unroll
    for (int j = 0; j < 2; ++j) { const v2u a = *(const GAS v2u*)(p + 512 * j + 8 * lane);
        const f32x2 d0 = __builtin_amdgcn_cvt_pk_f32_fp8((int)a.x, false), d1 = __builtin_amdgcn_cvt_pk_f32_fp8((int)a.x, true), d2 = __builtin_amdgcn_cvt_pk_f32_fp8((int)a.y, false), d3 = __builtin_amdgcn_cvt_pk_f32_fp8((int)a.y, true);
        v[8 * j + 0] = d0[0]; v[8 * j + 1] = d0[1]; v[8 * j + 2] = d1[0]; v[8 * j + 3] = d1[1]; v[8 * j + 4] = d2[0]; v[8 * j + 5] = d2[1]; v[8 * j + 6] = d3[0]; v[8 * j + 7] = d3[1]; }
}
DI void st_row_bf16(bf16* p, int lane, const float (&v)[16]) {
#pragma unroll
    for (int j = 0; j < 2; ++j) st16(p + 512 * j + 8 * lane, cvt_pk_bf16(v[8 * j], v[8 * j + 1]), cvt_pk_bf16(v[8 * j + 2], v[8 * j + 3]), cvt_pk_bf16(v[8 * j + 4], v[8 * j + 5]), cvt_pk_bf16(v[8 * j + 6], v[8 * j + 7]));
}
DI int colx(int lane, int j) { return (lane >> 4) * 256 + (lane & 15) * 8 + 128 * j; }
DI void ld_rowx_f32(const float* p, int lane, float (&v)[16]) {
#pragma unroll
    for (int j = 0; j < 2; ++j) { const f32x4 a = *(const GAS f32x4*)(p + colx(lane, j)), b = *(const GAS f32x4*)(p + colx(lane, j) + 4);
#pragma unroll
        for (int e = 0; e < 4; ++e) { v[8 * j + e] = a[e]; v[8 * j + 4 + e] = b[e]; } }
}
DI void st_rowx_f32(float* p, int lane, const float (&v)[16]) {
#pragma unroll
    for (int j = 0; j < 2; ++j) { *(GAS f32x4*)(p + colx(lane, j)) = (f32x4){v[8 * j], v[8 * j + 1], v[8 * j + 2], v[8 * j + 3]}; *(GAS f32x4*)(p + colx(lane, j) + 4) = (f32x4){v[8 * j + 4], v[8 * j + 5], v[8 * j + 6], v[8 * j + 7]}; }
}
DI void st_rowx_bf16(bf16* p, int lane, const float (&v)[16]) {
#pragma unroll
    for (int j = 0; j < 2; ++j) st16(p + colx(lane, j), cvt_pk_bf16(v[8 * j], v[8 * j + 1]), cvt_pk_bf16(v[8 * j + 2], v[8 * j + 3]), cvt_pk_bf16(v[8 * j + 4], v[8 * j + 5]), cvt_pk_bf16(v[8 * j + 6], v[8 * j + 7]));
}
DI float row_sumsq(const float (&v)[16]) { float s = 0.f;
#pragma unroll
    for (int i = 0; i < 16; ++i) s += v[i] * v[i];
    return wave_sum(s); }
DI void norm_mod(const float (&x)[16], float rstd, const float* nw, const float* sh, const float* sc, int lane, float (&u)[16]) {
    float g[16], a[16], b[16]; ld_row_f32(nw, lane, g); ld_row_f32(sh, lane, a); ld_row_f32(sc, lane, b);
#pragma unroll
    for (int i = 0; i < 16; ++i) u[i] = x[i] * rstd * g[i] * (1.f + b[i]) + a[i];
}
DI void u_rows_layer0(Frame& F, bf16* U, const float* xin, const float* ctxin, const float* norms) {
    const int gw = F.vcu * 8 + F.wave, NGW = F.G * 8;
    const float* MOD = (const float*)(F.ws + WS_MOD);
    float av[16], bv[16]; int bcur = -1;
    float xn[16];
    if (gw < NTOK + NCTX) ld_row_f32(gw < NTOK ? xin + (size_t)gw * D : ctxin + (size_t)(gw - NTOK) * D, F.lane, xn);
    for (int m = gw; m < NTOK + NCTX; m += NGW) {
        const bool lat = m < NTOK; const int b = lat ? m / T : 8;
        float x[16], u[16];
#pragma unroll
        for (int i = 0; i < 16; ++i) x[i] = xn[i];
        const int mn = m + NGW;
        if (mn < NTOK + NCTX) ld_row_f32(mn < NTOK ? xin + (size_t)mn * D : ctxin + (size_t)(mn - NTOK) * D, F.lane, xn);
        if (b != bcur) {
            bcur = b; const float* mb = MOD + (size_t)b * 6144; float t1[16], t2[16];
            ld_row_f32(norms, F.lane, t1); ld_row_f32(mb + 1024, F.lane, t2); ld_row_f32(mb, F.lane, bv);
#pragma unroll
            for (int i = 0; i < 16; ++i) av[i] = t1[i] * (1.f + t2[i]);
        }
        const float rstd = rsqrtf(row_sumsq(x) * (1.f / D) + NORM_EPS);
#pragma unroll
        for (int i = 0; i < 16; ++i) u[i] = x[i] * rstd * av[i] + bv[i];
        st_row_bf16(U + (size_t)m * D, F.lane, u);
    }
}

#define MFMA32(a, b, c) __builtin_amdgcn_mfma_f32_32x32x16_bf16((a), (b), (c), 0, 0, 0)
#define MFMA16(a, b, c) __builtin_amdgcn_mfma_f32_16x16x32_bf16((a), (b), (c), 0, 0, 0)
DI int crow(int reg, int h5) { return (reg & 3) + 8 * (reg >> 2) + 4 * h5; }
DI float log2_gamma(const float* decay, int dir, int head) { const float x = decay[dir * NH + head]; return -log2f(1.f + expf(-x)); }

DI void retention_scores(Frame& F, const float* decay) {
    const bf16* Q = (const bf16*)(F.ws + WS_Q); const bf16* K = (const bf16*)(F.ws + WS_K); bf16* P = (bf16*)(F.ws + WS_P);
    const int lane = F.lane, r = lane & 31, h5 = lane >> 5;
    for (int unit = F.vcu; unit < NB * NH * NCHUNK; unit += F.G) {
        const int bh = unit >> 5, c = unit & 31, b = bh >> 2, head = bh & 3;
        const float lf = log2_gamma(decay, 0, head), lb = log2_gamma(decay, 1, head);
        bf16* Pt = P + (size_t)unit * CH * CH;
        {
            const bf16* kb = K + ((size_t)(b * NCHUNK + c) * NH + head) * 32768 + lane * 8;
            const bf16* qb = Q + ((size_t)(b * NCHUNK + c) * NH + head) * 32768;
            __syncthreads();
#pragma unroll
            for (int i = 0; i < 8; ++i) { const int pc = F.wave + 8 * i;
                __builtin_amdgcn_global_load_lds((const unsigned*)(kb + (size_t)pc * 512), (LAS unsigned*)(F.lds + RING_OFF + pc * 1024), 16, 0, 0);
                { const int qit = pc >> 4, qks = pc & 15;
                  __builtin_amdgcn_global_load_lds((const unsigned*)(qb + (size_t)(((2 * qit + (r >> 4)) * 8 + (qks >> 1)) * 64 + (r & 15) + 16 * (2 * (qks & 1) + h5)) * 8), (LAS unsigned*)(F.lds + RING_OFF + 65536 + pc * 1024), 16, 0, 0); } }
            VM_WAIT(); __syncthreads();
        }
#pragma unroll
        for (int tt = 0; tt < 2; ++tt) {
            const int tile = F.wave * 2 + tt, jt = tile >> 2, it = tile & 3;
            const LAS unsigned char* kp = F.lds + RING_OFF + (jt * 16) * 1024 + lane * 16;
            const LAS unsigned char* qp = F.lds + RING_OFF + 65536 + (it * 16) * 1024 + lane * 16;
            f32x16 acc;
#pragma unroll
            for (int i = 0; i < 16; ++i) acc[i] = 0.f;
#pragma unroll
            for (int s = 0; s < 16; ++s) { const bf16x8 a = *(const LAS bf16x8*)(kp + 1024 * s), bq = *(const LAS bf16x8*)(qp + 1024 * s); acc = MFMA32(a, bq, acc); }
            const int i = 32 * it + r;
#pragma unroll
            for (int g = 0; g < 4; ++g) {
                float o[4];
#pragma unroll
                for (int e = 0; e < 4; ++e) { const int j = 32 * jt + 8 * g + 4 * h5 + e; const int dd = i - j;
                    const float w = dd > 0 ? exp2f(lf * (float)dd) : (dd < 0 ? exp2f(lb * (float)(-dd)) : 2.f);
                    o[e] = acc[4 * g + e] * w; }
                v2u pk; pk.x = cvt_pk_bf16(o[0], o[1]); pk.y = cvt_pk_bf16(o[2], o[3]);
                *(GAS v2u*)(Pt + ((size_t)((2 * it + (r >> 4)) * 4 + jt) * 64 + (r & 15) + 16 * g) * 8 + 4 * h5) = pk;
            }
        }
    }
}

DI void dma16_untracked(const void* g, const LAS unsigned char* l) {
    const unsigned la = __builtin_amdgcn_readfirstlane((unsigned)(__UINTPTR_TYPE__)l);
    asm volatile("s_mov_b32 m0, %1\n\ts_nop 0\n\tglobal_load_lds_dwordx4 %0, off" :: "v"(g), "s"(la) : "memory", "m0");
}
constexpr size_t WS_SCANDUMP = 130 * MiB;
constexpr int KSLAB = 0, VPITCH = 192, SPITCH = 528;
constexpr int VIMG = 65536, VSIMG = VIMG + 128 * VPITCH, SIMG = VSIMG + 128 * VPITCH, SCAN_LDS_END = SIMG + 64 * SPITCH;
static_assert(SCAN_LDS_END <= LDSCTL_OFF, "scan LDS");
typedef LAS s16x4 lds_s16x4;
DI const LAS unsigned char* tr_lane_base(const LAS unsigned char* img, int pitch, int lane) {
    const int h5 = lane >> 5, blk = (lane >> 4) & 1, q = (lane & 15) >> 2, p = lane & 3;
    return img + (8 * h5 + q) * pitch + (16 * blk + 4 * p) * 2;
}
DI bf16x8 tr_frag(const LAS unsigned char* lane_base, int off, int pitch) {
    const s16x4 lo = __builtin_amdgcn_ds_read_tr16_b64_v4i16((lds_s16x4*)(lane_base + off));
    const s16x4 hi = __builtin_amdgcn_ds_read_tr16_b64_v4i16((lds_s16x4*)(lane_base + off + 4 * pitch));
    return __builtin_shufflevector(lo, hi, 0, 1, 2, 3, 4, 5, 6, 7);
}
#define WG_BAR() do { asm volatile("s_waitcnt lgkmcnt(0)" ::: "memory"); __builtin_amdgcn_s_barrier(); asm volatile("" ::: "memory"); } while (0)
DI void retention_scan(Frame& F, bf16* Opart, bf16* O, const float* decay, const int variant = 0) {
    const bf16* Qg = (const bf16*)(F.ws + WS_Q); const bf16* Kg = (const bf16*)(F.ws + WS_K); const bf16* Vg = (const bf16*)(F.ws + WS_V);
    const bf16* KCg = (const bf16*)(F.ws + WS_KC); const bf16* VCg = (const bf16*)(F.ws + WS_VC); const bf16* Pg = (const bf16*)(F.ws + WS_P);
    const int lane = F.lane, w = F.wave, tid = F.tid;
    const int it = w >> 1, et = w & 1;
    const LAS unsigned char* trK = tr_lane_base(F.lds + KSLAB + w * 8192, 64, lane);
    const LAS unsigned char* trV = tr_lane_base(F.lds + VIMG, VPITCH, lane);
    const LAS unsigned char* trVS = tr_lane_base(F.lds + VSIMG, VPITCH, lane);
    for (int unit = F.vcu; unit < NB * NH * 8; unit += F.G) {
        const int bh = unit >> 3, eb = unit & 7, b = bh >> 2, head = bh & 3;
        const int vcol = head * DV + eb * 64;
#pragma unroll
        for (int pass = 0; pass < 2; ++pass) {
            const bool fwd = pass == 1;
            const float l2g = log2_gamma(decay, fwd ? 0 : 1, head);
            const float gC = exp2f(l2g * (float)CH);
            f32x16 accS[2];
#pragma unroll
            for (int i = 0; i < 16; ++i) { accS[0][i] = 0.f; accS[1][i] = 0.f; }
            v4u vreg[2];
#define SCAN_SRC(s, kp, vp) do { if ((s) < 2) { const int cc = fwd ? (s) : 1 - (s); kp = KCg + ((size_t)(b * 2 + cc) * NH + head) * 32768; vp = VCg + ((size_t)b * LCTX + cc * CH) * 2048 + vcol; } \
                else { const int cc = fwd ? (s) - 2 : 33 - (s); kp = Kg + ((size_t)(b * NCHUNK + cc) * NH + head) * 32768; vp = Vg + ((size_t)b * T + cc * CH) * 2048 + vcol; } } while (0)
#define SCAN_LOADV(s) do { const bf16* kp_; const bf16* vp_; SCAN_SRC(s, kp_, vp_); (void)kp_; \
                _Pragma("unroll") for (int i = 0; i < 2; ++i) vreg[i] = *(const GAS v4u*)(vp_ + (size_t)((tid >> 3) + 64 * i) * 2048 + (tid & 7) * 8); } while (0)
#define SCAN_LOADK(s) do { const bf16* kp_; const bf16* vp_; SCAN_SRC(s, kp_, vp_); (void)vp_; \
                _Pragma("unroll") for (int i = 0; i < 8; ++i) kreg[i] = *(const GAS v4u*)(kp_ + (unsigned)((((i >> 1) * 16 + 2 * w + ((lane & 3) >> 1)) * 64 + ((16 * i + (lane >> 2)) & 31) + 32 * (lane & 1)) * 8)); } while (0)
#define SCAN_WRITEK() do { _Pragma("unroll") for (int i = 0; i < 8; ++i) *(LAS v4u*)(F.lds + KSLAB + w * 8192 + i * 1024 + lane * 16) = kreg[i]; } while (0)
            v4u kreg[8];
            bf16x8 qf[8], pf[4];
            { int lane_ = lane, tid_ = tid; asm volatile("" : "+v"(lane_), "+v"(tid_));
              const int lane = lane_, tid = tid_; (void)lane; (void)tid;
              SCAN_LOADV(0); asm volatile("" : "+v"(vreg[0]), "+v"(vreg[1]));
              SCAN_LOADK(0); SCAN_WRITEK(); asm volatile("s_waitcnt lgkmcnt(0)" ::: "memory"); }
#pragma unroll 1
            for (int s = 0; s < 34; ++s) {
                int lz = lane, tz = tid; asm volatile("" : "+v"(lz), "+v"(tz));
                const int r = lz & 31, h5 = lz >> 5;
                const unsigned ooff = (unsigned)(4 * h5) * 2048u + (unsigned)r;
#pragma unroll
                for (int i = 0; i < 2; ++i) {
                    const int row = (tz >> 3) + 64 * i;
                    const float dec = exp2f(l2g * (float)(fwd ? (CH - 1 - row) : row));
                    const v4u x = vreg[i]; v4u o;
                    o.x = cvt_pk_bf16(bf_lo(x.x) * dec, bf_hi(x.x) * dec); o.y = cvt_pk_bf16(bf_lo(x.y) * dec, bf_hi(x.y) * dec);
                    o.z = cvt_pk_bf16(bf_lo(x.z) * dec, bf_hi(x.z) * dec); o.w = cvt_pk_bf16(bf_lo(x.w) * dec, bf_hi(x.w) * dec);
                    *(LAS v4u*)(F.lds + VIMG + row * VPITCH + (tz & 7) * 16) = x;
                    *(LAS v4u*)(F.lds + VSIMG + row * VPITCH + (tz & 7) * 16) = o;
                }
#pragma unroll
                for (int e2 = 0; e2 < 2; ++e2)
#pragma unroll
                    for (int g = 0; g < 4; ++g) { v2u pk; pk.x = cvt_pk_bf16(accS[e2][4 * g], accS[e2][4 * g + 1]); pk.y = cvt_pk_bf16(accS[e2][4 * g + 2], accS[e2][4 * g + 3]);
                        *(LAS v2u*)(F.lds + SIMG + (32 * e2 + r) * SPITCH + (32 * w + 8 * g + 4 * h5) * 2) = pk; }
                {
                    const int lane = lz; const int sk = s + 1 < 34 ? s + 1 : 33;
                    { const bf16* kp_; const bf16* vp_; SCAN_SRC(sk, kp_, vp_); (void)kp_;
#pragma unroll
                      for (int i = 0; i < 2; ++i) vreg[i] = *(const GAS v4u*)(vp_ + (unsigned)(((tz >> 3) + 64 * i) * 2048 + (tz & 7) * 8)); }
                    SCAN_LOADK(sk); }
                WG_BAR();
                unsigned opk[8];
#pragma unroll
                for (int i = 0; i < 8; ++i) opk[i] = 0u;
                if (s >= 2 && !(variant & 1)) {
                    f32x4 accO[4];
#pragma unroll
                    for (int mt = 0; mt < 4; ++mt) accO[mt] = (f32x4){0.f, 0.f, 0.f, 0.f};
                    {
                        const LAS unsigned char* sp_ = F.lds + SIMG + (lz & 15) * SPITCH + 16 * (lz >> 4);
                        bf16x8 sb[2][4];
#pragma unroll
                        for (int mt = 0; mt < 4; ++mt) sb[0][mt] = *(const LAS bf16x8*)(sp_ + 16 * mt * SPITCH);
#pragma unroll
                        for (int ks = 0; ks < 8; ++ks) {
                            if (ks < 7) {
#pragma unroll
                                for (int mt = 0; mt < 4; ++mt) sb[(ks + 1) & 1][mt] = *(const LAS bf16x8*)(sp_ + 16 * mt * SPITCH + 64 * (ks + 1)); }
                            __builtin_amdgcn_sched_barrier(0);
#pragma unroll
                            for (int mt = 0; mt < 4; ++mt) accO[mt] = MFMA16(sb[ks & 1][mt], qf[ks], accO[mt]);
                            __builtin_amdgcn_sched_barrier(0);
                        }
                    }
                    {
                        const int sn = s + 1 < 34 ? s + 1 : 33;
                        const int cq = fwd ? sn - 2 : 33 - sn;
                        const bf16* qn = Qg + ((((size_t)(b * NCHUNK + cq) * NH + head) * 8 + w) * 8) * 512;
#pragma unroll
                        for (int ks = 0; ks < 8; ++ks) qf[ks] = *(const GAS bf16x8*)(qn + (unsigned)lz * 8u + 512 * ks);
                    }
                    {
                        const int il = 16 * w + (lz & 15);
                        const float qd = exp2f(l2g * (float)(fwd ? il + 1 : CH - il));
#pragma unroll
                        for (int mt = 0; mt < 4; ++mt) accO[mt] *= qd;
                    }
                    if (fwd) {
                        const LAS unsigned char* vp_ = F.lds + VIMG + (8 * (lz >> 4) + ((lz & 15) >> 2)) * VPITCH + 8 * (lz & 3);
                        bf16x8 vb[2][4];
#pragma unroll
                        for (int mt = 0; mt < 4; ++mt) vb[0][mt] = tr_frag(vp_, 32 * mt, VPITCH);
#pragma unroll
                        for (int ks = 0; ks < 4; ++ks) {
                            if (ks < 3) {
#pragma unroll
                                for (int mt = 0; mt < 4; ++mt) vb[(ks + 1) & 1][mt] = tr_frag(vp_, 32 * (ks + 1) * VPITCH + 32 * mt, VPITCH); }
                            __builtin_amdgcn_sched_barrier(0);
#pragma unroll
                            for (int mt = 0; mt < 4; ++mt) accO[mt] = MFMA16(vb[ks & 1][mt], pf[ks], accO[mt]);
                            __builtin_amdgcn_sched_barrier(0);
                        }
                    }
#pragma unroll
                    for (int mt = 0; mt < 4; ++mt) { opk[2 * mt] = cvt_pk_bf16(accO[mt][0], accO[mt][1]); opk[2 * mt + 1] = cvt_pk_bf16(accO[mt][2], accO[mt][3]); }
                }
                {
                    const int sn = s + 1 < 34 ? s + 1 : 33;
                    const int cq = sn >= 2 ? (fwd ? sn - 2 : 33 - sn) : (fwd ? 0 : 31);
                    const bf16* qn = Qg + ((((size_t)(b * NCHUNK + cq) * NH + head) * 8 + w) * 8) * 512;
                    const unsigned qoff = (unsigned)lz * 8u;
                    if (s < 2) {
#pragma unroll
                        for (int ks = 0; ks < 8; ++ks) qf[ks] = *(const GAS bf16x8*)(qn + qoff + 512 * ks); }
                    if (fwd) {
                        const bf16* pn = Pg + ((size_t)(bh * NCHUNK + cq) * CH * CH) + (size_t)(w * 4) * 512;
#pragma unroll
                        for (int ks = 0; ks < 4; ++ks) pf[ks] = *(const GAS bf16x8*)(pn + qoff + 512 * ks);
                    }
                }
#pragma unroll
                for (int i = 0; i < 16; ++i) { accS[0][i] *= gC; accS[1][i] *= gC; }
                if (!(variant & 2))
                {
                    bf16x8 ua[2], ub0[2], ub1[2];
                    ua[0] = tr_frag(trK, 0, 64); ub0[0] = tr_frag(trVS, 0, VPITCH); ub1[0] = tr_frag(trVS, 64, VPITCH);
#pragma unroll
                    for (int ks = 0; ks < 8; ++ks) {
                        if (ks < 7) { ua[(ks + 1) & 1] = tr_frag(trK, 16 * (ks + 1) * 64, 64); ub0[(ks + 1) & 1] = tr_frag(trVS, 16 * (ks + 1) * VPITCH, VPITCH); ub1[(ks + 1) & 1] = tr_frag(trVS, 16 * (ks + 1) * VPITCH + 64, VPITCH); }
                        __builtin_amdgcn_sched_barrier(0);
                        accS[0] = MFMA32(ua[ks & 1], ub0[ks & 1], accS[0]); accS[1] = MFMA32(ua[ks & 1], ub1[ks & 1], accS[1]);
                        __builtin_amdgcn_sched_barrier(0);
                    }
                }
                asm volatile("s_waitcnt lgkmcnt(0)" ::: "memory");
                { const int lane = lz; SCAN_WRITEK(); }
                {
                    const int cc = fwd ? s - 2 : 33 - s;
                    const size_t obase = ((size_t)b * T + cc * CH + 16 * w) * 2048 + vcol;
                    GAS unsigned char* dstp = s >= 2 ? (GAS unsigned char*)((fwd ? O : Opart) + obase) : (GAS unsigned char*)(F.ws + WS_SCANDUMP) + (size_t)(16 * w) * 4096;
                    const unsigned so = (unsigned)(lz & 15) * 4096u + (unsigned)(lz >> 4) * 8u;
#pragma unroll
                    for (int mt = 0; mt < 4; ++mt) *(GAS v2u*)(dstp + so + 32 * mt) = (v2u){opk[2 * mt], opk[2 * mt + 1]};
                }
                WG_BAR();
            }
#undef SCAN_SRC
#undef SCAN_LOADV
#undef SCAN_LOADK
#undef SCAN_WRITEK
            VM_WAIT(); __syncthreads();
        }
    }
}
DI void gn_gate_rows(Frame& F, bf16* O, const bf16* G, const bf16* OP) {
    const int gw = F.vcu * 8 + F.wave, NGW = F.G * 8;
    v4u an[4], gn[4], pn[4];
    if (gw < NTOK) {
#pragma unroll
        for (int j = 0; j < 4; ++j) { an[j] = *(const GAS v4u*)(O + (size_t)gw * VTOT + 512 * j + 8 * F.lane); pn[j] = *(const GAS v4u*)(OP + (size_t)gw * VTOT + 512 * j + 8 * F.lane); gn[j] = *(const GAS v4u*)(G + (size_t)gw * VTOT + 512 * j + 8 * F.lane); } }
    for (int m = gw; m < NTOK; m += NGW) {
        bf16* op = O + (size_t)m * VTOT;
        v4u ac[4], gc[4], pc[4];
#pragma unroll
        for (int j = 0; j < 4; ++j) { ac[j] = an[j]; gc[j] = gn[j]; pc[j] = pn[j]; }
        const int mn = m + NGW;
        if (mn < NTOK) {
#pragma unroll
            for (int j = 0; j < 4; ++j) { an[j] = *(const GAS v4u*)(O + (size_t)mn * VTOT + 512 * j + 8 * F.lane); pn[j] = *(const GAS v4u*)(OP + (size_t)mn * VTOT + 512 * j + 8 * F.lane); gn[j] = *(const GAS v4u*)(G + (size_t)mn * VTOT + 512 * j + 8 * F.lane); } }
#pragma unroll
        for (int j = 0; j < 4; ++j) {
            const v4u a = ac[j], g = gc[j], q = pc[j];
            float v[8] = {bf_lo(a.x) + bf_lo(q.x), bf_hi(a.x) + bf_hi(q.x), bf_lo(a.y) + bf_lo(q.y), bf_hi(a.y) + bf_hi(q.y), bf_lo(a.z) + bf_lo(q.z), bf_hi(a.z) + bf_hi(q.z), bf_lo(a.w) + bf_lo(q.w), bf_hi(a.w) + bf_hi(q.w)};
            const float gg[8] = {bf_lo(g.x), bf_hi(g.x), bf_lo(g.y), bf_hi(g.y), bf_lo(g.z), bf_hi(g.z), bf_lo(g.w), bf_hi(g.w)};
            float ss = 0.f;
#pragma unroll
            for (int e = 0; e < 8; ++e) ss += v[e] * v[e];
            const float rstd = rsqrtf(wave_sum(ss) * (1.f / DV) + NORM_EPS);
#pragma unroll
            for (int e = 0; e < 8; ++e) v[e] = v[e] * rstd * gg[e];
            st16(op + 512 * j + 8 * F.lane, cvt_pk_bf16(v[0], v[1]), cvt_pk_bf16(v[2], v[3]), cvt_pk_bf16(v[4], v[5]), cvt_pk_bf16(v[6], v[7]));
        }
    }
}
constexpr size_t WS_WPRIME = 156 * MiB, WS_CPART = WS_MOD + 1 * MiB;
DI void router_prescale(Frame& F, const float* norms, const float* router) {
    const float* MOD = (const float*)(F.ws + WS_MOD);
    bf16* WP = (bf16*)(F.ws + WS_WPRIME); float* CP = (float*)(F.ws + WS_CPART);
    const int gt = F.vcu * 512 + F.tid, NT = F.G * 512;
    for (int i = gt; i < 2 * NB * D * NE; i += NT) {
        const int e = i & 63, k = (i >> 6) & 1023, b = (i >> 16) & 7, l = i >> 19;
        const float v = norms[(l * 4 + 2) * D + k] * (1.f + MOD[(size_t)(l * 9 + b) * 6144 + 4 * D + k]) * router[((size_t)l * D + k) * NE + e];
        const bf16 hi = f2bf(v), lo = f2bf(v - bf2f(hi));
        const size_t o = (size_t)(l * NB + b) * 131072 + ((size_t)((e >> 5) * 64 + (k >> 4)) * 64 + (e & 31) + 32 * ((k >> 3) & 1)) * 8 + (k & 7);
        WP[o] = hi; WP[o + 65536] = lo;
    }
    const int gw = F.vcu * 8 + F.wave, NGW = F.G * 8;
    for (int t = gw; t < 2 * NB * 16; t += NGW) {
        const int ch = t & 15, b = (t >> 4) & 7, l = t >> 7;
        float a = 0.f;
#pragma unroll 8
        for (int kk = 0; kk < 64; ++kk) { const int k = ch * 64 + kk; a += MOD[(size_t)(l * 9 + b) * 6144 + 3 * D + k] * router[((size_t)l * D + k) * NE + F.lane]; }
        CP[(size_t)t * 64 + F.lane] = a;
    }
}
DI void rows_router(Frame& F, int layer, const float* hin, const bf16* Y, bf16* U, const float* norms, const float* mbias, float* hout, const int variant = 0, const int cl = 0) {
    const float* MOD = (const float*)(F.ws + WS_MOD) + (size_t)layer * 9 * 6144;
    const float* nrm = norms + (size_t)layer * 4 * D;
    constexpr int UP = 2064;
    LAS unsigned char* uhi = F.lds + RING_OFF; LAS unsigned char* ulo = uhi + 32 * UP;
    LAS float* plg = (LAS float*)uhi;
    LAS float* rstdl = (LAS float*)(ulo + 32 * UP);
    LAS int* bcnt = (LAS int*)(rstdl + 32); LAS int* bbase = bcnt + 64;
    LAS int* park = bbase + 64;
    const int lane = F.lane, w = F.wave;
    const float mybias = mbias[layer * NE + lane];
    unsigned char* lb = F.ws + WS_LIST;
    if (F.tid < 64) bcnt[F.tid] = 0;
    int nblk = 0;
#define RT_LOADSET(q_, m_) do { _Pragma("unroll") for (int j_ = 0; j_ < 2; ++j_) { yS[q_][j_] = *(const GAS v4u*)(Y + (size_t)(m_) * D + 512 * j_ + 8 * lane); \
        hS[q_][2 * j_] = *(const GAS f32x4*)(hin + (size_t)(m_) * D + 512 * j_ + 8 * lane); hS[q_][2 * j_ + 1] = *(const GAS f32x4*)(hin + (size_t)(m_) * D + 512 * j_ + 8 * lane + 4); } } while (0)
    v4u yS[4][2]; f32x4 hS[4][4];
    if (F.vcu < NTOK / 32 && !(variant & 1)) { const int mf = F.vcu * 32 + w * 4;
#pragma unroll
        for (int q4 = 0; q4 < 4; ++q4) { RT_LOADSET(q4, mf + q4); } }
    for (int blk = F.vcu; blk < NTOK / 32; blk += F.G, ++nblk) {
        const int m0 = blk * 32, b = m0 / T;
        const float* mb = MOD + (size_t)b * 6144;
        float csum = 0.f;
        { const float* cp = (const float*)(F.ws + WS_CPART) + (size_t)((layer * NB + b) * 16) * 64 + lane;
#pragma unroll
          for (int ch = 0; ch < 16; ++ch) csum += cp[ch * 64]; }
        if (!(variant & 1)) {
            float gg[16], av[16], bv[16];
            { float t1[16], t2[16]; ld_row_f32(nrm + D, lane, t1); ld_row_f32(mb + 2 * D, lane, t2);
#pragma unroll
              for (int i = 0; i < 16; ++i) gg[i] = t1[i] * t2[i];
              __builtin_amdgcn_sched_barrier(0);
              ld_row_f32(nrm + 2 * D, lane, t1); ld_row_f32(mb + 4 * D, lane, t2); ld_row_f32(mb + 3 * D, lane, bv);
#pragma unroll
              for (int i = 0; i < 16; ++i) av[i] = t1[i] * (1.f + t2[i]); }
            const int mnext = (blk + F.G) * 32;
            const bool hasnext = blk + F.G < NTOK / 32;
#pragma unroll
            for (int rr = 0; rr < 4; ++rr) {
                const int rl = w * 4 + rr, m = m0 + rl;
                float y[16], h[16], u[16];
#pragma unroll
                for (int j = 0; j < 2; ++j) { const v4u a = yS[rr][j];
                    y[8 * j + 0] = bf_lo(a.x); y[8 * j + 1] = bf_hi(a.x); y[8 * j + 2] = bf_lo(a.y); y[8 * j + 3] = bf_hi(a.y); y[8 * j + 4] = bf_lo(a.z); y[8 * j + 5] = bf_hi(a.z); y[8 * j + 6] = bf_lo(a.w); y[8 * j + 7] = bf_hi(a.w);
#pragma unroll
                    for (int e = 0; e < 4; ++e) { h[8 * j + e] = hS[rr][2 * j][e]; h[8 * j + 4 + e] = hS[rr][2 * j + 1][e]; } }
                const float rs1 = rsqrtf(row_sumsq(y) * (1.f / D) + NORM_EPS);
#pragma unroll
                for (int i = 0; i < 16; ++i) h[i] += gg[i] * (y[i] * rs1);
                st_row_f32(hout + (size_t)m * D, lane, h);
                const float rs2 = rsqrtf(row_sumsq(h) * (1.f / D) + NORM_EPS);
#pragma unroll
                for (int i = 0; i < 16; ++i) u[i] = h[i] * rs2 * av[i] + bv[i];
                st_row_bf16(U + (size_t)m * D, lane, u);
#pragma unroll
                for (int j = 0; j < 2; ++j) {
                    unsigned hh[4], ll[4];
#pragma unroll
                    for (int e = 0; e < 4; ++e) { const float x0 = h[8 * j + 2 * e], x1 = h[8 * j + 2 * e + 1]; const unsigned ph = cvt_pk_bf16(x0, x1); hh[e] = ph; ll[e] = cvt_pk_bf16(x0 - bf_lo(ph), x1 - bf_hi(ph)); }
                    *(LAS v4u*)(uhi + rl * UP + (512 * j + 8 * lane) * 2) = (v4u){hh[0], hh[1], hh[2], hh[3]};
                    *(LAS v4u*)(ulo + rl * UP + (512 * j + 8 * lane) * 2) = (v4u){ll[0], ll[1], ll[2], ll[3]};
                }
                if (lane == 0) rstdl[rl] = rs2;
                if (hasnext) { RT_LOADSET(rr, mnext + w * 4 + rr); }
            }
        }
        __syncthreads();
        if (!(variant & 2)) {
            const int kq = w >> 1, et = w & 1, r = lane & 31, h5 = lane >> 5;
            const bf16* wph = (const bf16*)(F.ws + WS_WPRIME) + (size_t)(layer * NB + b) * 131072 + ((size_t)(et * 64 + 16 * kq) * 64 + lane) * 8;
            f32x16 acc;
#pragma unroll
            for (int i = 0; i < 16; ++i) acc[i] = 0.f;
#pragma unroll
            for (int half = 0; half < 2; ++half) {
                bf16x8 bh[8], bl[8];
#pragma unroll
                for (int ks = 0; ks < 8; ++ks) { bh[ks] = *(const GAS bf16x8*)(wph + 512 * (8 * half + ks)); bl[ks] = *(const GAS bf16x8*)(wph + 65536 + 512 * (8 * half + ks)); }
                __builtin_amdgcn_sched_barrier(0);
#pragma unroll
                for (int ks = 0; ks < 8; ++ks) {
                    const bf16x8 ah = *(const LAS bf16x8*)(uhi + r * UP + (256 * kq + 16 * (8 * half + ks) + 8 * h5) * 2), al = *(const LAS bf16x8*)(ulo + r * UP + (256 * kq + 16 * (8 * half + ks) + 8 * h5) * 2);
                    acc = MFMA32(ah, bh[ks], acc); acc = MFMA32(ah, bl[ks], acc); acc = MFMA32(al, bh[ks], acc);
                }
                __builtin_amdgcn_sched_barrier(0);
            }
            __syncthreads();
#pragma unroll
            for (int i = 0; i < 16; ++i) plg[(kq * 32 + crow(i, h5)) * 65 + 32 * et + r] = acc[i];
        }
        __syncthreads();
        int lc = lane; asm volatile("" : "+v"(lc));
        float wgt[4]; int ksl[4], ipos[4];
#pragma unroll
        for (int rr = 0; rr < 4; ++rr) { ksl[rr] = -1; wgt[rr] = 0.f; ipos[rr] = 0; }
        if (!(variant & 4))
#pragma unroll
        for (int rr = 0; rr < 4; ++rr) {
            const int rl = w * 4 + rr;
            const float lg = rstdl[rl] * (plg[rl * 65 + lc] + plg[(32 + rl) * 65 + lc] + plg[(64 + rl) * 65 + lc] + plg[(96 + rl) * 65 + lc]) + csum;
            const float sc = sigmoidf_(lg), bs = sc + mybias;
            const float NINF = -__builtin_inff();
            const float m1 = grp8_max(bs);
            const bool ism = bs == m1;
            const float nm = grp8_sum(ism ? 1.f : 0.f);
            const float rest = grp8_max(ism ? NINF : bs);
            const float gs = m1 + (nm >= 2.f ? m1 : rest);
            int grk = 0; const int grp = lc >> 3;
#pragma unroll
            for (int g = 0; g < 8; ++g) { const float o = __builtin_bit_cast(float, __builtin_amdgcn_readlane(__builtin_bit_cast(int, gs), 8 * g)); grk += (o > gs || (o == gs && g < grp)) ? 1 : 0; }
            const bool gsel = grk < 4;
            float cur = gsel ? bs : NINF;
            bool sel = false;
#pragma unroll
            for (int t8 = 0; t8 < TOPK; ++t8) {
                const float mx = wave_max(cur);
                const unsigned long long eq = __builtin_amdgcn_ballot_w64(cur == mx);
                const int first = __builtin_ctzll(eq);
                const bool isf = lc == first;
                sel = sel || isf; cur = isf ? NINF : cur;
            }
            const float ssum = wave_sum(sel ? sc : 0.f);
            const unsigned long long bal = __ballot(sel);
            ksl[rr] = sel ? __popcll(bal & ((1ull << lc) - 1ull)) : -1;
            wgt[rr] = sc / ssum * 2.5f;
            ipos[rr] = sel ? __hip_atomic_fetch_add(bcnt + lc, 1, __ATOMIC_RELAXED, __HIP_MEMORY_SCOPE_WORKGROUP) : 0;
        }
#pragma unroll
        for (int rr = 0; rr < 4; ++rr) if (ksl[rr] >= 0) { const int pi = ((nblk * 32 + w * 4 + rr) * 8 + ksl[rr]) * 2; park[pi] = lc | (ipos[rr] << 8); park[pi + 1] = __builtin_bit_cast(int, wgt[rr]); }
        __syncthreads();
    }
    if (w == 0) { const int n = bcnt[lane]; bbase[lane] = n ? (int)atomicAdd(F.ctl + cnt_word(layer + cl, 0, lane), (unsigned)n) : 0; }
    __syncthreads();
    for (int k = 0; k < nblk; ++k) {
        const int m0 = (F.vcu + k * F.G) * 32;
#pragma unroll 1
        for (int rr = 0; rr < 4; ++rr) {
            const int m = m0 + w * 4 + rr;
            if (lane < 8) {
                const int pi = ((k * 32 + w * 4 + rr) * 8 + lane) * 2; const int pe = park[pi]; const float wv = __builtin_bit_cast(float, park[pi + 1]);
                const int e = pe & 0xff, pos = bbase[e] + (pe >> 8);
                ((int*)lb)[(size_t)e * ECAP + pos] = m;
                ((int*)(lb + LIST_ARR))[m * 8 + lane] = (e << 16) | pos; ((float*)(lb + 2 * LIST_ARR))[m * 8 + lane] = wv;
            }
            if (lane == 0) ((int*)lb)[(size_t)NE * ECAP + m] = m;
        }
    }
    __syncthreads();
}

DI void moe_tables(Frame& F, int layer, int slice) {
    LAS int* cum = (LAS int*)(F.lds + LDSCTL_OFF); LAS int* cnt = (LAS int*)(F.lds + LDSCTL_OFF + 272); LAS int* rb = (LAS int*)(F.lds + LDSCTL_OFF + 544);
    __syncthreads();
    if (F.wave == 0) {
        const int lane = F.lane;
        const int n = (int)__hip_atomic_load(F.ctl + cnt_word(layer, slice, lane), RLX_AGENT);
        int pb = (n + 255) >> 8, pr = n;
#pragma unroll
        for (int d = 1; d < 64; d <<= 1) {
            const int ob = __builtin_amdgcn_ds_bpermute((lane - d) << 2, pb), orr = __builtin_amdgcn_ds_bpermute((lane - d) << 2, pr);
            if (lane >= d) { pb += ob; pr += orr; }
        }
        cnt[lane] = n; cum[lane] = pb - ((n + 255) >> 8); rb[lane] = pr - n;
        if (lane == 63) { cnt[NE] = SLTOK; cum[NE] = pb; rb[NE] = pr; cum[NEX] = pb + ((SLTOK + 255) >> 8); rb[NEX] = pr + SLTOK; }
    }
    __syncthreads();
    {
        LAS unsigned char* eob = (LAS unsigned char*)(F.lds + LDSCTL_OFF + 1536); const int nb = cum[NEX];
        for (int blk = F.tid; blk < nb; blk += 512) { int e = 0, hi_ = NEX;
#pragma unroll
            for (int it = 0; it < 7; ++it) { const int mid = (e + hi_) >> 1; if (cum[mid] <= blk) e = mid; else hi_ = mid; }
            eob[blk] = (unsigned char)e; }
    }
    __syncthreads();
}
DI void moe_gemm1(Frame& F, int layer, int slice) {
    moe_tables(F, layer, slice);
    const LAS int* cum = (const LAS int*)(F.lds + LDSCTL_OFF); const LAS int* cnt = (const LAS int*)(F.lds + LDSCTL_OFF + 272); const LAS int* rb = (const LAS int*)(F.lds + LDSCTL_OFF + 544);
    unsigned char* lb = F.ws + WS_LIST + (size_t)slice * LIST_SLICE;
    pg8::Gemm g{(const bf16*)(F.ws + WS_U), (const bf16*)(F.ws + WS_W13), 1024};
    MoeOrder S{cum, cnt, rb, (const LAS unsigned char*)(F.lds + LDSCTL_OFF + 1536), (const int*)lb, 2, F.G, F.vcu, cum[NEX] * 2};
    EpiSwiGLU E{(bf16*)(F.ws + WS_ACT)};
    pg8::gemm_phase<EpiSwiGLU, MoeOrder, true>(F.lds + RING_OFF, g, S, E, F.tid, STAG_G1);
}
DI void moe_gemm2(Frame& F, int layer, int slice, int nostore = 0) {
    moe_tables(F, layer, slice);
    const LAS int* cum = (const LAS int*)(F.lds + LDSCTL_OFF); const LAS int* cnt = (const LAS int*)(F.lds + LDSCTL_OFF + 272); const LAS int* rb = (const LAS int*)(F.lds + LDSCTL_OFF + 544);
    pg8::Gemm g{(const bf16*)(F.ws + WS_ACT), (const bf16*)(F.ws + WS_W2), 256};
    MoeOrder S{cum, cnt, rb, (const LAS unsigned char*)(F.lds + LDSCTL_OFF + 1536), nullptr, 4, F.G, F.vcu, cum[NEX] * 4};
    EpiMoeOut E{F.ws + WS_Y2, nostore};
    pg8::gemm_phase<EpiMoeOut, MoeOrder, false>(F.lds + RING_OFF, g, S, E, F.tid, STAG_G2);
}
DI void moe_combine(Frame& F, int layer, int slice, bool last_layer, const float* norms) {
    moe_tables(F, layer, slice);
    const LAS int* rb = (const LAS int*)(F.lds + LDSCTL_OFF + 544);
    const int gw = F.vcu * 8 + F.wave, NGW = F.G * 8, lane = F.lane;
    const float* MOD = (const float*)(F.ws + WS_MOD);
    const unsigned char* Y2 = F.ws + WS_Y2; bf16* U = (bf16*)(F.ws + WS_UC);
    const unsigned char* lb = F.ws + WS_LIST + (size_t)slice * LIST_SLICE;
    const int* slot = (const int*)(lb + LIST_ARR); const float* wts = (const float*)(lb + 2 * LIST_ARR);
    float g3[16]; ld_rowx_f32(norms + (size_t)(layer * 4 + 3) * D, lane, g3);
    for (int ml0 = gw; ml0 < SLTOK; ml0 += 2 * NGW) {
        int lz = F.lane; asm volatile("" : "+v"(lz));
        int mm[2]; v4u rw[2][9]; float wk[2][8];
#pragma unroll
        for (int t = 0; t < 2; ++t) {
            const int ml = ml0 + t * NGW; mm[t] = ml < SLTOK ? ml : ml0;
            const int sv = slot[mm[t] * 8 + (lz & 7)]; const float wv = wts[mm[t] * 8 + (lz & 7)];
            const int myrow = rb[sv >> 16] + (sv & 0xffff);
#pragma unroll
            for (int k = 0; k < 8; ++k) { const int row = __builtin_amdgcn_readlane(myrow, k); wk[t][k] = __builtin_bit_cast(float, __builtin_amdgcn_readlane(__builtin_bit_cast(int, wv), k));
                rw[t][k] = *(const GAS v4u*)(Y2 + (size_t)row * D + (unsigned)(16 * lz)); }
            rw[t][8] = *(const GAS v4u*)(Y2 + ((size_t)SLTOK * 8 + mm[t]) * D + 16 * lz);
        }
        float o[2][16];
#pragma unroll
        for (int t = 0; t < 2; ++t) {
#pragma unroll
            for (int i = 0; i < 16; ++i) o[t][i] = 0.f;
#pragma unroll
            for (int k = 0; k < 9; ++k) { const float w = k < 8 ? wk[t][k < 8 ? k : 0] : 1.f;
#pragma unroll
                for (int j = 0; j < 2; ++j) { v2u a; a.x = j ? rw[t][k].z : rw[t][k].x; a.y = j ? rw[t][k].w : rw[t][k].y;
                    const f32x2 d0 = __builtin_amdgcn_cvt_pk_f32_fp8((int)a.x, false), d1 = __builtin_amdgcn_cvt_pk_f32_fp8((int)a.x, true), d2 = __builtin_amdgcn_cvt_pk_f32_fp8((int)a.y, false), d3 = __builtin_amdgcn_cvt_pk_f32_fp8((int)a.y, true);
                    o[t][8 * j + 0] += w * d0[0]; o[t][8 * j + 1] += w * d0[1]; o[t][8 * j + 2] += w * d1[0]; o[t][8 * j + 3] += w * d1[1]; o[t][8 * j + 4] += w * d2[0]; o[t][8 * j + 5] += w * d2[1]; o[t][8 * j + 6] += w * d3[0]; o[t][8 * j + 7] += w * d3[1]; } }
        }
        float h[2][16], gf[2][16];
#pragma unroll
        for (int t = 0; t < 2; ++t) { const int m = slice * SLTOK + mm[t]; ld_rowx_f32(F.out + (size_t)m * D, lz, h[t]); ld_rowx_f32(MOD + ((size_t)(layer * 9 + m / T)) * 6144 + 5 * D, lz, gf[t]); }
#pragma unroll
        for (int t = 0; t < 2; ++t) {
            if (ml0 + t * NGW >= SLTOK) break;
            const int m = slice * SLTOK + mm[t], b = m / T;
            const float rs = rsqrtf(row_sumsq(o[t]) * (1.f / D) + NORM_EPS);
#pragma unroll
            for (int i = 0; i < 16; ++i) h[t][i] += gf[t][i] * (o[t][i] * rs * g3[i]);
            st_rowx_f32(F.out + (size_t)m * D, lz, h[t]);
            if (!last_layer) {
                const float rs2 = rsqrtf(row_sumsq(h[t]) * (1.f / D) + NORM_EPS);
                const float* mb = MOD + ((size_t)((layer + 1) * 9 + b)) * 6144;
                float u[16], ng[16], na[16], nb[16]; ld_rowx_f32(norms + (size_t)((layer + 1) * 4) * D, lz, ng); ld_rowx_f32(mb, lz, na); ld_rowx_f32(mb + D, lz, nb);
#pragma unroll
                for (int i = 0; i < 16; ++i) u[i] = h[t][i] * rs2 * ng[i] * (1.f + nb[i]) + na[i];
                st_rowx_bf16(U + (size_t)m * D, lz, u);
            }
        }
    }
}

DI void dwconv_ln(Frame& F, const bf16* Z, bf16* C, const float* dw, const float* bdwp, const float* lngp, const float* lnbp) {
    LAS float* red = (LAS float*)(F.lds + RING_OFF);
    LAS float* tot = red + 32 * 528;
    const int tid = F.tid, c0 = 2 * tid;
    const f32x2 bdw = *(const GAS f32x2*)(bdwp + c0), lg = *(const GAS f32x2*)(lngp + c0), lb = *(const GAS f32x2*)(lnbp + c0);
    f32x2 kk[31];
#pragma unroll
    for (int w = 0; w < 31; ++w) kk[w] = *(const GAS f32x2*)(dw + w * D + c0);
    for (int run = F.vcu; run < NTOK / 128; run += F.G) {
        const int mrun = run * 128, trun = mrun & (T - 1);
        f32x2 zz[46]; unsigned zn[16];
        { unsigned z[46];
#pragma unroll
          for (int i = 0; i < 46; ++i) { const int t = trun - 15 + i; z[i] = (t >= 0 && t < T) ? *(const GAS unsigned*)(Z + (size_t)(mrun - 15 + i) * D + c0) : 0u; }
#pragma unroll
          for (int i = 0; i < 46; ++i) zz[i] = (f32x2){bf_lo(z[i]), bf_hi(z[i])}; }
#pragma unroll 1
        for (int j = 0; j < 8; ++j) {
            const int m0 = mrun + 16 * j, t0 = trun + 16 * j;
            if (j + 1 < 8) {
#pragma unroll
                for (int i = 0; i < 16; ++i) { const int t = t0 + 31 + i; zn[i] = (t < T) ? *(const GAS unsigned*)(Z + (size_t)(m0 + 31 + i) * D + c0) : 0u; }
            }
            f32x2 acc2[16];
#pragma unroll
            for (int i = 0; i < 16; ++i) acc2[i] = bdw;
#pragma unroll
            for (int w = 0; w < 31; ++w)
#pragma unroll
                for (int i = 0; i < 16; ++i) acc2[i] = __builtin_elementwise_fma(zz[i + w], kk[w], acc2[i]);
            __syncthreads();
#pragma unroll
            for (int i = 0; i < 16; ++i) { red[i * 528 + tid] = acc2[i][0] + acc2[i][1]; red[(16 + i) * 528 + tid] = acc2[i][0] * acc2[i][0] + acc2[i][1] * acc2[i][1]; }
            __syncthreads();
            { const int tk = tid >> 5, which = (tid >> 4) & 1, pp = tid & 15; float acc_ = 0.f;
              const LAS float* rp = red + (which * 16 + tk) * 528 + pp;
#pragma unroll
              for (int k = 0; k < 32; ++k) acc_ += rp[16 * k];
              acc_ += lane_xor(acc_, tid & 63, 1); acc_ += lane_xor(acc_, tid & 63, 2); acc_ += lane_xor(acc_, tid & 63, 4); acc_ += lane_xor(acc_, tid & 63, 8);
              const float oth = lane_xor(acc_, tid & 63, 16);
              if ((tid & 31) == 0) { const float mu = acc_ * (1.f / D), var = oth * (1.f / D) - mu * mu; tot[2 * tk] = mu; tot[2 * tk + 1] = rsqrtf(fmaxf(var, 0.f) + LN_EPS); } }
            __syncthreads();
#pragma unroll
            for (int i = 0; i < 16; ++i) {
                const float mu = tot[2 * i], rstd = tot[2 * i + 1];
                const float v0 = (acc2[i][0] - mu) * rstd * lg[0] + lb[0], v1 = (acc2[i][1] - mu) * rstd * lg[1] + lb[1];
                *(GAS unsigned*)(C + (size_t)(m0 + i) * D + c0) = cvt_pk_bf16(siluf_(v0), siluf_(v1));
            }
#pragma unroll
            for (int i = 0; i < 30; ++i) zz[i] = zz[i + 16];
#pragma unroll
            for (int i = 0; i < 16; ++i) zz[30 + i] = (f32x2){bf_lo(zn[i]), bf_hi(zn[i])};
        }
    }
}

constexpr int N_PHASES = 18;
struct Args { const float* in[26]; float* out; unsigned char* ws; int ph_lo, ph_hi; };
#define INP(i) ([&]() -> const float* { int j_ = (i); asm volatile("" : "+s"(j_)); return args.in[j_]; }())
__global__ void __launch_bounds__(512, 2) fwd_kernel(Args args) {
    extern __shared__ __attribute__((aligned(16))) unsigned char lds[];
    Frame F;
    F.lds = (LAS unsigned char*)lds;
    F.MISC = (volatile LAS unsigned*)(F.lds + MISC_OFF);
    F.tid = threadIdx.x; F.lane = F.tid & 63; F.wave = __builtin_amdgcn_readfirstlane(F.tid >> 6);
    F.G = gridDim.x; { const int bx = blockIdx.x; F.vcu = (F.G % 8 == 0) ? (bx % 8) * (F.G / 8) + bx / 8 : bx; }
    F.ws = args.ws; F.ctl = (unsigned*)(args.ws + WS_CTL); F.out = args.out;
    for (int u = F.tid; u < (LDS_BYTES - LDSCTL_OFF) / 4; u += 512) ((LAS unsigned*)(F.lds + LDSCTL_OFF))[u] = 0u;
    __syncthreads();
    const int wave_s = __builtin_amdgcn_readfirstlane(threadIdx.x >> 6);
    const int lo = args.ph_lo, hi = args.ph_hi;
    XcdBarrier bar; bar.bar = F.ctl + CW_BAR; bar.x = 0; bar.st = nullptr;
    if (hi - lo > 1) bar = xcd_barrier_post(F.ctl + CW_BAR, F.MISC + 8);
    int ph = 0;
#ifdef PROBE_A
    volatile LAS unsigned long long* stampv = (volatile LAS unsigned long long*)(F.lds + LDSCTL_OFF + 1280);
    if (blockIdx.x == 0 && F.tid == 0) stampv[0] = __builtin_amdgcn_s_memrealtime();
#define STAMP() do { if (blockIdx.x == 0 && F.tid == 0) stampv[ph + 1] = __builtin_amdgcn_s_memrealtime(); } while (0)
#else
#define STAMP() do { } while (0)
#endif
#define FRESH() do { int lz_; asm volatile("v_mbcnt_lo_u32_b32 %0, -1, 0\n\tv_mbcnt_hi_u32_b32 %0, -1, %0" : "=&v"(lz_)); F.lane = lz_; F.wave = wave_s; F.tid = wave_s * 64 + lz_;     \
        unsigned char* w_ = args.ws; float* o_ = args.out; asm volatile("" : "+s"(w_), "+s"(o_)); F.ws = w_; F.ctl = (unsigned*)(w_ + WS_CTL); F.out = o_; ws = w_; U0 = (bf16*)o_; OPART = (bf16*)o_; Ob = (bf16*)(w_ + WS_V); } while (0)
#define PH_BEGIN if (lo <= ph && ph < hi) { FRESH();
#define PH_END } if (lo <= ph && ph + 1 < hi) xcd_barrier(bar, F.tid == 0); STAMP(); ++ph;
    unsigned char* ws; bf16 *U0, *OPART, *Ob;

    PH_BEGIN mod_vectors(F, INP(I_C), INP(I_CCTX), INP(I_MODW), INP(I_MODB)); rope_tables(F); conv_small_weights(F, INP(I_RWIN), INP(I_RWOUT), INP(I_CW1), INP(I_CW2));
             conv_moe_weights(F, 0, INP(I_MW1), INP(I_MW3), INP(I_MW2), INP(I_SW1), INP(I_SW3), INP(I_SW2)); PH_END
    PH_BEGIN u_rows_layer0(F, U0, INP(I_X), INP(I_CTX), INP(I_NORMS)); router_prescale(F, INP(I_NORMS), INP(I_ROUTER)); PH_END
    PH_BEGIN
        pg8::Gemm g{U0, (const bf16*)(ws + WS_WIN), 1024}; InprojOrder S; S.init(F.G, (int)blockIdx.x);
        EpiQKVG E{ws};
        pg8::gemm_phase<EpiQKVG, InprojOrder, false>(F.lds + RING_OFF, g, S, E, F.tid, STAG_IN);
    PH_END
    PH_BEGIN retention_scores(F, INP(I_RDECAY)); PH_END
    PH_BEGIN retention_scan(F, OPART, Ob, INP(I_RDECAY)); PH_END
    PH_BEGIN gn_gate_rows(F, Ob, (const bf16*)(ws + WS_G), OPART); PH_END
    PH_BEGIN
        pg8::Gemm g{Ob, (const bf16*)(ws + WS_WOUT), 2048}; pg8::StaticOrder S; S.init(NTOK, D, F.G, (int)blockIdx.x);
        EpiBf16 E{(bf16*)(ws + WS_Y), D, nullptr};
        pg8::gemm_phase<EpiBf16, pg8::StaticOrder, false>(F.lds + RING_OFF, g, S, E, F.tid, STAG_PL);
    PH_END
#pragma unroll 1
    for (int layer = 0; layer < 2; ++layer) {
        if (layer == 1) {
            PH_BEGIN
                pg8::Gemm g{(const bf16*)(ws + WS_UC), (const bf16*)(ws + WS_CW1), 1024}; pg8::StaticOrder S; S.init(NTOK, 2048, F.G, (int)blockIdx.x);
                EpiGLU E{(bf16*)(ws + WS_Z), INP(I_CB1)};
                pg8::gemm_phase<EpiGLU, pg8::StaticOrder, false>(F.lds + RING_OFF, g, S, E, F.tid, STAG_PL);
            PH_END
            PH_BEGIN dwconv_ln(F, (const bf16*)(ws + WS_Z), (bf16*)(ws + WS_C), INP(I_CDW), INP(I_CBDW), INP(I_CLNG), INP(I_CLNB)); PH_END
            PH_BEGIN
                pg8::Gemm g{(const bf16*)(ws + WS_C), (const bf16*)(ws + WS_CW2), 1024}; pg8::StaticOrder S; S.init(NTOK, D, F.G, (int)blockIdx.x);
                EpiBf16 E{(bf16*)(ws + WS_Y1), D, INP(I_CB2)};
                pg8::gemm_phase<EpiBf16, pg8::StaticOrder, false>(F.lds + RING_OFF, g, S, E, F.tid, STAG_PL);
            PH_END
        }
        PH_BEGIN rows_router(F, layer, layer ? (const float*)F.out : INP(I_X), (const bf16*)(ws + (layer ? WS_Y1 : WS_Y)), (bf16*)(ws + WS_U), INP(I_NORMS), INP(I_MBIAS), F.out); PH_END
        PH_BEGIN moe_gemm1(F, layer, 0); PH_END
        PH_BEGIN moe_gemm2(F, layer, 0); PH_END
        PH_BEGIN moe_combine(F, layer, 0, layer == 1, INP(I_NORMS));
                 if (layer == 0) conv_moe_weights(F, 1, INP(I_MW1), INP(I_MW3), INP(I_MW2), INP(I_SW1), INP(I_SW3), INP(I_SW2)); PH_END
    }
#ifdef PROBE_A
    if (blockIdx.x == 0 && F.tid == 0) {
        const unsigned long long tend = __builtin_amdgcn_s_memrealtime();
        unsigned long long sa = 0, sb = 0;
        for (int k = 0; k < N_PHASES; ++k) { const unsigned long long d = stampv[k + 1] - stampv[k]; if ((PROBE_A >> k) & 1u) sa += d; if ((PROBE_B >> k) & 1u) sb += d; }
        if (sb) { VM_WAIT(); F.out[0] += (float)sb * 0.001f; }
        while (__builtin_amdgcn_s_memrealtime() - tend < 8ull * sa) __builtin_amdgcn_s_sleep(8);
    }
#endif
#undef PH_BEGIN
#undef PH_END
}

extern "C" void kernel_launch(void* const* d_in, const int* in_sizes, int n_in, void* d_out, int out_size, void* d_ws, size_t ws_size, hipStream_t stream) {
    static int grid = 0;
    if (grid == 0) {
        if (n_in != 26 || in_sizes[0] != NTOK * D || out_size != NTOK * D || ws_size < WS_END) {
            fprintf(stderr, "kernel_launch: unexpected shapes / workspace (n_in %d, ws %zu, need %zu); nothing launched\n", n_in, ws_size, (size_t)WS_END); grid = -1; return; }
        int dev = 0, cus = 0, per_cu = 0;
        if (hipGetDevice(&dev) != hipSuccess || hipDeviceGetAttribute(&cus, hipDeviceAttributeMultiprocessorCount, dev) != hipSuccess) { grid = -1; return; }
        if (hipFuncSetAttribute((const void*)fwd_kernel, hipFuncAttributeMaxDynamicSharedMemorySize, LDS_BYTES) != hipSuccess) { fprintf(stderr, "kernel_launch: hipFuncSetAttribute failed\n"); grid = -1; return; }
        if (hipOccupancyMaxActiveBlocksPerMultiprocessor(&per_cu, (const void*)fwd_kernel, 512, LDS_BYTES) != hipSuccess || per_cu < 1) { fprintf(stderr, "kernel_launch: occupancy query says %d\n", per_cu); }
        (void)hipGetLastError();
        if (cus < 160) { fprintf(stderr, "kernel_launch: %d CUs: this kernel's per-workgroup tables are sized for >= 160 workgroups; nothing launched\n", cus); grid = -1; return; }
        grid = cus;
    }
    if (grid < 0) return;
    (void)hipMemsetAsync((char*)d_ws + WS_CTL, 0, CTL_ZERO_BYTES, stream);
    Args a{};
    for (int i = 0; i < 26; ++i) a.in[i] = (const float*)d_in[i];
    a.out = (float*)d_out; a.ws = (unsigned char*)d_ws;
#if MK_ONE_LAUNCH
    a.ph_lo = 0; a.ph_hi = N_PHASES;
    hipLaunchKernelGGL(fwd_kernel, dim3(grid), dim3(512), LDS_BYTES, stream, a);
#else
    for (int p = 0; p < N_PHASES; ++p) { a.ph_lo = p; a.ph_hi = p + 1; hipLaunchKernelGGL(fwd_kernel, dim3(grid), dim3(512), LDS_BYTES, stream, a); }
#endif
}
```
